# Optimizing an MI355X kernel written in HIP

```python
import jax, jax.numpy as jnp
from jax import lax
import numpy as np

D_MODEL = 1024
BATCH = 1
SEQ = 16384
DEPTH = 4

N_MIXERS = 4
NORM_EPS = 1e-6
ROPE_THETA = 10000.0
LIN_CHUNK = 64
ATTN_BLOCK = 128
HGRN_EXPAND = 128
HGRN_HEADS = D_MODEL // HGRN_EXPAND
HGRN_DK = HGRN_EXPAND
HGRN_DV = D_MODEL // HGRN_HEADS
GLA_HEADS = 4
GLA_KEY_DIM = D_MODEL // 2
GLA_VALUE_DIM = D_MODEL
GLA_DK = GLA_KEY_DIM // GLA_HEADS
GLA_DV = GLA_VALUE_DIM // GLA_HEADS
GLA_GATE_RANK = 16
GLA_GATE_NORMALIZER = 16.0
RET_HEADS = 8
RET_DK = D_MODEL // RET_HEADS
RET_DV = 2 * D_MODEL // RET_HEADS
MLA_HEADS = 8
MLA_Q_LORA = 384
MLA_KV_LORA = 128
MLA_NOPE = 128
MLA_ROPE = 64
MLA_V = 128
MLA_QK = MLA_NOPE + MLA_ROPE
FFN_HIDDEN = -(-8 * D_MODEL // (3 * 256)) * 256

kernel_name = "hybrid_hgrn2_gla_retnet_mla_trunk"


def _rms_norm(x, gain=None):
    xf = x.astype(jnp.float32)
    y = xf * lax.rsqrt(jnp.mean(jnp.square(xf), axis=-1, keepdims=True) + NORM_EPS)
    if gain is not None:
        y = y * gain.astype(jnp.float32)
    return y.astype(x.dtype)


def _rope(x, positions):
    d = x.shape[-1]
    half = d // 2
    inv_freq = 1.0 / (ROPE_THETA ** (jnp.arange(half, dtype=jnp.float32) / half))
    ang = positions.astype(jnp.float32)[..., None] * inv_freq
    cos = jnp.cos(ang)[:, :, None, :]
    sin = jnp.sin(ang)[:, :, None, :]
    xf = x.astype(jnp.float32)
    x1, x2 = xf[..., :half], xf[..., half:]
    return jnp.concatenate([x1 * cos - x2 * sin, x2 * cos + x1 * sin], axis=-1).astype(x.dtype)


def _to_heads(t, n_heads):
    b, s, _ = t.shape
    return t.reshape(b, s, n_heads, -1).transpose(0, 2, 1, 3)


def _to_chunks(t, chunk):
    b, h, l, d = t.shape
    return jnp.moveaxis(t.reshape(b, h, l // chunk, chunk, d), 2, 0)


def _from_chunks(t):
    n, b, h, c, d = t.shape
    return jnp.moveaxis(t, 0, 2).reshape(b, h, n * c, d)


def _gated_linear_scan(q, k, v, log_f):
    b, h, _, dk = q.shape
    dv = v.shape[-1]
    f32 = jnp.float32
    qc, kc, vc, gc = (_to_chunks(t.astype(f32), LIN_CHUNK) for t in (q, k, v, log_f))
    causal = jnp.tril(jnp.ones((LIN_CHUNK, LIN_CHUNK), dtype=bool))[:, :, None]

    def step(state, inp):
        q_, k_, v_, g_ = inp
        cum = jnp.cumsum(g_, axis=2)
        diff = cum[:, :, :, None, :] - cum[:, :, None, :, :]
        decay = jnp.exp(jnp.where(causal, diff, -jnp.inf))
        scores = jnp.einsum('bhtk,bhsk,bhtsk->bhts', q_, k_, decay)
        o_intra = jnp.einsum('bhts,bhsv->bhtv', scores, v_)
        o_inter = jnp.einsum('bhtk,bhkv->bhtv', q_ * jnp.exp(cum), state)
        last = cum[:, :, -1:, :]
        new_state = (jnp.exp(last[:, :, 0, :])[..., None] * state
                     + jnp.einsum('bhsk,bhsv->bhkv', k_ * jnp.exp(last - cum), v_))
        return new_state, o_intra + o_inter

    s0 = jnp.zeros((b, h, dk, dv), f32)
    _, o = lax.scan(step, s0, (qc, kc, vc, gc))
    return _from_chunks(o)


def _retention_scan(q, k, v, log_gamma):
    b, h, _, dk = q.shape
    dv = v.shape[-1]
    f32 = jnp.float32
    qc, kc, vc = (_to_chunks(t.astype(f32), LIN_CHUNK) for t in (q, k, v))
    idx = jnp.arange(LIN_CHUNK, dtype=f32)
    lg = log_gamma[:, None]
    causal = jnp.tril(jnp.ones((LIN_CHUNK, LIN_CHUNK), dtype=bool))
    intra_decay = jnp.exp(jnp.where(causal, lg[:, :, None] * (idx[:, None] - idx[None, :]), -jnp.inf))
    q_decay = jnp.exp(lg * (idx + 1.0))[:, :, None]
    k_decay = jnp.exp(lg * (LIN_CHUNK - 1.0 - idx))[:, :, None]
    chunk_decay = jnp.exp(log_gamma * LIN_CHUNK)[:, None, None]

    def step(state, inp):
        q_, k_, v_ = inp
        scores = jnp.einsum('bhtk,bhsk->bhts', q_, k_) * intra_decay
        o = (jnp.einsum('bhts,bhsv->bhtv', scores, v_)
             + jnp.einsum('bhtk,bhkv->bhtv', q_ * q_decay, state))
        new_state = chunk_decay * state + jnp.einsum('bhsk,bhsv->bhkv', k_ * k_decay, v_)
        return new_state, o

    s0 = jnp.zeros((b, h, dk, dv), f32)
    _, o = lax.scan(step, s0, (qc, kc, vc))
    return _from_chunks(o)


def _causal_attention_blocked(q, k, v):
    b, s, h, dq = q.shape
    dv = v.shape[-1]
    nb = s // ATTN_BLOCK
    scale = dq ** -0.5
    qb = jnp.moveaxis(q.reshape(b, nb, ATTN_BLOCK, h, dq), 1, 0)
    kpos = jnp.arange(s)

    def one_block(args):
        q_blk, j = args
        qpos = j * ATTN_BLOCK + jnp.arange(ATTN_BLOCK)
        sc = jnp.einsum('bqhd,bkhd->bhqk', q_blk, k).astype(jnp.float32) * scale
        sc = jnp.where(kpos[None, :] <= qpos[:, None], sc, -jnp.inf)
        p = jax.nn.softmax(sc, axis=-1).astype(v.dtype)
        return jnp.einsum('bhqk,bkhd->bqhd', p, v)

    o = lax.map(one_block, (qb, jnp.arange(nb)))
    return jnp.moveaxis(o, 0, 1).reshape(b, s, h, dv)


def _hgrn2(h, w_in, g_norm, w_out, lower_bound):
    b, s, _ = h.shape
    q, f, i, g = jnp.split(h @ w_in, 4, axis=-1)
    q = jax.nn.silu(q) * (HGRN_DK ** -0.5)
    forget = lower_bound + (1.0 - lower_bound) * jax.nn.sigmoid(f.astype(jnp.float32))
    k = 1.0 - forget
    log_f = jnp.log(forget)
    o = _gated_linear_scan(_to_heads(q, HGRN_HEADS), _to_heads(k, HGRN_HEADS),
                           _to_heads(i, HGRN_HEADS), _to_heads(log_f, HGRN_HEADS))
    o = o.transpose(0, 2, 1, 3).astype(h.dtype)
    o = _rms_norm(o, g_norm) * jax.nn.silu(g.reshape(b, s, HGRN_HEADS, HGRN_DV))
    return o.reshape(b, s, -1) @ w_out


def _gla(h, w_in, w_gk_up, b_gk, g_norm, w_out):
    b, s, _ = h.shape
    q, k, v, g, gk_low = jnp.split(
        h @ w_in, [GLA_KEY_DIM, 2 * GLA_KEY_DIM, 2 * GLA_KEY_DIM + GLA_VALUE_DIM,
                   2 * GLA_KEY_DIM + 2 * GLA_VALUE_DIM], axis=-1)
    log_f = jax.nn.log_sigmoid((gk_low @ w_gk_up + b_gk).astype(jnp.float32)) / GLA_GATE_NORMALIZER
    q = q * (GLA_DK ** -0.5)
    o = _gated_linear_scan(_to_heads(q, GLA_HEADS), _to_heads(k, GLA_HEADS),
                           _to_heads(v, GLA_HEADS), _to_heads(log_f, GLA_HEADS))
    o = o.transpose(0, 2, 1, 3).astype(h.dtype)
    o = _rms_norm(o, g_norm) * jax.nn.silu(g.reshape(b, s, GLA_HEADS, GLA_DV))
    return o.reshape(b, s, -1) @ w_out


def _retnet(h, positions, w_in, w_out):
    b, s, _ = h.shape
    q, k, v, g = jnp.split(h @ w_in, [D_MODEL, 2 * D_MODEL, 4 * D_MODEL], axis=-1)
    q = _rope(q.reshape(b, s, RET_HEADS, RET_DK), positions)
    k = _rope(k.reshape(b, s, RET_HEADS, RET_DK), positions) * (RET_DK ** -0.5)
    log_gamma = jnp.log(1.0 - 2.0 ** (-5.0 - jnp.arange(RET_HEADS, dtype=jnp.float32)))
    o = _retention_scan(q.transpose(0, 2, 1, 3), k.transpose(0, 2, 1, 3),
                        _to_heads(v, RET_HEADS), log_gamma)
    o = _rms_norm(o.transpose(0, 2, 1, 3).astype(h.dtype))
    o = jax.nn.silu(g) * o.reshape(b, s, -1)
    return o @ w_out


def _mla(h, positions, w_in, g_q_lora, g_kv_lora, w_uq, w_ukv, g_qnorm, g_knorm, w_out):
    b, s, _ = h.shape
    c_q, c_kv, k_rope = jnp.split(h @ w_in, [MLA_Q_LORA, MLA_Q_LORA + MLA_KV_LORA], axis=-1)
    c_q = _rms_norm(c_q, g_q_lora)
    c_kv = _rms_norm(c_kv, g_kv_lora)
    q = (c_q @ w_uq).reshape(b, s, MLA_HEADS, MLA_QK)
    kv = (c_kv @ w_ukv).reshape(b, s, MLA_HEADS, MLA_NOPE + MLA_V)
    k_nope, v = kv[..., :MLA_NOPE], kv[..., MLA_NOPE:]
    k_rope = jnp.broadcast_to(k_rope[:, :, None, :], (b, s, MLA_HEADS, MLA_ROPE))
    k = jnp.concatenate([k_nope, k_rope], axis=-1)
    q = _rms_norm(q, g_qnorm)
    k = _rms_norm(k, g_knorm)
    q = jnp.concatenate([q[..., :MLA_NOPE], _rope(q[..., MLA_NOPE:], positions)], axis=-1)
    k = jnp.concatenate([k[..., :MLA_NOPE], _rope(k[..., MLA_NOPE:], positions)], axis=-1)
    o = _causal_attention_blocked(q, k, v)
    return o.reshape(b, s, -1) @ w_out


def _swiglu(h, w_gate_up, w_down):
    a, u = jnp.split(h @ w_gate_up, 2, axis=-1)
    return (jax.nn.silu(a) * u) @ w_down


def setup_inputs(seed: int = 0) -> dict:
    key = jax.random.key(seed)
    keys = iter(jax.random.split(key, 40))
    n_a, n_b, n_c, n_d = (len(range(m, DEPTH, N_MIXERS)) for m in range(N_MIXERS))
    out_gain = (2.0 * DEPTH) ** -0.5

    def w(shape, fan_in, gain=1.0):
        return jax.random.normal(next(keys), shape, jnp.float32) * (gain * fan_in ** -0.5)

    def gain(shape):
        return 1.0 + 0.02 * jax.random.normal(next(keys), shape, jnp.float32)

    x = jax.random.normal(next(keys), (BATCH, SEQ, D_MODEL), jnp.float32)
    positions = jnp.broadcast_to(jnp.arange(SEQ, dtype=jnp.int32), (BATCH, SEQ))
    gla_in = 2 * GLA_KEY_DIM + 2 * GLA_VALUE_DIM + GLA_GATE_RANK
    return {
        "x": x,
        "positions": positions,
        "norm_mix": gain((DEPTH, D_MODEL)),
        "norm_ffn": gain((DEPTH, D_MODEL)),
        "hgrn_w_in": w((n_a, D_MODEL, 4 * D_MODEL), D_MODEL),
        "hgrn_g_norm": gain((n_a, HGRN_DV)),
        "hgrn_w_out": w((n_a, D_MODEL, D_MODEL), D_MODEL, out_gain),
        "hgrn_lb_logits": 0.5 * jax.random.normal(next(keys), (DEPTH + 1, D_MODEL), jnp.float32),
        "gla_w_in": w((n_b, D_MODEL, gla_in), D_MODEL),
        "gla_w_gk_up": w((n_b, GLA_GATE_RANK, GLA_KEY_DIM), GLA_GATE_RANK),
        "gla_b_gk": 0.01 * jax.random.normal(next(keys), (n_b, GLA_KEY_DIM), jnp.float32),
        "gla_g_norm": gain((n_b, GLA_DV)),
        "gla_w_out": w((n_b, GLA_VALUE_DIM, D_MODEL), GLA_VALUE_DIM, out_gain),
        "ret_w_in": w((n_c, D_MODEL, 6 * D_MODEL), D_MODEL),
        "ret_w_out": w((n_c, 2 * D_MODEL, D_MODEL), 2 * D_MODEL, out_gain),
        "mla_w_in": w((n_d, D_MODEL, MLA_Q_LORA + MLA_KV_LORA + MLA_ROPE), D_MODEL),
        "mla_g_q_lora": gain((n_d, MLA_Q_LORA)),
        "mla_g_kv_lora": gain((n_d, MLA_KV_LORA)),
        "mla_w_uq": w((n_d, MLA_Q_LORA, MLA_HEADS * MLA_QK), MLA_Q_LORA),
        "mla_w_ukv": w((n_d, MLA_KV_LORA, MLA_HEADS * (MLA_NOPE + MLA_V)), MLA_KV_LORA),
        "mla_g_qnorm": gain((n_d, MLA_QK)),
        "mla_g_knorm": gain((n_d, MLA_QK)),
        "mla_w_out": w((n_d, MLA_HEADS * MLA_V, D_MODEL), MLA_HEADS * MLA_V, out_gain),
        "ffn_w_gate_up": w((DEPTH, D_MODEL, 2 * FFN_HIDDEN), D_MODEL),
        "ffn_w_down": w((DEPTH, FFN_HIDDEN, D_MODEL), FFN_HIDDEN, out_gain),
    }


def reference(x, positions, norm_mix, norm_ffn,
              hgrn_w_in, hgrn_g_norm, hgrn_w_out, hgrn_lb_logits,
              gla_w_in, gla_w_gk_up, gla_b_gk, gla_g_norm, gla_w_out,
              ret_w_in, ret_w_out,
              mla_w_in, mla_g_q_lora, mla_g_kv_lora, mla_w_uq, mla_w_ukv,
              mla_g_qnorm, mla_g_knorm, mla_w_out,
              ffn_w_gate_up, ffn_w_down):
    lower_bounds = jnp.cumsum(jax.nn.softmax(hgrn_lb_logits.astype(jnp.float32), axis=0), axis=0)
    for i in range(DEPTH):
        mixer, j = i % N_MIXERS, i // N_MIXERS
        h = _rms_norm(x, norm_mix[i])
        if mixer == 0:
            y = _hgrn2(h, hgrn_w_in[j], hgrn_g_norm[j], hgrn_w_out[j], lower_bounds[i])
        elif mixer == 1:
            y = _gla(h, gla_w_in[j], gla_w_gk_up[j], gla_b_gk[j], gla_g_norm[j], gla_w_out[j])
        elif mixer == 2:
            y = _retnet(h, positions, ret_w_in[j], ret_w_out[j])
        else:
            y = _mla(h, positions, mla_w_in[j], mla_g_q_lora[j], mla_g_kv_lora[j], mla_w_uq[j],
                     mla_w_ukv[j], mla_g_qnorm[j], mla_g_knorm[j], mla_w_out[j])
        x = x + y.astype(x.dtype)
        h = _rms_norm(x, norm_ffn[i])
        x = x + _swiglu(h, ffn_w_gate_up[i], ffn_w_down[i]).astype(x.dtype)
    return x
```

```cpp
#include <hip/hip_runtime.h>
#include <hip/hip_cooperative_groups.h>
#include <stdint.h>
#include <cstdio>
namespace cg = cooperative_groups;

typedef unsigned short bf16_t;
typedef short bf16x8 __attribute__((ext_vector_type(8)));
typedef float f32x16 __attribute__((ext_vector_type(16)));
typedef float f32x4 __attribute__((ext_vector_type(4)));
typedef float f32x2 __attribute__((ext_vector_type(2)));
typedef unsigned u32x4 __attribute__((ext_vector_type(4)));
typedef unsigned u32x2 __attribute__((ext_vector_type(2)));

#define DI __device__ __forceinline__
#define MFMA(a, b, c) __builtin_amdgcn_mfma_f32_32x32x16_bf16((a), (b), (c), 0, 0, 0)

constexpr int S = 16384;
constexpr int VTS = 16384 + 192;
constexpr int NT = 512;
constexpr int LDS_BYTES = 147456 + 16;
constexpr int HALF_LDS = 73728;
constexpr size_t MiB = 1048576;
constexpr size_t WM_OFF = 0, WF_OFF = 17 * MiB, HB_OFF = 34 * MiB, PB_OFF = 66 * MiB, VTB_OFF = 198 * MiB,
                 SB_OFF = 263 * MiB, DB_OFF = 327 * MiB, TABR_OFF = 328 * MiB, TABM_OFF = 336 * MiB, LB_OFF = 340 * MiB,
                 SSQA_OFF = LB_OFF + 8192, SSQB_OFF = LB_OFF + 8192 + 65536, WMB_OFF = 341 * MiB, AO_OFF = PB_OFF + 100 * MiB;

struct Params {
  const float* x; const int* pos; const float* norm_mix; const float* norm_ffn;
  const float* hgrn_w_in; const float* hgrn_g_norm; const float* hgrn_w_out; const float* hgrn_lb;
  const float* gla_w_in; const float* gla_w_gk_up; const float* gla_b_gk; const float* gla_g_norm; const float* gla_w_out;
  const float* ret_w_in; const float* ret_w_out;
  const float* mla_w_in; const float* mla_g_q_lora; const float* mla_g_kv_lora; const float* mla_w_uq; const float* mla_w_ukv;
  const float* mla_g_qnorm; const float* mla_g_knorm; const float* mla_w_out;
  const float* ffn_w_gate_up; const float* ffn_w_down;
  float* out; char* ws;
};

DI int tid_() { int t = threadIdx.x & 255; asm volatile("" : "+v"(t)); return t; }
DI int gtid_() { int t = threadIdx.x; asm volatile("" : "+v"(t)); return t; }
DI int VB_() { int hv = __builtin_amdgcn_readfirstlane((int)(threadIdx.x >> 8)); asm volatile("" : "+s"(hv)); return blockIdx.x * 2 + hv; }
DI int VG_() { return gridDim.x * 2; }
DI bf16_t f2bf(float x) { unsigned u = __float_as_uint(x); u += 0x7fffu + ((u >> 16) & 1u); return (bf16_t)(u >> 16); }
DI float bf2f(bf16_t b) { return __uint_as_float(((unsigned)b) << 16); }
DI unsigned pack2(float a, float b) { return (unsigned)f2bf(a) | ((unsigned)f2bf(b) << 16); }
DI float lo2f(unsigned u) { return __uint_as_float(u << 16); }
DI float hi2f(unsigned u) { return __uint_as_float(u & 0xffff0000u); }
DI int crow(int i, int h) { return (i & 3) + 8 * (i >> 2) + 4 * h; }
DI float sigmoidf_(float x) { return 1.0f / (1.0f + __expf(-x)); }
DI float siluf_(float x) { return x / (1.0f + __expf(-x)); }
DI float clampe(float e) { return fminf(fmaxf(e, -80.f), 80.f); }
DI float wave_sum(float v) {
#pragma unroll
  for (int o = 1; o < 64; o <<= 1) v += __shfl_xor(v, o);
  return v;
}
DI f32x16 zero16() { f32x16 z; for (int i = 0; i < 16; ++i) z[i] = 0.f; return z; }

DI void conv_tile(const float* __restrict__ src, int K, int N, int mode, bf16_t* __restrict__ dst, int tile, char* smem) {
  float* T = (float*)smem;
  const int nkt = K >> 6, rt = tile / nkt, kt = tile % nkt, tid = tid_();
  const int R0 = rt * 64;
  int n0 = R0;
  if (mode == 1) { const int q = R0 >> 7, t = (R0 & 127) >> 6; n0 = t * 2816 + q * 64; }
#pragma unroll
  for (int i = 0; i < 4; ++i) {
    const int id = tid + 256 * i, kr = id >> 4, c4 = id & 15;
    f32x4 v = {0.f, 0.f, 0.f, 0.f};
    if (n0 + 4 * c4 < N) v = *(const f32x4*)(src + (size_t)(kt * 64 + kr) * N + n0 + 4 * c4);
    *(f32x4*)(T + kr * 68 + 4 * c4) = v;
  }
  __syncthreads();
  const int r = tid >> 2, seg = tid & 3;
  u32x4 o0, o1;
  const float* tp = T + (seg * 16) * 68 + r;
  o0.x = pack2(tp[0 * 68], tp[1 * 68]); o0.y = pack2(tp[2 * 68], tp[3 * 68]); o0.z = pack2(tp[4 * 68], tp[5 * 68]); o0.w = pack2(tp[6 * 68], tp[7 * 68]);
  o1.x = pack2(tp[8 * 68], tp[9 * 68]); o1.y = pack2(tp[10 * 68], tp[11 * 68]); o1.z = pack2(tp[12 * 68], tp[13 * 68]); o1.w = pack2(tp[14 * 68], tp[15 * 68]);
  bf16_t* d = dst + (size_t)(R0 + r) * K + kt * 64 + seg * 16;
  *(u32x4*)d = o0; *(u32x4*)(d + 8) = o1;
  __syncthreads();
}

DI void norm_item(const float* __restrict__ x, const float* __restrict__ gain, bf16_t* __restrict__ H, int item) {
  const int wave = tid_() >> 6, lane = tid_() & 63;
  const int row = item * 4 + wave;
  const f32x4* xr = (const f32x4*)(x + (size_t)row * 1024);
  f32x4 v[4]; float ss = 0.f;
#pragma unroll
  for (int j = 0; j < 4; ++j) { v[j] = xr[lane + 64 * j]; ss += v[j].x * v[j].x + v[j].y * v[j].y + v[j].z * v[j].z + v[j].w * v[j].w; }
  ss = wave_sum(ss);
  const float rstd = rsqrtf(ss * (1.0f / 1024.0f) + 1e-6f);
  const f32x4* g4 = (const f32x4*)gain;
#pragma unroll
  for (int j = 0; j < 4; ++j) {
    const f32x4 g = g4[lane + 64 * j];
    u32x2 o; o.x = pack2(v[j].x * rstd * g.x, v[j].y * rstd * g.y); o.y = pack2(v[j].z * rstd * g.z, v[j].w * rstd * g.w);
    *(u32x2*)(H + (size_t)row * 1024 + 4 * (lane + 64 * j)) = o;
  }
}

DI void sincos_acc(float ang, float& c, float& s) {
  const double x = (double)ang;
  const double q = __builtin_rint(x * 0.63661977236758134308);
  const double y = x - q * 1.57079632679489661923;
  const double y2 = y * y;
  double sp = y * (1.0 + y2 * (-1.0 / 6 + y2 * (1.0 / 120 + y2 * (-1.0 / 5040 + y2 * (1.0 / 362880 + y2 * (-1.0 / 39916800))))));
  double cp = 1.0 + y2 * (-0.5 + y2 * (1.0 / 24 + y2 * (-1.0 / 720 + y2 * (1.0 / 40320 + y2 * (-1.0 / 3628800 + y2 * (1.0 / 479001600))))));
  const int k = ((int)q) & 3;
  double sr, cr;
  if (k == 0) { sr = sp; cr = cp; } else if (k == 1) { sr = cp; cr = -sp; } else if (k == 2) { sr = -sp; cr = -cp; } else { sr = -cp; cr = sp; }
  c = (float)cr; s = (float)sr;
}
DI void table_item(const Params& p, int item) {
  const int row = item * 4 + (tid_() >> 6), j = tid_() & 63;
  const float pf = (float)p.pos[row];
  float* tr = (float*)(p.ws + TABR_OFF); float* tm = (float*)(p.ws + TABM_OFF);
  {
    const float inv = 1.0f / exp2f((float)j * (13.287712379549449f / 64.0f));
    float c, s; sincos_acc(pf * inv, c, s);
    tr[(size_t)row * 64 + j] = c; tr[(size_t)S * 64 + (size_t)row * 64 + j] = s;
  }
  if (j < 32) {
    const float inv = 1.0f / exp2f((float)j * (13.287712379549449f / 32.0f));
    float c, s; sincos_acc(pf * inv, c, s);
    tm[(size_t)row * 32 + j] = c; tm[(size_t)S * 32 + (size_t)row * 32 + j] = s;
  }
}
DI void lb_item(const Params& p, int item) {
  const int c = item * 256 + tid_();
  float l[5], mx = -1e30f;
  for (int j = 0; j < 5; ++j) { l[j] = p.hgrn_lb[j * 1024 + c]; mx = fmaxf(mx, l[j]); }
  float sum = 0.f; for (int j = 0; j < 5; ++j) sum += __expf(l[j] - mx);
  ((float*)(p.ws + LB_OFF))[c] = __expf(l[0] - mx) / sum;
}

enum { EP_BF16 = 0, EP_SILU = 1, EP_LOGF = 2, EP_ROPE = 3, EP_VT = 4, EP_RESID = 5, EP_SWIGLU = 6, EP_NONE = 7 };
enum { G_HGRN_IN = 0, G_GLA_IN, G_RET_IN, G_MLA_IN, G_MLA_Q, G_MLA_KV, G_OUT, G_FFN1, G_FFN2 };
struct Epi { int mode; bf16_t* dst; int ld; int dcol0; float scale; const float* xin; float* xout; const float* rs_in; float* ssq_out; const float* gnext; };

DI Epi get_epi(const Params& p, int gid, int nt, int layer) {
  Epi e; e.mode = EP_BF16; e.dst = (bf16_t*)(p.ws + PB_OFF); e.ld = 0; e.dcol0 = 0; e.scale = 1.f; e.xin = nullptr; e.xout = nullptr; e.rs_in = nullptr; e.ssq_out = nullptr; e.gnext = nullptr;
  float* ssqA = (float*)(p.ws + SSQA_OFF); float* ssqB = (float*)(p.ws + SSQB_OFF);
  if (gid <= G_MLA_IN && layer > 0) e.rs_in = ssqB;
  if (gid == G_FFN1) e.rs_in = ssqA;
  bf16_t* VT = (bf16_t*)(p.ws + VTB_OFF);
  const float isq = 0.08838834764831845f;
  if (gid == G_HGRN_IN) {
    e.ld = 3072;
    if (nt < 8) { e.mode = EP_SILU; e.scale = isq; e.dcol0 = nt * 128; }
    else if (nt < 16) { e.mode = EP_LOGF; e.dcol0 = nt * 128; }
    else if (nt < 24) { e.mode = EP_VT; e.dst = VT; e.dcol0 = (nt - 16) * 128; }
    else { e.dcol0 = 2048 + (nt - 24) * 128; }
  } else if (gid == G_GLA_IN) {
    e.ld = 2176;
    if (nt < 4) { e.scale = isq; e.dcol0 = nt * 128; }
    else if (nt < 8) { e.dcol0 = nt * 128; }
    else if (nt < 16) { e.mode = EP_VT; e.dst = VT; e.dcol0 = (nt - 8) * 128; }
    else if (nt < 24) { e.dcol0 = 1024 + (nt - 16) * 128; }
    else if (nt == 24) { e.dcol0 = 2048; }
    else { e.mode = EP_NONE; }
  } else if (gid == G_RET_IN) {
    e.ld = 4160;
    if (nt < 8) { e.mode = EP_ROPE; e.dcol0 = nt * 128; }
    else if (nt < 16) { e.mode = EP_ROPE; e.scale = isq; e.dcol0 = nt * 128; }
    else if (nt < 32) { e.mode = EP_VT; e.dst = VT; e.dcol0 = (nt - 16) * 128; }
    else { e.dcol0 = 2048 + (nt - 32) * 128; }
  } else if (gid == G_MLA_IN) {
    e.ld = 640; e.dcol0 = nt * 128; if (nt >= 5) e.mode = EP_NONE;
  } else if (gid == G_MLA_Q) {
    e.dst = (bf16_t*)(p.ws + PB_OFF + 20 * MiB); e.ld = 1536; e.dcol0 = nt * 128;
  } else if (gid == G_MLA_KV) {
    if (nt & 1) { e.mode = EP_VT; e.dst = VT; e.dcol0 = (nt >> 1) * 128; }
    else { e.dst = (bf16_t*)(p.ws + PB_OFF + 68 * MiB); e.ld = 1024; e.dcol0 = (nt >> 1) * 128; }
  } else if (gid == G_OUT) {
    e.mode = EP_RESID; e.xin = (layer == 0) ? p.x : p.out; e.xout = p.out; e.dcol0 = nt * 128; e.ssq_out = ssqA; e.gnext = p.norm_ffn + layer * 1024;
  } else if (gid == G_FFN1) {
    e.mode = EP_SWIGLU; e.ld = 2816; e.dcol0 = nt * 64;
  } else {
    e.mode = EP_RESID; e.xin = p.out; e.xout = p.out; e.dcol0 = nt * 128; if (layer < 3) { e.ssq_out = ssqB; e.gnext = p.norm_mix + (layer + 1) * 1024; }
  }
  return e;
}

DI void gemm_tile(const Params& p, const bf16_t* __restrict__ A, int lda, const bf16_t* __restrict__ W, int K, int gid, int mt, int nt, int layer, char* smem) {
  const int gt = gtid_(), wave = gt >> 6, lane = gt & 63, r = lane & 31, h = lane >> 5, wr = wave >> 2, wc = wave & 3, grp = wc >> 1, wcl = wc & 1;
  const Epi e = get_epi(p, gid, nt * 2 + grp, layer);
  const bool swapped = (e.mode == EP_VT);
  const int nk = K >> 5;
  f32x16 acc[4][2];
#pragma unroll
  for (int a = 0; a < 4; ++a)
#pragma unroll
    for (int b = 0; b < 2; ++b) acc[a][b] = zero16();
  const int lrow = lane >> 2, lch = (lane & 3) ^ (lrow >> 2);
  const bf16_t* Ag = A + (size_t)(mt * 256 + 32 * wave + lrow) * lda + lch * 8;
  const bf16_t* Wg = W + (size_t)(nt * 256 + 32 * wave + lrow) * K + lch * 8;
  const unsigned a16 = (unsigned)(16 * lda), w16 = (unsigned)(16 * K);
  char* ldsw = smem + (32 * wave) * 64;
#define G_ISSUE(KT) { char* st_ = ldsw + ((KT) & 3) * 32768; const unsigned ko_ = (unsigned)((KT) * 32); \
    __builtin_amdgcn_global_load_lds((const unsigned*)(Ag + ko_), (unsigned*)(st_), 16, 0, 0); \
    __builtin_amdgcn_global_load_lds((const unsigned*)(Ag + a16 + ko_), (unsigned*)(st_ + 1024), 16, 0, 0); \
    __builtin_amdgcn_global_load_lds((const unsigned*)(Wg + ko_), (unsigned*)(st_ + 16384), 16, 0, 0); \
    __builtin_amdgcn_global_load_lds((const unsigned*)(Wg + w16 + ko_), (unsigned*)(st_ + 16384 + 1024), 16, 0, 0); }
#define RAW_BARRIER() { asm volatile("s_waitcnt lgkmcnt(0)" ::: "memory"); __builtin_amdgcn_s_barrier(); asm volatile("" ::: "memory"); }
  const int sw = (r >> 2) & 3;
  const int xo0 = ((0 + h) ^ sw) * 16, xo1 = ((2 + h) ^ sw) * 16;
  const char* Afr = smem + (wr * 128 + r) * 64;
  const char* Bfr = smem + 16384 + (grp * 128 + wcl * 32 + r) * 64;
  RAW_BARRIER();
  G_ISSUE(0); G_ISSUE(1); G_ISSUE(2);
  for (int kt = 0; kt < nk; ++kt) {
    asm volatile("s_waitcnt vmcnt(8)" ::: "memory");
    RAW_BARRIER();
    const char* Ab = Afr + (kt & 3) * 32768; const char* Bb = Bfr + (kt & 3) * 32768;
    bf16x8 fa[2][4], fb[2][2];
#pragma unroll
    for (int ks = 0; ks < 2; ++ks) {
      const int xo = ks ? xo1 : xo0;
      fb[ks][0] = *(const bf16x8*)(Bb + xo); fb[ks][1] = *(const bf16x8*)(Bb + 64 * 64 + xo);
#pragma unroll
      for (int a = 0; a < 4; ++a) fa[ks][a] = *(const bf16x8*)(Ab + a * 32 * 64 + xo);
    }
    const int ktn = (kt + 3 < nk) ? kt + 3 : nk - 1;
    char* st_ = ldsw + ((kt + 3) & 3) * 32768; const unsigned ko_ = (unsigned)(ktn * 32);
#define MMN(ks, a) { acc[a][0] = MFMA(fb[ks][0], fa[ks][a], acc[a][0]); acc[a][1] = MFMA(fb[ks][1], fa[ks][a], acc[a][1]); }
#define SB() __builtin_amdgcn_sched_barrier(0)
#define SEQ(MM) { MM(0, 0); MM(0, 1); SB(); \
    __builtin_amdgcn_global_load_lds((const unsigned*)(Ag + ko_), (unsigned*)(st_), 16, 0, 0); \
    SB(); MM(0, 2); MM(0, 3); SB(); \
    __builtin_amdgcn_global_load_lds((const unsigned*)(Ag + a16 + ko_), (unsigned*)(st_ + 1024), 16, 0, 0); \
    SB(); MM(1, 0); MM(1, 1); SB(); \
    __builtin_amdgcn_global_load_lds((const unsigned*)(Wg + ko_), (unsigned*)(st_ + 16384), 16, 0, 0); \
    SB(); MM(1, 2); MM(1, 3); SB(); \
    __builtin_amdgcn_global_load_lds((const unsigned*)(Wg + w16 + ko_), (unsigned*)(st_ + 16384 + 1024), 16, 0, 0); \
    SB(); }
    SEQ(MMN)
#undef MMN
#undef SEQ
#undef SB
  }
  asm volatile("s_waitcnt vmcnt(0)" ::: "memory");
  RAW_BARRIER();
#undef G_ISSUE
#undef RAW_BARRIER
  const int rowbase = mt * 256 + wr * 128;
  if (e.mode == EP_NONE) return;
  char* wl = smem + wave * 18432;
#define WAVE_SYNC() { asm volatile("" ::: "memory"); __builtin_amdgcn_wave_barrier(); asm volatile("s_waitcnt lgkmcnt(0)" ::: "memory"); }
  if (e.rs_in) {
#pragma unroll
    for (int a = 0; a < 4; ++a) {
      const float rs = rsqrtf(e.rs_in[rowbase + 32 * a + r] * (1.0f / 1024.0f) + 1e-6f);
#pragma unroll
      for (int i = 0; i < 16; ++i) { acc[a][0][i] *= rs; acc[a][1][i] *= rs; }
    }
  }
  const int c0 = 4 * h;
  if (e.mode == EP_VT) {
    bf16_t* St = (bf16_t*)wl;
#pragma unroll
    for (int a = 0; a < 4; ++a)
#pragma unroll
      for (int b = 0; b < 2; ++b)
#pragma unroll
        for (int i = 0; i < 16; ++i) St[(32 * b + crow(i, h)) * 136 + 32 * a + r] = f2bf(acc[a][b][i]);
    WAVE_SYNC();
#pragma unroll
    for (int j = 0; j < 16; ++j) {
      const int id = lane + 64 * j, nl = id >> 4, ch = id & 15;
      const int n = 32 * wcl + 64 * (nl >> 5) + (nl & 31);
      *(u32x4*)(e.dst + (unsigned)((e.dcol0 + n) * VTS + rowbase + ch * 8)) = *(const u32x4*)(St + nl * 136 + ch * 8);
    }
    return;
  }
  if (e.mode == EP_RESID) {
    float* St = (float*)wl;
#pragma unroll
    for (int ps = 0; ps < 2; ++ps) {
#pragma unroll
      for (int a2 = 0; a2 < 2; ++a2)
#pragma unroll
        for (int b = 0; b < 2; ++b)
#pragma unroll
          for (int g = 0; g < 4; ++g) {
            f32x4 v; v.x = acc[2 * ps + a2][b][4 * g]; v.y = acc[2 * ps + a2][b][4 * g + 1]; v.z = acc[2 * ps + a2][b][4 * g + 2]; v.w = acc[2 * ps + a2][b][4 * g + 3];
            *(f32x4*)(St + (32 * a2 + r) * 68 + 32 * b + 8 * g + c0) = v;
          }
      WAVE_SYNC();
      const int pc = lane & 15, piece = pc >> 3, c4 = pc & 7, colx = e.dcol0 + 32 * wcl + 64 * piece + c4 * 4;
      f32x4 g4 = {1.f, 1.f, 1.f, 1.f};
      if (e.ssq_out) g4 = *(const f32x4*)(e.gnext + colx);
#pragma unroll
      for (int j = 0; j < 16; ++j) {
        const int id = lane + 64 * j, rw = id >> 4;
        const unsigned off = (unsigned)((rowbase + 64 * ps + rw) * 1024 + colx);
        const f32x4 xv = *(const f32x4*)(e.xin + off);
        const f32x4 av = *(const f32x4*)(St + rw * 68 + piece * 32 + c4 * 4);
        const f32x4 xn = xv + av;
        *(f32x4*)(e.xout + off) = xn;
        if (e.ssq_out) {
          u32x2 hb; hb.x = pack2(xn.x * g4.x, xn.y * g4.y); hb.y = pack2(xn.z * g4.z, xn.w * g4.w);
          *(u32x2*)((bf16_t*)(p.ws + HB_OFF) + off) = hb;
          float sq = xn.x * xn.x + xn.y * xn.y + xn.z * xn.z + xn.w * xn.w;
          sq += __shfl_xor(sq, 1); sq += __shfl_xor(sq, 2); sq += __shfl_xor(sq, 4); sq += __shfl_xor(sq, 8);
          if ((lane & 15) == 0) atomicAdd(e.ssq_out + (rowbase + 64 * ps + rw), sq);
        }
      }
      WAVE_SYNC();
    }
    return;
  }
  if (e.mode == EP_SWIGLU) {
    bf16_t* St = (bf16_t*)wl;
#pragma unroll
    for (int a = 0; a < 4; ++a)
#pragma unroll
      for (int g = 0; g < 4; ++g) {
        u32x2 o;
        o.x = pack2(siluf_(acc[a][0][4 * g]) * acc[a][1][4 * g], siluf_(acc[a][0][4 * g + 1]) * acc[a][1][4 * g + 1]);
        o.y = pack2(siluf_(acc[a][0][4 * g + 2]) * acc[a][1][4 * g + 2], siluf_(acc[a][0][4 * g + 3]) * acc[a][1][4 * g + 3]);
        *(u32x2*)(St + (32 * a + r) * 40 + 8 * g + c0) = o;
      }
    WAVE_SYNC();
#pragma unroll
    for (int j = 0; j < 8; ++j) {
      const int id = lane + 64 * j, rw = id >> 2, c4 = id & 3;
      *(u32x4*)(e.dst + (unsigned)((rowbase + rw) * 2816 + e.dcol0 + 32 * wcl + c4 * 8)) = *(const u32x4*)(St + rw * 40 + c4 * 8);
    }
    return;
  }
  bf16_t* St = (bf16_t*)wl;
  if (e.mode == EP_ROPE) {
    const float* ct = (const float*)(p.ws + TABR_OFF); const float* st = ct + (size_t)S * 64;
#pragma unroll
    for (int a = 0; a < 4; ++a)
#pragma unroll
      for (int g = 0; g < 4; ++g) {
        const unsigned ti = (unsigned)((rowbase + 32 * a + r) * 64 + 32 * wcl + 8 * g + c0);
        const f32x4 c = *(const f32x4*)(ct + ti), sn = *(const f32x4*)(st + ti);
        const float x10 = acc[a][0][4 * g], x11 = acc[a][0][4 * g + 1], x12 = acc[a][0][4 * g + 2], x13 = acc[a][0][4 * g + 3];
        const float x20 = acc[a][1][4 * g], x21 = acc[a][1][4 * g + 1], x22 = acc[a][1][4 * g + 2], x23 = acc[a][1][4 * g + 3];
        u32x2 o1, o2;
        o1.x = pack2((x10 * c.x - x20 * sn.x) * e.scale, (x11 * c.y - x21 * sn.y) * e.scale); o1.y = pack2((x12 * c.z - x22 * sn.z) * e.scale, (x13 * c.w - x23 * sn.w) * e.scale);
        o2.x = pack2((x20 * c.x + x10 * sn.x) * e.scale, (x21 * c.y + x11 * sn.y) * e.scale); o2.y = pack2((x22 * c.z + x12 * sn.z) * e.scale, (x23 * c.w + x13 * sn.w) * e.scale);
        *(u32x2*)(St + (32 * a + r) * 72 + 8 * g + c0) = o1;
        *(u32x2*)(St + (32 * a + r) * 72 + 32 + 8 * g + c0) = o2;
      }
  } else {
#pragma unroll
    for (int b = 0; b < 2; ++b)
#pragma unroll
      for (int g = 0; g < 4; ++g) {
        f32x4 lbv = {0.f, 0.f, 0.f, 0.f};
        if (e.mode == EP_LOGF) lbv = *(const f32x4*)((const float*)(p.ws + LB_OFF) + (e.dcol0 - 1024 + 32 * wcl + 64 * b + 8 * g + c0));
#pragma unroll
        for (int a = 0; a < 4; ++a) {
          float v0 = acc[a][b][4 * g], v1 = acc[a][b][4 * g + 1], v2 = acc[a][b][4 * g + 2], v3 = acc[a][b][4 * g + 3];
          if (e.mode == EP_SILU) { v0 = siluf_(v0) * e.scale; v1 = siluf_(v1) * e.scale; v2 = siluf_(v2) * e.scale; v3 = siluf_(v3) * e.scale; }
          else if (e.mode == EP_LOGF) {
            v0 = __logf(lbv.x + (1.f - lbv.x) * sigmoidf_(v0)); v1 = __logf(lbv.y + (1.f - lbv.y) * sigmoidf_(v1));
            v2 = __logf(lbv.z + (1.f - lbv.z) * sigmoidf_(v2)); v3 = __logf(lbv.w + (1.f - lbv.w) * sigmoidf_(v3));
          } else { v0 *= e.scale; v1 *= e.scale; v2 *= e.scale; v3 *= e.scale; }
          u32x2 o; o.x = pack2(v0, v1); o.y = pack2(v2, v3);
          *(u32x2*)(St + (32 * a + r) * 72 + 32 * b + 8 * g + c0) = o;
        }
      }
  }
  WAVE_SYNC();
#pragma unroll
  for (int j = 0; j < 16; ++j) {
    const int id = lane + 64 * j, rw = id >> 3, pc = id & 7, piece = pc >> 2, c4 = pc & 3;
    *(u32x4*)(e.dst + (unsigned)((rowbase + rw) * e.ld + e.dcol0 + 32 * wcl + 64 * piece + c4 * 8)) = *(const u32x4*)(St + rw * 72 + piece * 32 + c4 * 8);
  }
#undef WAVE_SYNC
}

struct ScanDesc {
  const bf16_t* q; const bf16_t* k; const bf16_t* g; int ldp, ldg;
  bf16_t* gate;
  const float* gnorm;
  int mode;
  int H0, Hg, dv;
};
DI float ret_lg(int hh) { return __logf(1.0f - exp2f(-5.0f - (float)hh)); }

DI void scan1_run(const Params& p, const ScanDesc& d, int n, char* smem) {
  bf16_t* Gs = (bf16_t*)smem;
  bf16_t* Kr = (bf16_t*)(smem + 16384);
  bf16_t* KmT = (bf16_t*)(smem + 32768);
  bf16_t* VTs = (bf16_t*)(smem + 51200);
  float* tot = (float*)(smem + 69632);
  float* fac = (float*)(smem + 70656);
  const int ndvb = d.dv >> 7;
  const int G = VG_(), B = VB_();
  const int tid = tid_(), kk = tid & 127, half = tid >> 7;
  const int wave = tid >> 6, lane = tid & 63, r = lane & 31, h = lane >> 5;
  const bf16_t* VT = (const bf16_t*)(p.ws + VTB_OFF);
  u32x4 pg[4], pk[4], pv[4];
#define S1_ISSUE(U) { const int dvb_ = (U) % ndvb, hl_ = ((U) / ndvb) % d.Hg, c_ = (U) / (ndvb * d.Hg), hh_ = d.H0 + hl_, row0_ = c_ * 64; \
    _Pragma("unroll") for (int i = 0; i < 4; ++i) { const int id = tid + 256 * i, rw = id >> 4, ch = id & 15; \
      if (d.mode != 2) pg[i] = *(const u32x4*)(d.g + (size_t)(row0_ + rw) * d.ldg + hh_ * 128 + ch * 8); \
      if (d.mode != 0) pk[i] = *(const u32x4*)(d.k + (size_t)(row0_ + rw) * d.ldp + hh_ * 128 + ch * 8); \
      const int v = id >> 3, c8 = id & 7; \
      pv[i] = *(const u32x4*)(VT + (size_t)(hh_ * d.dv + dvb_ * 128 + v) * VTS + row0_ + c8 * 8); } }
  { int u = B; if (u >= n) u = n - 1; S1_ISSUE(u); }
  for (int u0 = 0; u0 < n; u0 += G) {
    int unit = u0 + B; if (unit >= n) unit = n - 1;
    const int dvb = unit % ndvb, hl = (unit / ndvb) % d.Hg, c = unit / (ndvb * d.Hg);
    const int hh = d.H0 + hl;
#pragma unroll
    for (int i = 0; i < 4; ++i) {
      const int id = tid + 256 * i, rw = id >> 4, ch = id & 15;
      if (d.mode != 2) *(u32x4*)(Gs + rw * 128 + ch * 8) = pg[i];
      if (d.mode != 0) *(u32x4*)(Kr + rw * 128 + ch * 8) = pk[i];
      const int v = id >> 3, c8 = id & 7;
      *(u32x4*)(VTs + v * 72 + c8 * 8) = pv[i];
    }
    __syncthreads();
    if (u0 + G < n) { int un = u0 + G + B; if (un >= n) un = n - 1; S1_ISSUE(un); }
    float gv[32];
    float tsum = 0.f;
    if (d.mode == 2) { const float lg = ret_lg(hh);
#pragma unroll
      for (int j = 0; j < 32; ++j) gv[j] = lg;
      tsum = 32.f * lg;
    } else {
#pragma unroll
      for (int j = 0; j < 32; ++j) { gv[j] = bf2f(Gs[(32 * half + j) * 128 + kk]); tsum += gv[j]; }
    }
    tot[half * 128 + kk] = tsum;
    __syncthreads();
    const float cum31 = tot[kk], last = cum31 + tot[128 + kk];
    if (half == 0) {
      fac[kk] = __expf(clampe(last - cum31));
      if (dvb == 0) ((float*)(p.ws + DB_OFF))[(size_t)(c * d.Hg + hl) * 128 + kk] = __expf(last);
    }
    float crun = half ? cum31 : 0.f;
#pragma unroll
    for (int g8 = 0; g8 < 4; ++g8) {
      float km[8];
#pragma unroll
      for (int j8 = 0; j8 < 8; ++j8) {
        const int j = g8 * 8 + j8;
        crun += gv[j];
        const float kval = (d.mode == 0) ? (1.0f - __expf(gv[j])) : bf2f(Kr[(32 * half + j) * 128 + kk]);
        km[j8] = kval * __expf(clampe(cum31 - crun));
      }
      u32x4 o; o.x = pack2(km[0], km[1]); o.y = pack2(km[2], km[3]); o.z = pack2(km[4], km[5]); o.w = pack2(km[6], km[7]);
      *(u32x4*)(KmT + kk * 72 + 32 * half + 8 * g8) = o;
    }
    __syncthreads();
    f32x16 acc[4];
#pragma unroll
    for (int nn = 0; nn < 4; ++nn) acc[nn] = zero16();
#pragma unroll
    for (int ks = 0; ks < 4; ++ks) {
      const bf16x8 a = *(const bf16x8*)(VTs + (32 * wave + r) * 72 + 16 * ks + 8 * h);
#pragma unroll
      for (int nn = 0; nn < 4; ++nn) {
        const bf16x8 bb = *(const bf16x8*)(KmT + (32 * nn + r) * 72 + 16 * ks + 8 * h);
        acc[nn] = MFMA(a, bb, acc[nn]);
      }
    }
#pragma unroll
    for (int nn = 0; nn < 4; ++nn) {
      const float f = fac[32 * nn + r];
#pragma unroll
      for (int i = 0; i < 16; ++i) Gs[(32 * wave + crow(i, h)) * 128 + 32 * nn + r] = f2bf(acc[nn][i] * f);
    }
    __syncthreads();
    bf16_t* Sb = (bf16_t*)(p.ws + SB_OFF) + ((size_t)(c * d.Hg + hl) * d.dv + dvb * 128) * 128;
#pragma unroll
    for (int i = 0; i < 8; ++i) { const int id = tid + 256 * i; *(u32x4*)(Sb + id * 8) = *(const u32x4*)(Gs + id * 8); }
    __syncthreads();
  }
#undef S1_ISSUE
}

DI void scan2_phase(const Params& p, const ScanDesc& d, bool live) {
  bf16_t* Sb = (bf16_t*)(p.ws + SB_OFF);
  const float* Db = (const float*)(p.ws + DB_OFF);
  const int per_c = d.Hg * d.dv * 128;
  const int n8 = per_c >> 3;
  const int tid = tid_();
  if (tid >= 32) return;
  for (int e8 = VB_() * 32 + tid; e8 < n8; e8 += VG_() * 32) {
    const int hl = e8 / (d.dv * 16), kk = (e8 & 15) * 8;
    bf16_t* sp = Sb + (size_t)e8 * 8; const float* dp = Db + hl * 128 + kk;
    float r[8];
#pragma unroll
    for (int q = 0; q < 8; ++q) r[q] = 0.f;
    for (int c0 = 0; c0 < 256; c0 += 8) {
      u32x4 L[8]; f32x4 d0[8], d1[8];
#pragma unroll
      for (int j = 0; j < 8; ++j) {
        L[j] = *(const u32x4*)(sp + (size_t)(c0 + j) * per_c);
        d0[j] = *(const f32x4*)(dp + (size_t)(c0 + j) * d.Hg * 128); d1[j] = *(const f32x4*)(dp + (size_t)(c0 + j) * d.Hg * 128 + 4);
      }
#pragma unroll
      for (int j = 0; j < 8; ++j) {
        u32x4 o; o.x = pack2(r[0], r[1]); o.y = pack2(r[2], r[3]); o.z = pack2(r[4], r[5]); o.w = pack2(r[6], r[7]);
        if (live) *(u32x4*)(sp + (size_t)(c0 + j) * per_c) = o;
        r[0] = d0[j].x * r[0] + lo2f(L[j].x); r[1] = d0[j].y * r[1] + hi2f(L[j].x); r[2] = d0[j].z * r[2] + lo2f(L[j].y); r[3] = d0[j].w * r[3] + hi2f(L[j].y);
        r[4] = d1[j].x * r[4] + lo2f(L[j].z); r[5] = d1[j].y * r[5] + hi2f(L[j].z); r[6] = d1[j].z * r[6] + lo2f(L[j].w); r[7] = d1[j].w * r[7] + hi2f(L[j].w);
      }
    }
    if (!live && r[0] == 1.2345e-30f) sp[0] = 0;
  }
}

DI void scan3_unit(const Params& p, const ScanDesc& d, int unit, bool valid, char* smem) {
  bf16_t* Qm = (bf16_t*)smem;
  bf16_t* Km = (bf16_t*)(smem + 17408);
  bf16_t* VTs = Km;
  bf16_t* Pm = (bf16_t*)(smem + 35840);
  bf16_t* Gs = Pm;
  bf16_t* Ss = (bf16_t*)(smem + 45056);
  float* tot = (float*)(smem + 63488);
  float* e31 = (float*)(smem + 64512);
  float* red = (float*)(smem + 65024);
  const int hl = unit % d.Hg, c = unit / d.Hg;
  const int hh = d.H0 + hl, row0 = c * 64;
  const int tid = tid_(), kk = tid & 127, half = tid >> 7;
  const int wave = tid >> 6, lane = tid & 63, r = lane & 31, h = lane >> 5;
#pragma unroll
  for (int i = 0; i < 4; ++i) {
    const int id = tid + 256 * i, rw = id >> 4, ch = id & 15;
    if (d.mode != 2) *(u32x4*)(Gs + rw * 128 + ch * 8) = *(const u32x4*)(d.g + (size_t)(row0 + rw) * d.ldg + hh * 128 + ch * 8);
    if (d.mode != 0) *(u32x4*)(Km + rw * 136 + ch * 8) = *(const u32x4*)(d.k + (size_t)(row0 + rw) * d.ldp + hh * 128 + ch * 8);
    *(u32x4*)(Qm + rw * 136 + ch * 8) = *(const u32x4*)(d.q + (size_t)(row0 + rw) * d.ldp + hh * 128 + ch * 8);
  }
  __syncthreads();
  {
    float gv[32];
    float tsum = 0.f;
    if (d.mode == 2) { const float lg = ret_lg(hh);
#pragma unroll
      for (int j = 0; j < 32; ++j) gv[j] = lg;
      tsum = 32.f * lg;
    } else {
#pragma unroll
      for (int j = 0; j < 32; ++j) { gv[j] = bf2f(Gs[(32 * half + j) * 128 + kk]); tsum += gv[j]; }
    }
    tot[half * 128 + kk] = tsum;
    __syncthreads();
    const float cum31 = tot[kk];
    if (half == 0) e31[kk] = __expf(cum31);
    float crun = half ? cum31 : 0.f;
#pragma unroll
    for (int j = 0; j < 32; ++j) {
      crun += gv[j];
      const float e = clampe(crun - cum31);
      const int idx = (32 * half + j) * 136 + kk;
      const float kval = (d.mode == 0) ? (1.0f - __expf(gv[j])) : bf2f(Km[idx]);
      const float qval = bf2f(Qm[idx]);
      Qm[idx] = f2bf(qval * __expf(e));
      Km[idx] = f2bf(kval * __expf(-e));
    }
  }
  __syncthreads();
  if (wave < 3) {
    const int I = (wave >= 1), J = (wave == 2);
    f32x16 sc = zero16();
#pragma unroll
    for (int ks = 0; ks < 8; ++ks) {
      const bf16x8 a = *(const bf16x8*)(Qm + (32 * I + r) * 136 + 16 * ks + 8 * h);
      const bf16x8 b = *(const bf16x8*)(Km + (32 * J + r) * 136 + 16 * ks + 8 * h);
      sc = MFMA(a, b, sc);
    }
#pragma unroll
    for (int i = 0; i < 16; ++i) {
      const int t = crow(i, h);
      float v = sc[i];
      if (I == J) v = (r <= t) ? v : 0.f;
      Pm[(32 * I + t) * 72 + 32 * J + r] = f2bf(v);
    }
  }
  __syncthreads();
  const int ndvb = d.dv >> 7;
  f32x16 acc[2][2];
#pragma unroll
  for (int a = 0; a < 2; ++a)
#pragma unroll
    for (int b = 0; b < 2; ++b) acc[a][b] = zero16();
  const bf16_t* VT = (const bf16_t*)(p.ws + VTB_OFF);
#pragma unroll
  for (int dvb = 0; dvb < 2; ++dvb) {
    if (dvb < ndvb) {
      const bf16_t* Sg = (const bf16_t*)(p.ws + SB_OFF) + ((size_t)(c * d.Hg + hl) * d.dv + dvb * 128) * 128;
#pragma unroll
      for (int i = 0; i < 4; ++i) {
        const int id = tid + 256 * i, v = id >> 3, ch = id & 7;
        *(u32x4*)(VTs + v * 72 + ch * 8) = *(const u32x4*)(VT + (size_t)(hh * d.dv + dvb * 128 + v) * VTS + row0 + ch * 8);
      }
#pragma unroll
      for (int hk = 0; hk < 2; ++hk) {
#pragma unroll
        for (int i = 0; i < 4; ++i) {
          const int id = tid + 256 * i, v = id >> 3, ch = id & 7;
          const u32x4 sv = *(const u32x4*)(Sg + (size_t)v * 128 + hk * 64 + ch * 8);
          const float* ef = e31 + hk * 64 + ch * 8;
          u32x4 o;
          o.x = pack2(lo2f(sv.x) * ef[0], hi2f(sv.x) * ef[1]); o.y = pack2(lo2f(sv.y) * ef[2], hi2f(sv.y) * ef[3]);
          o.z = pack2(lo2f(sv.z) * ef[4], hi2f(sv.z) * ef[5]); o.w = pack2(lo2f(sv.w) * ef[6], hi2f(sv.w) * ef[7]);
          *(u32x4*)(Ss + v * 72 + ch * 8) = o;
        }
        __syncthreads();
#pragma unroll
        for (int mt2 = 0; mt2 < 2; ++mt2) {
          if (hk == 0) {
#pragma unroll
            for (int ks = 0; ks < 4; ++ks) {
              if (mt2 == 1 || ks < 2) {
                const bf16x8 a = *(const bf16x8*)(Pm + (32 * mt2 + r) * 72 + 16 * ks + 8 * h);
                const bf16x8 b = *(const bf16x8*)(VTs + (32 * wave + r) * 72 + 16 * ks + 8 * h);
                acc[dvb][mt2] = MFMA(a, b, acc[dvb][mt2]);
              }
            }
          }
#pragma unroll
          for (int ks = 0; ks < 4; ++ks) {
            const bf16x8 a = *(const bf16x8*)(Qm + (32 * mt2 + r) * 136 + hk * 64 + 16 * ks + 8 * h);
            const bf16x8 b = *(const bf16x8*)(Ss + (32 * wave + r) * 72 + 16 * ks + 8 * h);
            acc[dvb][mt2] = MFMA(a, b, acc[dvb][mt2]);
          }
        }
        __syncthreads();
      }
    }
  }
#pragma unroll
  for (int mt2 = 0; mt2 < 2; ++mt2)
#pragma unroll
    for (int i = 0; i < 16; ++i) {
      float ssq = acc[0][mt2][i] * acc[0][mt2][i];
      if (ndvb == 2) ssq += acc[1][mt2][i] * acc[1][mt2][i];
      ssq += __shfl_xor(ssq, 16); ssq += __shfl_xor(ssq, 8); ssq += __shfl_xor(ssq, 4); ssq += __shfl_xor(ssq, 2); ssq += __shfl_xor(ssq, 1);
      if (r == 0) red[wave * 64 + 32 * mt2 + crow(i, h)] = ssq;
    }
  __syncthreads();
  const float invdv = 1.0f / (float)d.dv;
  bf16_t* Ot = Qm;
#pragma unroll
  for (int dvb = 0; dvb < 2; ++dvb) {
    if (dvb < ndvb) {
      const int v = dvb * 128 + 32 * wave + r;
      const float gn = d.gnorm ? d.gnorm[v] : 1.0f;
#pragma unroll
      for (int mt2 = 0; mt2 < 2; ++mt2)
#pragma unroll
        for (int i = 0; i < 16; ++i) {
          const int t = 32 * mt2 + crow(i, h);
          const float tsq = red[t] + red[64 + t] + red[128 + t] + red[192 + t];
          const float rstd = rsqrtf(tsq * invdv + 1e-6f);
          Ot[t * 136 + 32 * wave + r] = f2bf(acc[dvb][mt2][i] * rstd * gn);
        }
      __syncthreads();
#pragma unroll
      for (int i = 0; i < 4; ++i) {
        const int id = tid + 256 * i, t = id >> 4, ch = id & 15;
        bf16_t* gp = d.gate + (size_t)(row0 + t) * d.ldp + hh * d.dv + dvb * 128 + ch * 8;
        const u32x4 gt = *(const u32x4*)gp;
        const u32x4 ov = *(const u32x4*)(Ot + t * 136 + ch * 8);
        u32x4 o;
        o.x = pack2(lo2f(ov.x) * siluf_(lo2f(gt.x)), hi2f(ov.x) * siluf_(hi2f(gt.x)));
        o.y = pack2(lo2f(ov.y) * siluf_(lo2f(gt.y)), hi2f(ov.y) * siluf_(hi2f(gt.y)));
        o.z = pack2(lo2f(ov.z) * siluf_(lo2f(gt.z)), hi2f(ov.z) * siluf_(hi2f(gt.z)));
        o.w = pack2(lo2f(ov.w) * siluf_(lo2f(gt.w)), hi2f(ov.w) * siluf_(hi2f(gt.w)));
        if (valid) *(u32x4*)gp = o;
      }
      __syncthreads();
    }
  }
}

DI void gla_gate_phase(const Params& p) {
  const bf16_t* P = (const bf16_t*)(p.ws + PB_OFF);
  bf16_t* G = (bf16_t*)(p.ws + HB_OFF);
  const int tid = tid_();
  float w0[16], w1[16];
#pragma unroll
  for (int j = 0; j < 16; ++j) { w0[j] = p.gla_w_gk_up[j * 512 + 2 * tid]; w1[j] = p.gla_w_gk_up[j * 512 + 2 * tid + 1]; }
  const float b0 = p.gla_b_gk[2 * tid], b1 = p.gla_b_gk[2 * tid + 1];
  for (int row = VB_(); row < S; row += VG_()) {
    const u32x4 g0 = *(const u32x4*)(P + (size_t)row * 2176 + 2048), g1 = *(const u32x4*)(P + (size_t)row * 2176 + 2056);
    float gl[16];
    gl[0] = lo2f(g0.x); gl[1] = hi2f(g0.x); gl[2] = lo2f(g0.y); gl[3] = hi2f(g0.y); gl[4] = lo2f(g0.z); gl[5] = hi2f(g0.z); gl[6] = lo2f(g0.w); gl[7] = hi2f(g0.w);
    gl[8] = lo2f(g1.x); gl[9] = hi2f(g1.x); gl[10] = lo2f(g1.y); gl[11] = hi2f(g1.y); gl[12] = lo2f(g1.z); gl[13] = hi2f(g1.z); gl[14] = lo2f(g1.w); gl[15] = hi2f(g1.w);
    float z0 = b0, z1 = b1;
#pragma unroll
    for (int j = 0; j < 16; ++j) { z0 += gl[j] * w0[j]; z1 += gl[j] * w1[j]; }
    const float l0 = (fminf(z0, 0.f) - __logf(1.0f + __expf(-fabsf(z0)))) * 0.0625f;
    const float l1 = (fminf(z1, 0.f) - __logf(1.0f + __expf(-fabsf(z1)))) * 0.0625f;
    *(unsigned*)(G + (size_t)row * 512 + 2 * tid) = pack2(l0, l1);
  }
}

DI void mla_m1_item(const Params& p, int item, bool live) {
  bf16_t* P1 = (bf16_t*)(p.ws + PB_OFF);
  const int wave = tid_() >> 6, lane = tid_() & 63;
  const int row = item * 4 + wave;
  unsigned* rp = (unsigned*)(P1 + (size_t)row * 640);
  unsigned a[3]; float ss = 0.f;
#pragma unroll
  for (int j = 0; j < 3; ++j) { a[j] = rp[lane + 64 * j]; const float x0 = lo2f(a[j]), x1 = hi2f(a[j]); ss += x0 * x0 + x1 * x1; }
  const unsigned b = rp[192 + lane]; const float y0 = lo2f(b), y1 = hi2f(b);
  float s2 = y0 * y0 + y1 * y1;
  ss = wave_sum(ss); s2 = wave_sum(s2);
  const float r1 = rsqrtf(ss * (1.0f / 384.0f) + 1e-6f), r2 = rsqrtf(s2 * (1.0f / 128.0f) + 1e-6f);
  if (live || r2 == 1.2345e-30f)
#pragma unroll
  for (int j = 0; j < 3; ++j) { const int c = 2 * (lane + 64 * j); rp[lane + 64 * j] = pack2(lo2f(a[j]) * r1 * p.mla_g_q_lora[c], hi2f(a[j]) * r1 * p.mla_g_q_lora[c + 1]); }
  if (live || r1 == 1.2345e-30f) rp[192 + lane] = pack2(y0 * r2 * p.mla_g_kv_lora[2 * lane], y1 * r2 * p.mla_g_kv_lora[2 * lane + 1]);
}
DI void mla_m3_item(const Params& p, int item, bool live, char* sm) {
  const bf16_t* P1 = (const bf16_t*)(p.ws + PB_OFF);
  bf16_t* Q = (bf16_t*)(p.ws + PB_OFF + 20 * MiB);
  const bf16_t* KR = (const bf16_t*)(p.ws + PB_OFF + 68 * MiB);
  bf16_t* KF = (bf16_t*)(p.ws + SB_OFF);
  const float* ct = (const float*)(p.ws + TABM_OFF); const float* st = ct + (size_t)S * 32;
  const int wave = tid_() >> 6, lane = tid_() & 63;
  const int row = item * 4 + wave, j = lane & 31;
  bf16_t* Lq = (bf16_t*)(sm + wave * 8448);
  bf16_t* Lk = Lq + 1536;
  bf16_t* Lo = Lk + 1088;
#define M3_SYNC() { asm volatile("" ::: "memory"); __builtin_amdgcn_wave_barrier(); asm volatile("s_waitcnt lgkmcnt(0)" ::: "memory"); }
#pragma unroll
  for (int i = 0; i < 3; ++i) *(u32x4*)(Lq + (lane + 64 * i) * 8) = *(const u32x4*)(Q + (size_t)row * 1536 + (lane + 64 * i) * 8);
#pragma unroll
  for (int i = 0; i < 2; ++i) *(u32x4*)(Lk + (lane + 64 * i) * 8) = *(const u32x4*)(KR + (size_t)row * 1024 + (lane + 64 * i) * 8);
  if (lane < 8) *(u32x4*)(Lk + 1024 + lane * 8) = *(const u32x4*)(P1 + (size_t)row * 640 + 512 + lane * 8);
  const float c = ct[(size_t)row * 32 + j], s = st[(size_t)row * 32 + j];
  const float sgn = (lane < 32) ? -1.f : 1.f;
  const float qscale = 0.07216878364870322f * 1.4426950408889634f;
  const float gq0 = p.mla_g_qnorm[lane], gq1 = p.mla_g_qnorm[64 + lane], gq2 = p.mla_g_qnorm[128 + lane];
  const float gk0 = p.mla_g_knorm[lane], gk1 = p.mla_g_knorm[64 + lane], gk2 = p.mla_g_knorm[128 + lane];
  M3_SYNC();
  const float kr = bf2f(Lk[1024 + lane]);
#pragma unroll
  for (int hd = 0; hd < 8; ++hd) {
    bf16_t* qp = Lq + hd * 192;
    float v0 = bf2f(qp[lane]), v1 = bf2f(qp[64 + lane]), v2 = bf2f(qp[128 + lane]);
    float ss = wave_sum(v0 * v0 + v1 * v1 + v2 * v2);
    float rs = rsqrtf(ss * (1.0f / 192.0f) + 1e-6f);
    v0 *= rs * gq0; v1 *= rs * gq1; v2 *= rs * gq2;
    float pr = __shfl_xor(v2, 32);
    float o2 = v2 * c + sgn * pr * s;
    qp[lane] = f2bf(v0 * qscale); qp[64 + lane] = f2bf(v1 * qscale); qp[128 + lane] = f2bf(o2 * qscale);
    const bf16_t* kp = Lk + hd * 128;
    float k0 = bf2f(kp[lane]), k1 = bf2f(kp[64 + lane]), k2 = kr;
    ss = wave_sum(k0 * k0 + k1 * k1 + k2 * k2);
    rs = rsqrtf(ss * (1.0f / 192.0f) + 1e-6f);
    k0 *= rs * gk0; k1 *= rs * gk1; k2 *= rs * gk2;
    pr = __shfl_xor(k2, 32);
    o2 = k2 * c + sgn * pr * s;
    bf16_t* ko = Lo + hd * 192;
    ko[lane] = f2bf(k0); ko[64 + lane] = f2bf(k1); ko[128 + lane] = f2bf(o2);
  }
  M3_SYNC();
  if (live || c == 1.2345e-30f) {
#pragma unroll
    for (int i = 0; i < 3; ++i) {
      *(u32x4*)(Q + (size_t)row * 1536 + (lane + 64 * i) * 8) = *(const u32x4*)(Lq + (lane + 64 * i) * 8);
      *(u32x4*)(KF + (size_t)row * 1536 + (lane + 64 * i) * 8) = *(const u32x4*)(Lo + (lane + 64 * i) * 8);
    }
  }
  M3_SYNC();
#undef M3_SYNC
}

DI void attn_unit(const Params& p, int unit, char* smem) {
  bf16_t* Ks = (bf16_t*)smem;
  bf16_t* VTs = (bf16_t*)(smem + 51200);
  const bf16_t* Q = (const bf16_t*)(p.ws + PB_OFF + 20 * MiB);
  const bf16_t* KF = (const bf16_t*)(p.ws + SB_OFF);
  const bf16_t* VT = (const bf16_t*)(p.ws + VTB_OFF);
  bf16_t* AO = (bf16_t*)(p.ws + AO_OFF);
  const int hd = unit & 7, qb = (unit < 256) ? 63 - (unit >> 3) : ((unit - 256) >> 3);
  const int gt = gtid_(), wave = gt >> 6, lane = gt & 63, r = lane & 31, h = lane >> 5;
  const int qrow = qb * 256 + 32 * wave + r;
  bf16x8 qf[12];
#pragma unroll
  for (int ks = 0; ks < 12; ++ks) qf[ks] = *(const bf16x8*)(Q + (size_t)qrow * 1536 + hd * 192 + 16 * ks + 8 * h);
  const int nkt = 4 * qb + 4;
  const int kmax_w = (qb * 256 + 32 * wave + 31) >> 6;
  const int kmask_w = (qb * 256 + 32 * wave) >> 6;
  float m = -1e30f, l = 0.f;
  f32x16 oacc[4];
#pragma unroll
  for (int i = 0; i < 4; ++i) oacc[i] = zero16();
  u32x4 rk[3], rv[2];
  const bf16_t* KFh = KF + hd * 192;
  const bf16_t* VTh = VT + (size_t)(hd * 128) * VTS;
#define A_LOAD(K0) { _Pragma("unroll") for (int i = 0; i < 3; ++i) { const int id = gt + 512 * i, kr = id / 24, ch = id % 24; rk[i] = *(const u32x4*)(KFh + (size_t)((K0) + kr) * 1536 + ch * 8); } \
                     _Pragma("unroll") for (int i = 0; i < 2; ++i) { const int id = gt + 512 * i, v = id >> 3, c8 = id & 7; rv[i] = *(const u32x4*)(VTh + (size_t)v * VTS + (K0) + c8 * 8); } }
#define A_STORE(BUF) { _Pragma("unroll") for (int i = 0; i < 3; ++i) { const int id = gt + 512 * i, kr = id / 24, ch = id % 24; *(u32x4*)(Ks + (BUF) * 12800 + kr * 200 + ch * 8) = rk[i]; } \
                       _Pragma("unroll") for (int i = 0; i < 2; ++i) { const int id = gt + 512 * i, v = id >> 3, c8 = id & 7; *(u32x4*)(VTs + (BUF) * 9216 + v * 72 + c8 * 8) = rv[i]; } }
  A_LOAD(0);
  __syncthreads();
  A_STORE(0);
  __syncthreads();
  for (int kt = 0; kt < nkt; ++kt) {
    const int buf = kt & 1;
    if (kt + 1 < nkt) A_LOAD((kt + 1) * 64);
    if (kt <= kmax_w) {
      const bf16_t* Kb = Ks + buf * 12800; const bf16_t* Vb = VTs + buf * 9216;
      f32x16 sa[2]; sa[0] = zero16(); sa[1] = zero16();
#pragma unroll
      for (int ks = 0; ks < 12; ++ks) {
        const bf16x8 a0 = *(const bf16x8*)(Kb + r * 200 + 16 * ks + 8 * h);
        const bf16x8 a1 = *(const bf16x8*)(Kb + (32 + r) * 200 + 16 * ks + 8 * h);
        sa[0] = MFMA(a0, qf[ks], sa[0]); sa[1] = MFMA(a1, qf[ks], sa[1]);
      }
      if (kt >= kmask_w) {
#pragma unroll
        for (int n = 0; n < 2; ++n)
#pragma unroll
          for (int i = 0; i < 16; ++i) { const int key = kt * 64 + 32 * n + crow(i, h); if (key > qrow) sa[n][i] = -1e30f; }
      }
      float mx = -1e30f;
#pragma unroll
      for (int n = 0; n < 2; ++n)
#pragma unroll
        for (int i = 0; i < 16; ++i) mx = fmaxf(mx, sa[n][i]);
      mx = fmaxf(mx, __shfl_xor(mx, 32));
      const float mnew = fmaxf(m, mx);
      const float alpha = exp2f(m - mnew);
      m = mnew;
      float rsum = 0.f;
#pragma unroll
      for (int n = 0; n < 2; ++n)
#pragma unroll
        for (int i = 0; i < 16; ++i) { const float pv = exp2f(sa[n][i] - mnew); sa[n][i] = pv; rsum += pv; }
      rsum += __shfl_xor(rsum, 32);
      l = l * alpha + rsum;
#pragma unroll
      for (int mt = 0; mt < 4; ++mt) {
        if (__builtin_amdgcn_ballot_w64(alpha != 1.0f) != 0ull) {
#pragma unroll
          for (int i = 0; i < 16; ++i) oacc[mt][i] *= alpha;
        }
      }
      bf16x8 pf[4];
#pragma unroll
      for (int n = 0; n < 2; ++n)
#pragma unroll
        for (int s2 = 0; s2 < 2; ++s2) {
          u32x4 pk;
          pk.x = pack2(sa[n][8 * s2 + 0], sa[n][8 * s2 + 1]); pk.y = pack2(sa[n][8 * s2 + 2], sa[n][8 * s2 + 3]);
          pk.z = pack2(sa[n][8 * s2 + 4], sa[n][8 * s2 + 5]); pk.w = pack2(sa[n][8 * s2 + 6], sa[n][8 * s2 + 7]);
          pf[n * 2 + s2] = __builtin_bit_cast(bf16x8, pk);
        }
#pragma unroll
      for (int mt = 0; mt < 4; ++mt)
#pragma unroll
        for (int f = 0; f < 4; ++f) {
          const bf16_t* vp = Vb + (32 * mt + r) * 72 + 16 * f + 4 * h;
          const u32x2 lo = *(const u32x2*)vp, hi = *(const u32x2*)(vp + 8);
          u32x4 av; av.x = lo.x; av.y = lo.y; av.z = hi.x; av.w = hi.y;
          oacc[mt] = MFMA(__builtin_bit_cast(bf16x8, av), pf[f], oacc[mt]);
        }
    }
    if (kt + 1 < nkt) A_STORE(buf ^ 1);
    __syncthreads();
  }
#undef A_LOAD
#undef A_STORE
  const float inv = 1.0f / l;
#pragma unroll
  for (int mt = 0; mt < 4; ++mt)
#pragma unroll
    for (int g = 0; g < 4; ++g) {
      u32x2 o; o.x = pack2(oacc[mt][4 * g] * inv, oacc[mt][4 * g + 1] * inv); o.y = pack2(oacc[mt][4 * g + 2] * inv, oacc[mt][4 * g + 3] * inv);
      *(u32x2*)(AO + (size_t)qrow * 1024 + hd * 128 + 32 * mt + 8 * g + 4 * h) = o;
    }
}

enum { ST_N1 = 0, ST_IN, ST_GATE, ST_S1, ST_S2, ST_S3, ST_S1B, ST_S2B, ST_S3B, ST_M1, ST_M2, ST_M3, ST_ATT, ST_OUT, ST_N2, ST_F1, ST_F2 };
__device__ __constant__ signed char c_steps[4][13] = {
  { ST_N1, ST_IN, ST_S1, ST_S2, ST_S3, ST_OUT, ST_F1, ST_F2, -1, -1, -1, -1, -1 },
  { ST_IN, ST_GATE, ST_S1, ST_S2, ST_S3, ST_OUT, ST_F1, ST_F2, -1, -1, -1, -1, -1 },
  { ST_IN, ST_S1, ST_S2, ST_S3, ST_S1B, ST_S2B, ST_S3B, ST_OUT, ST_F1, ST_F2, -1, -1, -1 },
  { ST_IN, ST_M1, ST_M2, ST_M3, ST_ATT, ST_OUT, ST_F1, ST_F2, -1, -1, -1, -1, -1 } };
constexpr int N_PHASES = 8 + 8 + 10 + 8;

struct ConvJob { const float* src; int K, N, Np, mode; bf16_t* dst; };
DI int conv_tiles(const ConvJob& j) { return (j.Np >> 6) * (j.K >> 6); }

DI bf16_t* wm_of(const Params& p, int layer) { return (bf16_t*)(p.ws + ((layer & 1) ? WMB_OFF : WM_OFF)); }
DI bool mixer_job(const Params& p, int layer, int j, ConvJob& o) {
  bf16_t* WM = wm_of(p, layer);
  if (layer == 0) {
    if (j == 0) { o = ConvJob{ p.hgrn_w_in, 1024, 4096, 4096, 0, WM }; return true; }
    if (j == 1) { o = ConvJob{ p.hgrn_w_out, 1024, 1024, 1024, 0, WM + 4194304 }; return true; }
  } else if (layer == 1) {
    if (j == 0) { o = ConvJob{ p.gla_w_in, 1024, 3088, 3328, 0, WM }; return true; }
    if (j == 1) { o = ConvJob{ p.gla_w_out, 1024, 1024, 1024, 0, WM + 3407872 }; return true; }
  } else if (layer == 2) {
    if (j == 0) { o = ConvJob{ p.ret_w_in, 1024, 6144, 6144, 0, WM }; return true; }
    if (j == 1) { o = ConvJob{ p.ret_w_out, 2048, 1024, 1024, 0, WM + 6291456 }; return true; }
  } else {
    if (j == 0) { o = ConvJob{ p.mla_w_in, 1024, 576, 768, 0, WM }; return true; }
    if (j == 1) { o = ConvJob{ p.mla_w_uq, 384, 1536, 1536, 0, WM + 786432 }; return true; }
    if (j == 2) { o = ConvJob{ p.mla_w_ukv, 128, 2048, 2048, 0, WM + 1376256 }; return true; }
    if (j == 3) { o = ConvJob{ p.mla_w_out, 1024, 1024, 1024, 0, WM + 1638400 }; return true; }
  }
  return false;
}
DI void run_conv(const ConvJob& job, int& off, char* sm) {
  const int G = VG_(), cnt = conv_tiles(job);
  const int start = (VB_() - (off % G) + G) % G;
  for (int t0 = 0; t0 < cnt; t0 += G) {
    int t = t0 + start; if (t >= cnt) t = cnt - 1;
    conv_tile(job.src, job.K, job.N, job.mode, job.dst, t, sm);
  }
  off += cnt;
}

DI ScanDesc make_scan(const Params& p, int layer, int grp) {
  ScanDesc d;
  bf16_t* P = (bf16_t*)(p.ws + PB_OFF);
  if (layer == 0) { d.q = P; d.k = P; d.g = P + 1024; d.ldp = 3072; d.ldg = 3072; d.gate = P + 2048; d.gnorm = p.hgrn_g_norm; d.mode = 0; d.H0 = 0; d.Hg = 8; d.dv = 128; }
  else if (layer == 1) { d.q = P; d.k = P + 512; d.g = (const bf16_t*)(p.ws + HB_OFF); d.ldp = 2176; d.ldg = 512; d.gate = P + 1024; d.gnorm = p.gla_g_norm; d.mode = 1; d.H0 = 0; d.Hg = 4; d.dv = 256; }
  else { d.q = P; d.k = P + 1024; d.g = P; d.ldp = 4160; d.ldg = 4160; d.gate = P + 2048; d.gnorm = nullptr; d.mode = 2; d.H0 = 4 * grp; d.Hg = 4; d.dv = 256; }
  return d;
}

DI void run_phase(const Params& p, int layer, int step, char* smem, bool live) {
  const int G = VG_(), B = VB_();
  char* sm = smem + (B & 1) * HALF_LDS;
  bf16_t* WM = wm_of(p, layer); bf16_t* WF = (bf16_t*)(p.ws + WF_OFF);
  bf16_t* H = (bf16_t*)(p.ws + HB_OFF); bf16_t* P = (bf16_t*)(p.ws + PB_OFF);
  switch (step) {
    case ST_N1: {
      for (int it = B; it < 4096; it += G) norm_item(p.x, p.norm_mix, H, it);
      for (int it = B; it < 4096; it += G) table_item(p, it);
      for (int it = B; it < 4; it += G) lb_item(p, it);
      { float* z = (float*)(p.ws + SSQA_OFF); for (int i = B * 256 + tid_(); i < 2 * 16384; i += G * 256) z[i] = 0.f; }
      int off = 0;
      for (int j = 0; j < 2; ++j) { ConvJob job; if (mixer_job(p, 0, j, job)) run_conv(job, off, sm); }
    } break;
    case ST_GATE: gla_gate_phase(p); break;
    case ST_S1: case ST_S1B: {
      const ScanDesc d = make_scan(p, layer, step == ST_S1B);
      const int n = 256 * d.Hg * (d.dv >> 7);
      scan1_run(p, d, n, sm);
    } break;
    case ST_S2: case ST_S2B: {
      const ScanDesc d = make_scan(p, layer, step == ST_S2B); scan2_phase(p, d, live);
      if (step == ST_S2) {
        int off = 0;
        { ConvJob job{ p.ffn_w_gate_up + (size_t)layer * 1024 * 5632, 1024, 5632, 5632, 1, WF }; run_conv(job, off, sm); }
        { ConvJob job{ p.ffn_w_down + (size_t)layer * 2816 * 1024, 2816, 1024, 1024, 0, WF + 5767168 }; run_conv(job, off, sm); }
        for (int j = 0; j < 4; ++j) { ConvJob job; if (mixer_job(p, layer + 1, j, job)) run_conv(job, off, sm); }
      }
    } break;
    case ST_S3: case ST_S3B: {
      const ScanDesc d = make_scan(p, layer, step == ST_S3B);
      const int n = 256 * d.Hg;
      for (int u0 = 0; u0 < n; u0 += G) { int u = u0 + B; const bool valid = (u < n) && live; if (u >= n) u = n - 1; scan3_unit(p, d, u, valid, sm); }
    } break;
    case ST_M1: {
      for (int it = B; it < 4096; it += G) mla_m1_item(p, it, live);
      int off = 0;
      { ConvJob job{ p.ffn_w_gate_up + (size_t)layer * 1024 * 5632, 1024, 5632, 5632, 1, WF }; run_conv(job, off, sm); }
      { ConvJob job{ p.ffn_w_down + (size_t)layer * 2816 * 1024, 2816, 1024, 1024, 0, WF + 5767168 }; run_conv(job, off, sm); }
    } break;
    case ST_M3: for (int it = B; it < 4096; it += G) mla_m3_item(p, it, live, sm); break;
    case ST_ATT: for (int u = blockIdx.x; u < 512; u += gridDim.x) attn_unit(p, u, smem); break;
    case ST_IN: case ST_M2: case ST_OUT: case ST_F1: case ST_F2: {
      const bf16_t* A = H; int lda = 1024; const bf16_t* W = WM; int K = 1024, ntn = 4, gid = G_OUT;
      const bf16_t* A2 = H; int lda2 = 0; const bf16_t* W2 = WM; int K2 = 0, ntn2 = 0, gid2 = 0;
      if (step == ST_IN) {
        if (layer == 0) { ntn = 16; gid = G_HGRN_IN; } else if (layer == 1) { ntn = 13; gid = G_GLA_IN; }
        else if (layer == 2) { ntn = 24; gid = G_RET_IN; } else { ntn = 3; gid = G_MLA_IN; }
      } else if (step == ST_M2) {
        A = P; lda = 640; W = WM + 786432; K = 384; ntn = 6; gid = G_MLA_Q;
        A2 = P + 384; lda2 = 640; W2 = WM + 1376256; K2 = 128; ntn2 = 8; gid2 = G_MLA_KV;
      } else if (step == ST_OUT) {
        if (layer == 0) { A = P + 2048; lda = 3072; W = WM + 4194304; }
        else if (layer == 1) { A = P + 1024; lda = 2176; W = WM + 3407872; }
        else if (layer == 2) { A = P + 2048; lda = 4160; W = WM + 6291456; K = 2048; }
        else { A = (const bf16_t*)(p.ws + AO_OFF); W = WM + 1638400; }
      } else if (step == ST_F1) { W = WF; ntn = 22; gid = G_FFN1; }
      else { A = P; lda = 2816; W = WF + 5767168; K = 2816; gid = G_FFN2; }
      if (step == ST_IN && layer > 0) { float* z = (float*)(p.ws + SSQA_OFF); for (int i = blockIdx.x * 512 + gtid_(); i < 16384; i += gridDim.x * 512) z[i] = 0.f; }
      if (step == ST_F1) { float* z = (float*)(p.ws + SSQB_OFF); for (int i = blockIdx.x * 512 + gtid_(); i < 16384; i += gridDim.x * 512) z[i] = 0.f; }
      const int nall = ntn + ntn2, nM = 64, total = nM * nall;
      for (int t = blockIdx.x; t < total; t += gridDim.x) {
        int wg = t; { const int q = total / 8, rr = total % 8, xcd = wg % 8, o = wg / 8; wg = (xcd < rr ? xcd * (q + 1) : rr * (q + 1) + (xcd - rr) * q) + o; }
        const int nig = 8 * nall, g0 = wg / nig, fm = g0 * 8, gsz = (nM - fm) < 8 ? (nM - fm) : 8;
        const int mt = fm + (wg % nig) % gsz; int n = (wg % nig) / gsz;
        const bf16_t* Ax = A; int ldx = lda; const bf16_t* Wx = W; int Kx = K, gx = gid;
        if (n >= ntn) { n -= ntn; Ax = A2; ldx = lda2; Wx = W2; Kx = K2; gx = gid2; }
        gemm_tile(p, Ax, ldx, Wx, Kx, gx, mt, n, layer, smem);
      }
    } break;
    default: break;
  }
}

#define XB_TMO      128
#define XB_XCNT(j)  (256  + 64 * (j))
#define XB_XSUB(j)  (1280 + 64 * (j))
#define XB_XGEN(j)  (2304 + 64 * (j))
#define XB_TOP      3328
#define XB_TOPGEN   3392
#define XCD_BAR_WORDS 3456
#define XB_SPIN_CAP (1u << 18)

__device__ __forceinline__ unsigned xb_ld(unsigned* p)              { return __hip_atomic_load(p, __ATOMIC_RELAXED, __HIP_MEMORY_SCOPE_AGENT); }
__device__ __forceinline__ unsigned xb_add(unsigned* p, unsigned v) { return __hip_atomic_fetch_add(p, v, __ATOMIC_RELAXED, __HIP_MEMORY_SCOPE_AGENT); }
__device__ __forceinline__ unsigned xb_xcc_id() { return (unsigned)__builtin_amdgcn_s_getreg((3 << 11) | 20) & 0xFu; }
#define XB_SPIN(cond, bar) do { unsigned _sp = 0; while (cond) { __builtin_amdgcn_s_sleep(1); \
    if ((++_sp & 255u) == 0u) { if (xb_ld(&(bar)[XB_TMO])) break; if (_sp > XB_SPIN_CAP) { atomicAdd(&(bar)[XB_TMO], 1u); break; } } } } while (0)

struct XcdBarrier {
    unsigned* bar; unsigned x;
    volatile unsigned* st;
};

__device__ __forceinline__ XcdBarrier xcd_barrier_post(unsigned* bar, volatile unsigned* st) {
    XcdBarrier b; b.bar = bar; b.x = xb_xcc_id(); b.st = st;
    if (threadIdx.x == 0) (void)xb_add(&bar[XB_XCNT(b.x)], 1u);
    return b;
}
__device__ __forceinline__ void xcd_barrier_complete(unsigned* bar, unsigned x, unsigned& nloc, unsigned& nx) {
    const unsigned G = gridDim.x * gridDim.y * gridDim.z;
    unsigned sum, cnt, mine, sp = 0u;
    for (;;) {
        sum = 0u; cnt = 0u; mine = 0u;
#pragma unroll
        for (unsigned j = 0; j < 16; ++j) { const unsigned c = xb_ld(&bar[XB_XCNT(j)]); sum += c; cnt += (c > 0u) ? 1u : 0u; mine = (j == x) ? c : mine; }
        if (sum == G) break;
        __builtin_amdgcn_s_sleep(1);
        if ((++sp & 255u) == 0u) { if (xb_ld(&bar[XB_TMO])) break; if (sp > XB_SPIN_CAP) { atomicAdd(&bar[XB_TMO], 1u); break; } }
    }
    nloc = mine > 0u ? mine : 1u; nx = cnt > 0u ? cnt : 1u;
}

__device__ __forceinline__ void xcd_barrier(const XcdBarrier& b) {
    asm volatile("s_waitcnt vmcnt(0)" ::: "memory");
    __syncthreads();
    if (threadIdx.x == 0) {
        unsigned* bar = b.bar;
        __builtin_amdgcn_s_waitcnt(0);
        unsigned nloc = b.st[0], nx = b.st[1];
        if (nloc == 0u) { xcd_barrier_complete(bar, b.x, nloc, nx); b.st[0] = nloc; b.st[1] = nx; }
        const unsigned old = xb_add(&bar[XB_XSUB(b.x)], 1u);
        const unsigned gen = old / nloc;
        if (old + 1u == (gen + 1u) * nloc) {
            __builtin_amdgcn_fence(__ATOMIC_RELEASE, "agent");
            asm volatile("s_waitcnt vmcnt(0)" ::: "memory");
            const unsigned og = xb_add(&bar[XB_TOP], 1u);
            const unsigned tg = og / nx;
            if (og + 1u == (tg + 1u) * nx) xb_add(&bar[XB_TOPGEN], 1u);
            else XB_SPIN(xb_ld(&bar[XB_TOPGEN]) == tg, bar);
            __builtin_amdgcn_fence(__ATOMIC_ACQUIRE, "agent");
            xb_add(&bar[XB_XGEN(b.x)], 1u);
            asm volatile("s_waitcnt vmcnt(0)" ::: "memory");
        } else {
            XB_SPIN(xb_ld(&bar[XB_XGEN(b.x)]) == gen, bar);
            __builtin_amdgcn_fence(__ATOMIC_ACQUIRE, "agent");
            asm volatile("s_waitcnt vmcnt(0)" ::: "memory");
        }
    }
    __syncthreads();
}


DI void grid_barrier(unsigned* ctr, unsigned& epoch) {
  asm volatile("s_waitcnt vmcnt(0)" ::: "memory");
  __syncthreads();
  epoch += gridDim.x;
  if (threadIdx.x < 64) {
    if (threadIdx.x == 0) {
      __builtin_amdgcn_fence(__ATOMIC_RELEASE, "agent");
      asm volatile("s_waitcnt vmcnt(0)" ::: "memory");
      __hip_atomic_fetch_add(ctr, 1u, __ATOMIC_RELAXED, __HIP_MEMORY_SCOPE_AGENT);
      while (__hip_atomic_load(ctr, __ATOMIC_RELAXED, __HIP_MEMORY_SCOPE_AGENT) < epoch) __builtin_amdgcn_s_sleep(1);
    }
    __builtin_amdgcn_fence(__ATOMIC_ACQUIRE, "agent");
    asm volatile("s_waitcnt vmcnt(0)" ::: "memory");
  }
  __syncthreads();
}

__global__ void __launch_bounds__(512) fwd_megakernel(Params p, int ph_lo, int ph_hi) {
  extern __shared__ __attribute__((aligned(16))) char smem[];
  cg::grid_group grid = cg::this_grid();
  volatile unsigned* xst = (volatile unsigned*)(smem + 147456);
  if (threadIdx.x == 0) { xst[0] = 0u; xst[1] = 0u; }
  __syncthreads();
  const XcdBarrier xb = xcd_barrier_post((unsigned*)(p.ws + LB_OFF + 262144), xst);
  int ph = 0;
  for (int layer = 0; layer < 4; ++layer) {
    for (int si = 0; si < 13; ++si) {
      const int step = c_steps[layer][si];
      if (step < 0) break;
      if (ph >= ph_lo && ph < ph_hi) {
        run_phase(p, layer, step, smem, true);
        if (ph + 1 < ph_hi) { if (ph_hi > 1000) grid.sync(); else xcd_barrier(xb); }
      }
      ++ph;
    }
  }
}

extern "C" void kernel_launch(void* const* d_in, const int* in_sizes, int n_in, void* d_out, int out_size, void* d_ws, size_t ws_size, hipStream_t stream) {
  static int grid_blocks = 0;
  Params p{};
  const float** fp = (const float**)&p;
  p.x = (const float*)d_in[0]; p.pos = (const int*)d_in[1];
  for (int i = 2; i < 25; ++i) fp[i] = (const float*)d_in[i];
  p.out = (float*)d_out; p.ws = (char*)d_ws;
  int lo = 0, hi = N_PHASES;
  void* args[] = { &p, &lo, &hi };
  if (!grid_blocks) {
    int dev = 0, cus = 0;
    (void)hipGetDevice(&dev);
    (void)hipDeviceGetAttribute(&cus, hipDeviceAttributeMultiprocessorCount, dev);
    (void)hipFuncSetAttribute((const void*)fwd_megakernel, hipFuncAttributeMaxDynamicSharedMemorySize, LDS_BYTES);
    grid_blocks = cus;
  }
  (void)hipMemsetAsync((char*)d_ws + LB_OFF + 262144, 0, XCD_BAR_WORDS * 4, stream);
  hipError_t e = hipLaunchCooperativeKernel((const void*)fwd_megakernel, dim3(grid_blocks), dim3(NT), args, LDS_BYTES, stream);
  if (e != hipSuccess) fprintf(stderr, "cooperative launch failed: %s (grid %d)\n", hipGetErrorString(e), grid_blocks);
}
```

```cpp
#include <hip/hip_runtime.h>
#include <hip/hip_cooperative_groups.h>
#include <stdint.h>
#include <cstdio>
namespace cg = cooperative_groups;

typedef unsigned short bf16_t;
typedef short bf16x8 __attribute__((ext_vector_type(8)));
typedef float f32x16 __attribute__((ext_vector_type(16)));
typedef float f32x4 __attribute__((ext_vector_type(4)));
typedef float f32x2 __attribute__((ext_vector_type(2)));
typedef unsigned u32x4 __attribute__((ext_vector_type(4)));
typedef unsigned u32x2 __attribute__((ext_vector_type(2)));

#define DI __device__ __forceinline__
#define MFMA(a, b, c) __builtin_amdgcn_mfma_f32_32x32x16_bf16((a), (b), (c), 0, 0, 0)

constexpr int S = 16384;
constexpr int VTS = 16384 + 192;
constexpr int NT = 512;
constexpr int LDS_BYTES = 147456 + 16;
constexpr int HALF_LDS = 73728;
constexpr size_t MiB = 1048576;
constexpr size_t WM_OFF = 0, WF_OFF = 17 * MiB, HB_OFF = 34 * MiB, PB_OFF = 66 * MiB, VTB_OFF = 198 * MiB,
                 SB_OFF = 263 * MiB, DB_OFF = 327 * MiB, TABR_OFF = 328 * MiB, TABM_OFF = 336 * MiB, LB_OFF = 340 * MiB,
                 SSQA_OFF = LB_OFF + 8192, SSQB_OFF = LB_OFF + 8192 + 65536, WMB_OFF = 341 * MiB, AO_OFF = PB_OFF + 100 * MiB;

struct Params {
  const float* x; const int* pos; const float* norm_mix; const float* norm_ffn;
  const float* hgrn_w_in; const float* hgrn_g_norm; const float* hgrn_w_out; const float* hgrn_lb;
  const float* gla_w_in; const float* gla_w_gk_up; const float* gla_b_gk; const float* gla_g_norm; const float* gla_w_out;
  const float* ret_w_in; const float* ret_w_out;
  const float* mla_w_in; const float* mla_g_q_lora; const float* mla_g_kv_lora; const float* mla_w_uq; const float* mla_w_ukv;
  const float* mla_g_qnorm; const float* mla_g_knorm; const float* mla_w_out;
  const float* ffn_w_gate_up; const float* ffn_w_down;
  float* out; char* ws;
};

DI int tid_() { int t = threadIdx.x & 255; asm volatile("" : "+v"(t)); return t; }
DI int gtid_() { int t = threadIdx.x; asm volatile("" : "+v"(t)); return t; }
DI int VB_() { int hv = __builtin_amdgcn_readfirstlane((int)(threadIdx.x >> 8)); asm volatile("" : "+s"(hv)); return blockIdx.x * 2 + hv; }
DI int VG_() { return gridDim.x * 2; }
DI bf16_t f2bf(float x) { unsigned u = __float_as_uint(x); u += 0x7fffu + ((u >> 16) & 1u); return (bf16_t)(u >> 16); }
DI float bf2f(bf16_t b) { return __uint_as_float(((unsigned)b) << 16); }
DI unsigned pack2(float a, float b) { return (unsigned)f2bf(a) | ((unsigned)f2bf(b) << 16); }
DI float lo2f(unsigned u) { return __uint_as_float(u << 16); }
DI float hi2f(unsigned u) { return __uint_as_float(u & 0xffff0000u); }
DI int crow(int i, int h) { return (i & 3) + 8 * (i >> 2) + 4 * h; }
DI float sigmoidf_(float x) { return 1.0f / (1.0f + __expf(-x)); }
DI float siluf_(float x) { return x / (1.0f + __expf(-x)); }
DI float clampe(float e) { return fminf(fmaxf(e, -80.f), 80.f); }
DI float wave_sum(float v) {
#pragma unroll
  for (int o = 1; o < 64; o <<= 1) v += __shfl_xor(v, o);
  return v;
}
DI f32x16 zero16() { f32x16 z; for (int i = 0; i < 16; ++i) z[i] = 0.f; return z; }

DI void conv_tile(const float* __restrict__ src, int K, int N, int mode, bf16_t* __restrict__ dst, int tile, char* smem) {
  float* T = (float*)smem;
  const int nkt = K >> 6, rt = tile / nkt, kt = tile % nkt, tid = tid_();
  const int R0 = rt * 64;
  int n0 = R0;
  if (mode == 1) { const int q = R0 >> 7, t = (R0 & 127) >> 6; n0 = t * 2816 + q * 64; }
#pragma unroll
  for (int i = 0; i < 4; ++i) {
    const int id = tid + 256 * i, kr = id >> 4, c4 = id & 15;
    f32x4 v = {0.f, 0.f, 0.f, 0.f};
    if (n0 + 4 * c4 < N) v = *(const f32x4*)(src + (size_t)(kt * 64 + kr) * N + n0 + 4 * c4);
    *(f32x4*)(T + kr * 68 + 4 * c4) = v;
  }
  __syncthreads();
  const int r = tid >> 2, seg = tid & 3;
  u32x4 o0, o1;
  const float* tp = T + (seg * 16) * 68 + r;
  o0.x = pack2(tp[0 * 68], tp[1 * 68]); o0.y = pack2(tp[2 * 68], tp[3 * 68]); o0.z = pack2(tp[4 * 68], tp[5 * 68]); o0.w = pack2(tp[6 * 68], tp[7 * 68]);
  o1.x = pack2(tp[8 * 68], tp[9 * 68]); o1.y = pack2(tp[10 * 68], tp[11 * 68]); o1.z = pack2(tp[12 * 68], tp[13 * 68]); o1.w = pack2(tp[14 * 68], tp[15 * 68]);
  bf16_t* d = dst + (size_t)(R0 + r) * K + kt * 64 + seg * 16;
  *(u32x4*)d = o0; *(u32x4*)(d + 8) = o1;
  __syncthreads();
}

DI void norm_item(const float* __restrict__ x, const float* __restrict__ gain, bf16_t* __restrict__ H, int item) {
  const int wave = tid_() >> 6, lane = tid_() & 63;
  const int row = item * 4 + wave;
  const f32x4* xr = (const f32x4*)(x + (size_t)row * 1024);
  f32x4 v[4]; float ss = 0.f;
#pragma unroll
  for (int j = 0; j < 4; ++j) { v[j] = xr[lane + 64 * j]; ss += v[j].x * v[j].x + v[j].y * v[j].y + v[j].z * v[j].z + v[j].w * v[j].w; }
  ss = wave_sum(ss);
  const float rstd = rsqrtf(ss * (1.0f / 1024.0f) + 1e-6f);
  const f32x4* g4 = (const f32x4*)gain;
#pragma unroll
  for (int j = 0; j < 4; ++j) {
    const f32x4 g = g4[lane + 64 * j];
    u32x2 o; o.x = pack2(v[j].x * rstd * g.x, v[j].y * rstd * g.y); o.y = pack2(v[j].z * rstd * g.z, v[j].w * rstd * g.w);
    *(u32x2*)(H + (size_t)row * 1024 + 4 * (lane + 64 * j)) = o;
  }
}

DI void sincos_acc(float ang, float& c, float& s) {
  const double x = (double)ang;
  const double q = __builtin_rint(x * 0.63661977236758134308);
  const double y = x - q * 1.57079632679489661923;
  const double y2 = y * y;
  double sp = y * (1.0 + y2 * (-1.0 / 6 + y2 * (1.0 / 120 + y2 * (-1.0 / 5040 + y2 * (1.0 / 362880 + y2 * (-1.0 / 39916800))))));
  double cp = 1.0 + y2 * (-0.5 + y2 * (1.0 / 24 + y2 * (-1.0 / 720 + y2 * (1.0 / 40320 + y2 * (-1.0 / 3628800 + y2 * (1.0 / 479001600))))));
  const int k = ((int)q) & 3;
  double sr, cr;
  if (k == 0) { sr = sp; cr = cp; } else if (k == 1) { sr = cp; cr = -sp; } else if (k == 2) { sr = -sp; cr = -cp; } else { sr = -cp; cr = sp; }
  c = (float)cr; s = (float)sr;
}
DI void table_item(const Params& p, int item) {
  const int row = item * 4 + (tid_() >> 6), j = tid_() & 63;
  const float pf = (float)p.pos[row];
  float* tr = (float*)(p.ws + TABR_OFF); float* tm = (float*)(p.ws + TABM_OFF);
  {
    const float inv = 1.0f / exp2f((float)j * (13.287712379549449f / 64.0f));
    float c, s; sincos_acc(pf * inv, c, s);
    tr[(size_t)row * 64 + j] = c; tr[(size_t)S * 64 + (size_t)row * 64 + j] = s;
  }
  if (j < 32) {
    const float inv = 1.0f / exp2f((float)j * (13.287712379549449f / 32.0f));
    float c, s; sincos_acc(pf * inv, c, s);
    tm[(size_t)row * 32 + j] = c; tm[(size_t)S * 32 + (size_t)row * 32 + j] = s;
  }
}
DI void lb_item(const Params& p, int item) {
  const int c = item * 256 + tid_();
  float l[5], mx = -1e30f;
  for (int j = 0; j < 5; ++j) { l[j] = p.hgrn_lb[j * 1024 + c]; mx = fmaxf(mx, l[j]); }
  float sum = 0.f; for (int j = 0; j < 5; ++j) sum += __expf(l[j] - mx);
  ((float*)(p.ws + LB_OFF))[c] = __expf(l[0] - mx) / sum;
}

enum { EP_BF16 = 0, EP_SILU = 1, EP_LOGF = 2, EP_ROPE = 3, EP_VT = 4, EP_RESID = 5, EP_SWIGLU = 6, EP_NONE = 7 };
enum { G_HGRN_IN = 0, G_GLA_IN, G_RET_IN, G_MLA_IN, G_MLA_Q, G_MLA_KV, G_OUT, G_FFN1, G_FFN2 };
struct Epi { int mode; bf16_t* dst; int ld; int dcol0; float scale; const float* xin; float* xout; const float* rs_in; float* ssq_out; const float* gnext; };

DI Epi get_epi(const Params& p, int gid, int nt, int layer) {
  Epi e; e.mode = EP_BF16; e.dst = (bf16_t*)(p.ws + PB_OFF); e.ld = 0; e.dcol0 = 0; e.scale = 1.f; e.xin = nullptr; e.xout = nullptr; e.rs_in = nullptr; e.ssq_out = nullptr; e.gnext = nullptr;
  float* ssqA = (float*)(p.ws + SSQA_OFF); float* ssqB = (float*)(p.ws + SSQB_OFF);
  if (gid <= G_MLA_IN && layer > 0) e.rs_in = ssqB;
  if (gid == G_FFN1) e.rs_in = ssqA;
  bf16_t* VT = (bf16_t*)(p.ws + VTB_OFF);
  const float isq = 0.08838834764831845f;
  if (gid == G_HGRN_IN) {
    e.ld = 3072;
    if (nt < 8) { e.mode = EP_SILU; e.scale = isq; e.dcol0 = nt * 128; }
    else if (nt < 16) { e.mode = EP_LOGF; e.dcol0 = nt * 128; }
    else if (nt < 24) { e.mode = EP_VT; e.dst = VT; e.dcol0 = (nt - 16) * 128; }
    else { e.dcol0 = 2048 + (nt - 24) * 128; }
  } else if (gid == G_GLA_IN) {
    e.ld = 2176;
    if (nt < 4) { e.scale = isq; e.dcol0 = nt * 128; }
    else if (nt < 8) { e.dcol0 = nt * 128; }
    else if (nt < 16) { e.mode = EP_VT; e.dst = VT; e.dcol0 = (nt - 8) * 128; }
    else if (nt < 24) { e.dcol0 = 1024 + (nt - 16) * 128; }
    else if (nt == 24) { e.dcol0 = 2048; }
    else { e.mode = EP_NONE; }
  } else if (gid == G_RET_IN) {
    e.ld = 4160;
    if (nt < 8) { e.mode = EP_ROPE; e.dcol0 = nt * 128; }
    else if (nt < 16) { e.mode = EP_ROPE; e.scale = isq; e.dcol0 = nt * 128; }
    else if (nt < 32) { e.mode = EP_VT; e.dst = VT; e.dcol0 = (nt - 16) * 128; }
    else { e.dcol0 = 2048 + (nt - 32) * 128; }
  } else if (gid == G_MLA_IN) {
    e.ld = 640; e.dcol0 = nt * 128; if (nt >= 5) e.mode = EP_NONE;
  } else if (gid == G_MLA_Q) {
    e.dst = (bf16_t*)(p.ws + PB_OFF + 20 * MiB); e.ld = 1536; e.dcol0 = nt * 128;
  } else if (gid == G_MLA_KV) {
    if (nt & 1) { e.mode = EP_VT; e.dst = VT; e.dcol0 = (nt >> 1) * 128; }
    else { e.dst = (bf16_t*)(p.ws + PB_OFF + 68 * MiB); e.ld = 1024; e.dcol0 = (nt >> 1) * 128; }
  } else if (gid == G_OUT) {
    e.mode = EP_RESID; e.xin = (layer == 0) ? p.x : p.out; e.xout = p.out; e.dcol0 = nt * 128; e.ssq_out = ssqA; e.gnext = p.norm_ffn + layer * 1024;
  } else if (gid == G_FFN1) {
    e.mode = EP_SWIGLU; e.ld = 2816; e.dcol0 = nt * 64;
  } else {
    e.mode = EP_RESID; e.xin = p.out; e.xout = p.out; e.dcol0 = nt * 128; if (layer < 3) { e.ssq_out = ssqB; e.gnext = p.norm_mix + (layer + 1) * 1024; }
  }
  return e;
}

DI void gemm_tile(const Params& p, const bf16_t* __restrict__ A, int lda, const bf16_t* __restrict__ W, int K, int gid, int mt, int nt, int layer, char* smem) {
  const int gt = gtid_(), wave = gt >> 6, lane = gt & 63, r = lane & 31, h = lane >> 5, wr = wave >> 2, wc = wave & 3, grp = wc >> 1, wcl = wc & 1;
  const Epi e = get_epi(p, gid, nt * 2 + grp, layer);
  const bool swapped = (e.mode == EP_VT);
  const int nk = K >> 5;
  f32x16 acc[4][2];
#pragma unroll
  for (int a = 0; a < 4; ++a)
#pragma unroll
    for (int b = 0; b < 2; ++b) acc[a][b] = zero16();
  const int lrow = lane >> 2, lch = (lane & 3) ^ (lrow >> 2);
  const bf16_t* Ag = A + (size_t)(mt * 256 + 32 * wave + lrow) * lda + lch * 8;
  const bf16_t* Wg = W + (size_t)(nt * 256 + 32 * wave + lrow) * K + lch * 8;
  const unsigned a16 = (unsigned)(16 * lda), w16 = (unsigned)(16 * K);
  char* ldsw = smem + (32 * wave) * 64;
#define G_ISSUE(KT) { char* st_ = ldsw + ((KT) & 3) * 32768; const unsigned ko_ = (unsigned)((KT) * 32); \
    __builtin_amdgcn_global_load_lds((const unsigned*)(Ag + ko_), (unsigned*)(st_), 16, 0, 0); \
    __builtin_amdgcn_global_load_lds((const unsigned*)(Ag + a16 + ko_), (unsigned*)(st_ + 1024), 16, 0, 0); \
    __builtin_amdgcn_global_load_lds((const unsigned*)(Wg + ko_), (unsigned*)(st_ + 16384), 16, 0, 0); \
    __builtin_amdgcn_global_load_lds((const unsigned*)(Wg + w16 + ko_), (unsigned*)(st_ + 16384 + 1024), 16, 0, 0); }
#define RAW_BARRIER() { asm volatile("s_waitcnt lgkmcnt(0)" ::: "memory"); __builtin_amdgcn_s_barrier(); asm volatile("" ::: "memory"); }
  const int sw = (r >> 2) & 3;
  const int xo0 = ((0 + h) ^ sw) * 16, xo1 = ((2 + h) ^ sw) * 16;
  const char* Afr = smem + (wr * 128 + r) * 64;
  const char* Bfr = smem + 16384 + (grp * 128 + wcl * 32 + r) * 64;
  RAW_BARRIER();
  G_ISSUE(0); G_ISSUE(1);
  for (int kt = 0; kt < nk; ++kt) {
    asm volatile("s_waitcnt vmcnt(4)" ::: "memory");
    RAW_BARRIER();
    const char* Ab = Afr + (kt & 3) * 32768; const char* Bb = Bfr + (kt & 3) * 32768;
    bf16x8 fa[2][4], fb[2][2];
#pragma unroll
    for (int ks = 0; ks < 2; ++ks) {
      const int xo = ks ? xo1 : xo0;
      fb[ks][0] = *(const bf16x8*)(Bb + xo); fb[ks][1] = *(const bf16x8*)(Bb + 64 * 64 + xo);
#pragma unroll
      for (int a = 0; a < 4; ++a) fa[ks][a] = *(const bf16x8*)(Ab + a * 32 * 64 + xo);
    }
    const int ktn = (kt + 2 < nk) ? kt + 2 : nk - 1;
    char* st_ = ldsw + ((kt + 2) & 3) * 32768; const unsigned ko_ = (unsigned)(ktn * 32);
#define MMN(ks, a) { acc[a][0] = MFMA(fb[ks][0], fa[ks][a], acc[a][0]); acc[a][1] = MFMA(fb[ks][1], fa[ks][a], acc[a][1]); }
#define SB() __builtin_amdgcn_sched_barrier(0)
#define SEQ(MM) { MM(0, 0); MM(0, 1); SB(); \
    __builtin_amdgcn_global_load_lds((const unsigned*)(Ag + ko_), (unsigned*)(st_), 16, 0, 0); \
    SB(); MM(0, 2); MM(0, 3); SB(); \
    __builtin_amdgcn_global_load_lds((const unsigned*)(Ag + a16 + ko_), (unsigned*)(st_ + 1024), 16, 0, 0); \
    SB(); MM(1, 0); MM(1, 1); SB(); \
    __builtin_amdgcn_global_load_lds((const unsigned*)(Wg + ko_), (unsigned*)(st_ + 16384), 16, 0, 0); \
    SB(); MM(1, 2); MM(1, 3); SB(); \
    __builtin_amdgcn_global_load_lds((const unsigned*)(Wg + w16 + ko_), (unsigned*)(st_ + 16384 + 1024), 16, 0, 0); \
    SB(); }
    SEQ(MMN)
#undef MMN
#undef SEQ
#undef SB
  }
  asm volatile("s_waitcnt vmcnt(0)" ::: "memory");
  RAW_BARRIER();
#undef G_ISSUE
#undef RAW_BARRIER
  const int rowbase = mt * 256 + wr * 128;
  if (e.mode == EP_NONE) return;
  char* wl = smem + wave * 18432;
#define WAVE_SYNC() { asm volatile("" ::: "memory"); __builtin_amdgcn_wave_barrier(); asm volatile("s_waitcnt lgkmcnt(0)" ::: "memory"); }
  if (e.rs_in) {
#pragma unroll
    for (int a = 0; a < 4; ++a) {
      const float rs = rsqrtf(e.rs_in[rowbase + 32 * a + r] * (1.0f / 1024.0f) + 1e-6f);
#pragma unroll
      for (int i = 0; i < 16; ++i) { acc[a][0][i] *= rs; acc[a][1][i] *= rs; }
    }
  }
  const int c0 = 4 * h;
  if (e.mode == EP_VT) {
    bf16_t* St = (bf16_t*)wl;
#pragma unroll
    for (int a = 0; a < 4; ++a)
#pragma unroll
      for (int b = 0; b < 2; ++b)
#pragma unroll
        for (int i = 0; i < 16; ++i) St[(32 * b + crow(i, h)) * 136 + 32 * a + r] = f2bf(acc[a][b][i]);
    WAVE_SYNC();
#pragma unroll
    for (int j = 0; j < 16; ++j) {
      const int id = lane + 64 * j, nl = id >> 4, ch = id & 15;
      const int n = 32 * wcl + 64 * (nl >> 5) + (nl & 31);
      *(u32x4*)(e.dst + (unsigned)((e.dcol0 + n) * VTS + rowbase + ch * 8)) = *(const u32x4*)(St + nl * 136 + ch * 8);
    }
    return;
  }
  if (e.mode == EP_RESID) {
    float* St = (float*)wl;
#pragma unroll
    for (int ps = 0; ps < 2; ++ps) {
#pragma unroll
      for (int a2 = 0; a2 < 2; ++a2)
#pragma unroll
        for (int b = 0; b < 2; ++b)
#pragma unroll
          for (int g = 0; g < 4; ++g) {
            f32x4 v; v.x = acc[2 * ps + a2][b][4 * g]; v.y = acc[2 * ps + a2][b][4 * g + 1]; v.z = acc[2 * ps + a2][b][4 * g + 2]; v.w = acc[2 * ps + a2][b][4 * g + 3];
            *(f32x4*)(St + (32 * a2 + r) * 68 + 32 * b + 8 * g + c0) = v;
          }
      WAVE_SYNC();
      const int pc = lane & 15, piece = pc >> 3, c4 = pc & 7, colx = e.dcol0 + 32 * wcl + 64 * piece + c4 * 4;
      f32x4 g4 = {1.f, 1.f, 1.f, 1.f};
      if (e.ssq_out) g4 = *(const f32x4*)(e.gnext + colx);
#pragma unroll
      for (int j = 0; j < 16; ++j) {
        const int id = lane + 64 * j, rw = id >> 4;
        const unsigned off = (unsigned)((rowbase + 64 * ps + rw) * 1024 + colx);
        const f32x4 xv = *(const f32x4*)(e.xin + off);
        const f32x4 av = *(const f32x4*)(St + rw * 68 + piece * 32 + c4 * 4);
        const f32x4 xn = xv + av;
        *(f32x4*)(e.xout + off) = xn;
        if (e.ssq_out) {
          u32x2 hb; hb.x = pack2(xn.x * g4.x, xn.y * g4.y); hb.y = pack2(xn.z * g4.z, xn.w * g4.w);
          *(u32x2*)((bf16_t*)(p.ws + HB_OFF) + off) = hb;
          float sq = xn.x * xn.x + xn.y * xn.y + xn.z * xn.z + xn.w * xn.w;
          sq += __shfl_xor(sq, 1); sq += __shfl_xor(sq, 2); sq += __shfl_xor(sq, 4); sq += __shfl_xor(sq, 8);
          if ((lane & 15) == 0) atomicAdd(e.ssq_out + (rowbase + 64 * ps + rw), sq);
        }
      }
      WAVE_SYNC();
    }
    return;
  }
  if (e.mode == EP_SWIGLU) {
    bf16_t* St = (bf16_t*)wl;
#pragma unroll
    for (int a = 0; a < 4; ++a)
#pragma unroll
      for (int g = 0; g < 4; ++g) {
        u32x2 o;
        o.x = pack2(siluf_(acc[a][0][4 * g]) * acc[a][1][4 * g], siluf_(acc[a][0][4 * g + 1]) * acc[a][1][4 * g + 1]);
        o.y = pack2(siluf_(acc[a][0][4 * g + 2]) * acc[a][1][4 * g + 2], siluf_(acc[a][0][4 * g + 3]) * acc[a][1][4 * g + 3]);
        *(u32x2*)(St + (32 * a + r) * 40 + 8 * g + c0) = o;
      }
    WAVE_SYNC();
#pragma unroll
    for (int j = 0; j < 8; ++j) {
      const int id = lane + 64 * j, rw = id >> 2, c4 = id & 3;
      *(u32x4*)(e.dst + (unsigned)((rowbase + rw) * 2816 + e.dcol0 + 32 * wcl + c4 * 8)) = *(const u32x4*)(St + rw * 40 + c4 * 8);
    }
    return;
  }
  bf16_t* St = (bf16_t*)wl;
  if (e.mode == EP_ROPE) {
    const float* ct = (const float*)(p.ws + TABR_OFF); const float* st = ct + (size_t)S * 64;
#pragma unroll
    for (int a = 0; a < 4; ++a)
#pragma unroll
      for (int g = 0; g < 4; ++g) {
        const unsigned ti = (unsigned)((rowbase + 32 * a + r) * 64 + 32 * wcl + 8 * g + c0);
        const f32x4 c = *(const f32x4*)(ct + ti), sn = *(const f32x4*)(st + ti);
        const float x10 = acc[a][0][4 * g], x11 = acc[a][0][4 * g + 1], x12 = acc[a][0][4 * g + 2], x13 = acc[a][0][4 * g + 3];
        const float x20 = acc[a][1][4 * g], x21 = acc[a][1][4 * g + 1], x22 = acc[a][1][4 * g + 2], x23 = acc[a][1][4 * g + 3];
        u32x2 o1, o2;
        o1.x = pack2((x10 * c.x - x20 * sn.x) * e.scale, (x11 * c.y - x21 * sn.y) * e.scale); o1.y = pack2((x12 * c.z - x22 * sn.z) * e.scale, (x13 * c.w - x23 * sn.w) * e.scale);
        o2.x = pack2((x20 * c.x + x10 * sn.x) * e.scale, (x21 * c.y + x11 * sn.y) * e.scale); o2.y = pack2((x22 * c.z + x12 * sn.z) * e.scale, (x23 * c.w + x13 * sn.w) * e.scale);
        *(u32x2*)(St + (32 * a + r) * 72 + 8 * g + c0) = o1;
        *(u32x2*)(St + (32 * a + r) * 72 + 32 + 8 * g + c0) = o2;
      }
  } else {
#pragma unroll
    for (int b = 0; b < 2; ++b)
#pragma unroll
      for (int g = 0; g < 4; ++g) {
        f32x4 lbv = {0.f, 0.f, 0.f, 0.f};
        if (e.mode == EP_LOGF) lbv = *(const f32x4*)((const float*)(p.ws + LB_OFF) + (e.dcol0 - 1024 + 32 * wcl + 64 * b + 8 * g + c0));
#pragma unroll
        for (int a = 0; a < 4; ++a) {
          float v0 = acc[a][b][4 * g], v1 = acc[a][b][4 * g + 1], v2 = acc[a][b][4 * g + 2], v3 = acc[a][b][4 * g + 3];
          if (e.mode == EP_SILU) { v0 = siluf_(v0) * e.scale; v1 = siluf_(v1) * e.scale; v2 = siluf_(v2) * e.scale; v3 = siluf_(v3) * e.scale; }
          else if (e.mode == EP_LOGF) {
            v0 = __logf(lbv.x + (1.f - lbv.x) * sigmoidf_(v0)); v1 = __logf(lbv.y + (1.f - lbv.y) * sigmoidf_(v1));
            v2 = __logf(lbv.z + (1.f - lbv.z) * sigmoidf_(v2)); v3 = __logf(lbv.w + (1.f - lbv.w) * sigmoidf_(v3));
          } else { v0 *= e.scale; v1 *= e.scale; v2 *= e.scale; v3 *= e.scale; }
          u32x2 o; o.x = pack2(v0, v1); o.y = pack2(v2, v3);
          *(u32x2*)(St + (32 * a + r) * 72 + 32 * b + 8 * g + c0) = o;
        }
      }
  }
  WAVE_SYNC();
#pragma unroll
  for (int j = 0; j < 16; ++j) {
    const int id = lane + 64 * j, rw = id >> 3, pc = id & 7, piece = pc >> 2, c4 = pc & 3;
    *(u32x4*)(e.dst + (unsigned)((rowbase + rw) * e.ld + e.dcol0 + 32 * wcl + 64 * piece + c4 * 8)) = *(const u32x4*)(St + rw * 72 + piece * 32 + c4 * 8);
  }
#undef WAVE_SYNC
}

struct ScanDesc {
  const bf16_t* q; const bf16_t* k; const bf16_t* g; int ldp, ldg;
  bf16_t* gate;
  const float* gnorm;
  int mode;
  int H0, Hg, dv;
};
DI float ret_lg(int hh) { return __logf(1.0f - exp2f(-5.0f - (float)hh)); }

DI void scan1_run(const Params& p, const ScanDesc& d, int n, char* smem) {
  bf16_t* Gs = (bf16_t*)smem;
  bf16_t* Kr = (bf16_t*)(smem + 16384);
  bf16_t* KmT = (bf16_t*)(smem + 32768);
  bf16_t* VTs = (bf16_t*)(smem + 51200);
  float* tot = (float*)(smem + 69632);
  float* fac = (float*)(smem + 70656);
  const int ndvb = d.dv >> 7;
  const int G = VG_(), B = VB_();
  const int tid = tid_(), kk = tid & 127, half = tid >> 7;
  const int wave = tid >> 6, lane = tid & 63, r = lane & 31, h = lane >> 5;
  const bf16_t* VT = (const bf16_t*)(p.ws + VTB_OFF);
  u32x4 pg[4], pk[4], pv[4];
#define S1_ISSUE(U) { const int dvb_ = (U) % ndvb, hl_ = ((U) / ndvb) % d.Hg, c_ = (U) / (ndvb * d.Hg), hh_ = d.H0 + hl_, row0_ = c_ * 64; \
    _Pragma("unroll") for (int i = 0; i < 4; ++i) { const int id = tid + 256 * i, rw = id >> 4, ch = id & 15; \
      if (d.mode != 2) pg[i] = *(const u32x4*)(d.g + (size_t)(row0_ + rw) * d.ldg + hh_ * 128 + ch * 8); \
      if (d.mode != 0) pk[i] = *(const u32x4*)(d.k + (size_t)(row0_ + rw) * d.ldp + hh_ * 128 + ch * 8); \
      const int v = id >> 3, c8 = id & 7; \
      pv[i] = *(const u32x4*)(VT + (size_t)(hh_ * d.dv + dvb_ * 128 + v) * VTS + row0_ + c8 * 8); } }
  { int u = B; if (u >= n) u = n - 1; S1_ISSUE(u); }
  for (int u0 = 0; u0 < n; u0 += G) {
    int unit = u0 + B; if (unit >= n) unit = n - 1;
    const int dvb = unit % ndvb, hl = (unit / ndvb) % d.Hg, c = unit / (ndvb * d.Hg);
    const int hh = d.H0 + hl;
#pragma unroll
    for (int i = 0; i < 4; ++i) {
      const int id = tid + 256 * i, rw = id >> 4, ch = id & 15;
      if (d.mode != 2) *(u32x4*)(Gs + rw * 128 + ch * 8) = pg[i];
      if (d.mode != 0) *(u32x4*)(Kr + rw * 128 + ch * 8) = pk[i];
      const int v = id >> 3, c8 = id & 7;
      *(u32x4*)(VTs + v * 72 + c8 * 8) = pv[i];
    }
    __syncthreads();
    if (u0 + G < n) { int un = u0 + G + B; if (un >= n) un = n - 1; S1_ISSUE(un); }
    float gv[32];
    float tsum = 0.f;
    if (d.mode == 2) { const float lg = ret_lg(hh);
#pragma unroll
      for (int j = 0; j < 32; ++j) gv[j] = lg;
      tsum = 32.f * lg;
    } else {
#pragma unroll
      for (int j = 0; j < 32; ++j) { gv[j] = bf2f(Gs[(32 * half + j) * 128 + kk]); tsum += gv[j]; }
    }
    tot[half * 128 + kk] = tsum;
    __syncthreads();
    const float cum31 = tot[kk], last = cum31 + tot[128 + kk];
    if (half == 0) {
      fac[kk] = __expf(clampe(last - cum31));
      if (dvb == 0) ((float*)(p.ws + DB_OFF))[(size_t)(c * d.Hg + hl) * 128 + kk] = __expf(last);
    }
    float crun = half ? cum31 : 0.f;
#pragma unroll
    for (int g8 = 0; g8 < 4; ++g8) {
      float km[8];
#pragma unroll
      for (int j8 = 0; j8 < 8; ++j8) {
        const int j = g8 * 8 + j8;
        crun += gv[j];
        const float kval = (d.mode == 0) ? (1.0f - __expf(gv[j])) : bf2f(Kr[(32 * half + j) * 128 + kk]);
        km[j8] = kval * __expf(clampe(cum31 - crun));
      }
      u32x4 o; o.x = pack2(km[0], km[1]); o.y = pack2(km[2], km[3]); o.z = pack2(km[4], km[5]); o.w = pack2(km[6], km[7]);
      *(u32x4*)(KmT + kk * 72 + 32 * half + 8 * g8) = o;
    }
    __syncthreads();
    f32x16 acc[4];
#pragma unroll
    for (int nn = 0; nn < 4; ++nn) acc[nn] = zero16();
#pragma unroll
    for (int ks = 0; ks < 4; ++ks) {
      const bf16x8 a = *(const bf16x8*)(VTs + (32 * wave + r) * 72 + 16 * ks + 8 * h);
#pragma unroll
      for (int nn = 0; nn < 4; ++nn) {
        const bf16x8 bb = *(const bf16x8*)(KmT + (32 * nn + r) * 72 + 16 * ks + 8 * h);
        acc[nn] = MFMA(a, bb, acc[nn]);
      }
    }
#pragma unroll
    for (int nn = 0; nn < 4; ++nn) {
      const float f = fac[32 * nn + r];
#pragma unroll
      for (int i = 0; i < 16; ++i) Gs[(32 * wave + crow(i, h)) * 128 + 32 * nn + r] = f2bf(acc[nn][i] * f);
    }
    __syncthreads();
    bf16_t* Sb = (bf16_t*)(p.ws + SB_OFF) + ((size_t)(c * d.Hg + hl) * d.dv + dvb * 128) * 128;
#pragma unroll
    for (int i = 0; i < 8; ++i) { const int id = tid + 256 * i; *(u32x4*)(Sb + id * 8) = *(const u32x4*)(Gs + id * 8); }
    __syncthreads();
  }
#undef S1_ISSUE
}

DI void scan2_phase(const Params& p, const ScanDesc& d, bool live) {
  bf16_t* Sb = (bf16_t*)(p.ws + SB_OFF);
  const float* Db = (const float*)(p.ws + DB_OFF);
  const int per_c = d.Hg * d.dv * 128;
  const int n8 = per_c >> 3;
  const int tid = tid_();
  if (tid >= 32) return;
  for (int e8 = VB_() * 32 + tid; e8 < n8; e8 += VG_() * 32) {
    const int hl = e8 / (d.dv * 16), kk = (e8 & 15) * 8;
    bf16_t* sp = Sb + (size_t)e8 * 8; const float* dp = Db + hl * 128 + kk;
    float r[8];
#pragma unroll
    for (int q = 0; q < 8; ++q) r[q] = 0.f;
    for (int c0 = 0; c0 < 256; c0 += 8) {
      u32x4 L[8]; f32x4 d0[8], d1[8];
#pragma unroll
      for (int j = 0; j < 8; ++j) {
        L[j] = *(const u32x4*)(sp + (size_t)(c0 + j) * per_c);
        d0[j] = *(const f32x4*)(dp + (size_t)(c0 + j) * d.Hg * 128); d1[j] = *(const f32x4*)(dp + (size_t)(c0 + j) * d.Hg * 128 + 4);
      }
#pragma unroll
      for (int j = 0; j < 8; ++j) {
        u32x4 o; o.x = pack2(r[0], r[1]); o.y = pack2(r[2], r[3]); o.z = pack2(r[4], r[5]); o.w = pack2(r[6], r[7]);
        if (live) *(u32x4*)(sp + (size_t)(c0 + j) * per_c) = o;
        r[0] = d0[j].x * r[0] + lo2f(L[j].x); r[1] = d0[j].y * r[1] + hi2f(L[j].x); r[2] = d0[j].z * r[2] + lo2f(L[j].y); r[3] = d0[j].w * r[3] + hi2f(L[j].y);
        r[4] = d1[j].x * r[4] + lo2f(L[j].z); r[5] = d1[j].y * r[5] + hi2f(L[j].z); r[6] = d1[j].z * r[6] + lo2f(L[j].w); r[7] = d1[j].w * r[7] + hi2f(L[j].w);
      }
    }
    if (!live && r[0] == 1.2345e-30f) sp[0] = 0;
  }
}

DI void scan3_unit(const Params& p, const ScanDesc& d, int unit, bool valid, char* smem) {
  bf16_t* Qm = (bf16_t*)smem;
  bf16_t* Km = (bf16_t*)(smem + 17408);
  bf16_t* VTs = Km;
  bf16_t* Pm = (bf16_t*)(smem + 35840);
  bf16_t* Gs = Pm;
  bf16_t* Ss = (bf16_t*)(smem + 45056);
  float* tot = (float*)(smem + 63488);
  float* e31 = (float*)(smem + 64512);
  float* red = (float*)(smem + 65024);
  const int hl = unit % d.Hg, c = unit / d.Hg;
  const int hh = d.H0 + hl, row0 = c * 64;
  const int tid = tid_(), kk = tid & 127, half = tid >> 7;
  const int wave = tid >> 6, lane = tid & 63, r = lane & 31, h = lane >> 5;
#pragma unroll
  for (int i = 0; i < 4; ++i) {
    const int id = tid + 256 * i, rw = id >> 4, ch = id & 15;
    if (d.mode != 2) *(u32x4*)(Gs + rw * 128 + ch * 8) = *(const u32x4*)(d.g + (size_t)(row0 + rw) * d.ldg + hh * 128 + ch * 8);
    if (d.mode != 0) *(u32x4*)(Km + rw * 136 + ch * 8) = *(const u32x4*)(d.k + (size_t)(row0 + rw) * d.ldp + hh * 128 + ch * 8);
    *(u32x4*)(Qm + rw * 136 + ch * 8) = *(const u32x4*)(d.q + (size_t)(row0 + rw) * d.ldp + hh * 128 + ch * 8);
  }
  __syncthreads();
  {
    float gv[32];
    float tsum = 0.f;
    if (d.mode == 2) { const float lg = ret_lg(hh);
#pragma unroll
      for (int j = 0; j < 32; ++j) gv[j] = lg;
      tsum = 32.f * lg;
    } else {
#pragma unroll
      for (int j = 0; j < 32; ++j) { gv[j] = bf2f(Gs[(32 * half + j) * 128 + kk]); tsum += gv[j]; }
    }
    tot[half * 128 + kk] = tsum;
    __syncthreads();
    const float cum31 = tot[kk];
    if (half == 0) e31[kk] = __expf(cum31);
    float crun = half ? cum31 : 0.f;
#pragma unroll
    for (int j = 0; j < 32; ++j) {
      crun += gv[j];
      const float e = clampe(crun - cum31);
      const int idx = (32 * half + j) * 136 + kk;
      const float kval = (d.mode == 0) ? (1.0f - __expf(gv[j])) : bf2f(Km[idx]);
      const float qval = bf2f(Qm[idx]);
      Qm[idx] = f2bf(qval * __expf(e));
      Km[idx] = f2bf(kval * __expf(-e));
    }
  }
  __syncthreads();
  if (wave < 3) {
    const int I = (wave >= 1), J = (wave == 2);
    f32x16 sc = zero16();
#pragma unroll
    for (int ks = 0; ks < 8; ++ks) {
      const bf16x8 a = *(const bf16x8*)(Qm + (32 * I + r) * 136 + 16 * ks + 8 * h);
      const bf16x8 b = *(const bf16x8*)(Km + (32 * J + r) * 136 + 16 * ks + 8 * h);
      sc = MFMA(a, b, sc);
    }
#pragma unroll
    for (int i = 0; i < 16; ++i) {
      const int t = crow(i, h);
      float v = sc[i];
      if (I == J) v = (r <= t) ? v : 0.f;
      Pm[(32 * I + t) * 72 + 32 * J + r] = f2bf(v);
    }
  }
  __syncthreads();
  const int ndvb = d.dv >> 7;
  f32x16 acc[2][2];
#pragma unroll
  for (int a = 0; a < 2; ++a)
#pragma unroll
    for (int b = 0; b < 2; ++b) acc[a][b] = zero16();
  const bf16_t* VT = (const bf16_t*)(p.ws + VTB_OFF);
#pragma unroll
  for (int dvb = 0; dvb < 2; ++dvb) {
    if (dvb < ndvb) {
      const bf16_t* Sg = (const bf16_t*)(p.ws + SB_OFF) + ((size_t)(c * d.Hg + hl) * d.dv + dvb * 128) * 128;
#pragma unroll
      for (int i = 0; i < 4; ++i) {
        const int id = tid + 256 * i, v = id >> 3, ch = id & 7;
        *(u32x4*)(VTs + v * 72 + ch * 8) = *(const u32x4*)(VT + (size_t)(hh * d.dv + dvb * 128 + v) * VTS + row0 + ch * 8);
      }
#pragma unroll
      for (int hk = 0; hk < 2; ++hk) {
#pragma unroll
        for (int i = 0; i < 4; ++i) {
          const int id = tid + 256 * i, v = id >> 3, ch = id & 7;
          const u32x4 sv = *(const u32x4*)(Sg + (size_t)v * 128 + hk * 64 + ch * 8);
          const float* ef = e31 + hk * 64 + ch * 8;
          u32x4 o;
          o.x = pack2(lo2f(sv.x) * ef[0], hi2f(sv.x) * ef[1]); o.y = pack2(lo2f(sv.y) * ef[2], hi2f(sv.y) * ef[3]);
          o.z = pack2(lo2f(sv.z) * ef[4], hi2f(sv.z) * ef[5]); o.w = pack2(lo2f(sv.w) * ef[6], hi2f(sv.w) * ef[7]);
          *(u32x4*)(Ss + v * 72 + ch * 8) = o;
        }
        __syncthreads();
#pragma unroll
        for (int mt2 = 0; mt2 < 2; ++mt2) {
          if (hk == 0) {
#pragma unroll
            for (int ks = 0; ks < 4; ++ks) {
              if (mt2 == 1 || ks < 2) {
                const bf16x8 a = *(const bf16x8*)(Pm + (32 * mt2 + r) * 72 + 16 * ks + 8 * h);
                const bf16x8 b = *(const bf16x8*)(VTs + (32 * wave + r) * 72 + 16 * ks + 8 * h);
                acc[dvb][mt2] = MFMA(a, b, acc[dvb][mt2]);
              }
            }
          }
#pragma unroll
          for (int ks = 0; ks < 4; ++ks) {
            const bf16x8 a = *(const bf16x8*)(Qm + (32 * mt2 + r) * 136 + hk * 64 + 16 * ks + 8 * h);
            const bf16x8 b = *(const bf16x8*)(Ss + (32 * wave + r) * 72 + 16 * ks + 8 * h);
            acc[dvb][mt2] = MFMA(a, b, acc[dvb][mt2]);
          }
        }
        __syncthreads();
      }
    }
  }
#pragma unroll
  for (int mt2 = 0; mt2 < 2; ++mt2)
#pragma unroll
    for (int i = 0; i < 16; ++i) {
      float ssq = acc[0][mt2][i] * acc[0][mt2][i];
      if (ndvb == 2) ssq += acc[1][mt2][i] * acc[1][mt2][i];
      ssq += __shfl_xor(ssq, 16); ssq += __shfl_xor(ssq, 8); ssq += __shfl_xor(ssq, 4); ssq += __shfl_xor(ssq, 2); ssq += __shfl_xor(ssq, 1);
      if (r == 0) red[wave * 64 + 32 * mt2 + crow(i, h)] = ssq;
    }
  __syncthreads();
  const float invdv = 1.0f / (float)d.dv;
  bf16_t* Ot = Qm;
#pragma unroll
  for (int dvb = 0; dvb < 2; ++dvb) {
    if (dvb < ndvb) {
      const int v = dvb * 128 + 32 * wave + r;
      const float gn = d.gnorm ? d.gnorm[v] : 1.0f;
#pragma unroll
      for (int mt2 = 0; mt2 < 2; ++mt2)
#pragma unroll
        for (int i = 0; i < 16; ++i) {
          const int t = 32 * mt2 + crow(i, h);
          const float tsq = red[t] + red[64 + t] + red[128 + t] + red[192 + t];
          const float rstd = rsqrtf(tsq * invdv + 1e-6f);
          Ot[t * 136 + 32 * wave + r] = f2bf(acc[dvb][mt2][i] * rstd * gn);
        }
      __syncthreads();
#pragma unroll
      for (int i = 0; i < 4; ++i) {
        const int id = tid + 256 * i, t = id >> 4, ch = id & 15;
        bf16_t* gp = d.gate + (size_t)(row0 + t) * d.ldp + hh * d.dv + dvb * 128 + ch * 8;
        const u32x4 gt = *(const u32x4*)gp;
        const u32x4 ov = *(const u32x4*)(Ot + t * 136 + ch * 8);
        u32x4 o;
        o.x = pack2(lo2f(ov.x) * siluf_(lo2f(gt.x)), hi2f(ov.x) * siluf_(hi2f(gt.x)));
        o.y = pack2(lo2f(ov.y) * siluf_(lo2f(gt.y)), hi2f(ov.y) * siluf_(hi2f(gt.y)));
        o.z = pack2(lo2f(ov.z) * siluf_(lo2f(gt.z)), hi2f(ov.z) * siluf_(hi2f(gt.z)));
        o.w = pack2(lo2f(ov.w) * siluf_(lo2f(gt.w)), hi2f(ov.w) * siluf_(hi2f(gt.w)));
        if (valid) *(u32x4*)gp = o;
      }
      __syncthreads();
    }
  }
}

DI void gla_gate_phase(const Params& p) {
  const bf16_t* P = (const bf16_t*)(p.ws + PB_OFF);
  bf16_t* G = (bf16_t*)(p.ws + HB_OFF);
  const int tid = tid_();
  float w0[16], w1[16];
#pragma unroll
  for (int j = 0; j < 16; ++j) { w0[j] = p.gla_w_gk_up[j * 512 + 2 * tid]; w1[j] = p.gla_w_gk_up[j * 512 + 2 * tid + 1]; }
  const float b0 = p.gla_b_gk[2 * tid], b1 = p.gla_b_gk[2 * tid + 1];
  for (int row = VB_(); row < S; row += VG_()) {
    const u32x4 g0 = *(const u32x4*)(P + (size_t)row * 2176 + 2048), g1 = *(const u32x4*)(P + (size_t)row * 2176 + 2056);
    float gl[16];
    gl[0] = lo2f(g0.x); gl[1] = hi2f(g0.x); gl[2] = lo2f(g0.y); gl[3] = hi2f(g0.y); gl[4] = lo2f(g0.z); gl[5] = hi2f(g0.z); gl[6] = lo2f(g0.w); gl[7] = hi2f(g0.w);
    gl[8] = lo2f(g1.x); gl[9] = hi2f(g1.x); gl[10] = lo2f(g1.y); gl[11] = hi2f(g1.y); gl[12] = lo2f(g1.z); gl[13] = hi2f(g1.z); gl[14] = lo2f(g1.w); gl[15] = hi2f(g1.w);
    float z0 = b0, z1 = b1;
#pragma unroll
    for (int j = 0; j < 16; ++j) { z0 += gl[j] * w0[j]; z1 += gl[j] * w1[j]; }
    const float l0 = (fminf(z0, 0.f) - __logf(1.0f + __expf(-fabsf(z0)))) * 0.0625f;
    const float l1 = (fminf(z1, 0.f) - __logf(1.0f + __expf(-fabsf(z1)))) * 0.0625f;
    *(unsigned*)(G + (size_t)row * 512 + 2 * tid) = pack2(l0, l1);
  }
}

DI void mla_m1_item(const Params& p, int item, bool live) {
  bf16_t* P1 = (bf16_t*)(p.ws + PB_OFF);
  const int wave = tid_() >> 6, lane = tid_() & 63;
  const int row = item * 4 + wave;
  unsigned* rp = (unsigned*)(P1 + (size_t)row * 640);
  unsigned a[3]; float ss = 0.f;
#pragma unroll
  for (int j = 0; j < 3; ++j) { a[j] = rp[lane + 64 * j]; const float x0 = lo2f(a[j]), x1 = hi2f(a[j]); ss += x0 * x0 + x1 * x1; }
  const unsigned b = rp[192 + lane]; const float y0 = lo2f(b), y1 = hi2f(b);
  float s2 = y0 * y0 + y1 * y1;
  ss = wave_sum(ss); s2 = wave_sum(s2);
  const float r1 = rsqrtf(ss * (1.0f / 384.0f) + 1e-6f), r2 = rsqrtf(s2 * (1.0f / 128.0f) + 1e-6f);
  if (live || r2 == 1.2345e-30f)
#pragma unroll
  for (int j = 0; j < 3; ++j) { const int c = 2 * (lane + 64 * j); rp[lane + 64 * j] = pack2(lo2f(a[j]) * r1 * p.mla_g_q_lora[c], hi2f(a[j]) * r1 * p.mla_g_q_lora[c + 1]); }
  if (live || r1 == 1.2345e-30f) rp[192 + lane] = pack2(y0 * r2 * p.mla_g_kv_lora[2 * lane], y1 * r2 * p.mla_g_kv_lora[2 * lane + 1]);
}
DI void mla_m3_item(const Params& p, int item, bool live, char* sm) {
  const bf16_t* P1 = (const bf16_t*)(p.ws + PB_OFF);
  bf16_t* Q = (bf16_t*)(p.ws + PB_OFF + 20 * MiB);
  const bf16_t* KR = (const bf16_t*)(p.ws + PB_OFF + 68 * MiB);
  bf16_t* KF = (bf16_t*)(p.ws + SB_OFF);
  const float* ct = (const float*)(p.ws + TABM_OFF); const float* st = ct + (size_t)S * 32;
  const int wave = tid_() >> 6, lane = tid_() & 63;
  const int row = item * 4 + wave, j = lane & 31;
  bf16_t* Lq = (bf16_t*)(sm + wave * 8448);
  bf16_t* Lk = Lq + 1536;
  bf16_t* Lo = Lk + 1088;
#define M3_SYNC() { asm volatile("" ::: "memory"); __builtin_amdgcn_wave_barrier(); asm volatile("s_waitcnt lgkmcnt(0)" ::: "memory"); }
#pragma unroll
  for (int i = 0; i < 3; ++i) *(u32x4*)(Lq + (lane + 64 * i) * 8) = *(const u32x4*)(Q + (size_t)row * 1536 + (lane + 64 * i) * 8);
#pragma unroll
  for (int i = 0; i < 2; ++i) *(u32x4*)(Lk + (lane + 64 * i) * 8) = *(const u32x4*)(KR + (size_t)row * 1024 + (lane + 64 * i) * 8);
  if (lane < 8) *(u32x4*)(Lk + 1024 + lane * 8) = *(const u32x4*)(P1 + (size_t)row * 640 + 512 + lane * 8);
  const float c = ct[(size_t)row * 32 + j], s = st[(size_t)row * 32 + j];
  const float sgn = (lane < 32) ? -1.f : 1.f;
  const float qscale = 0.07216878364870322f * 1.4426950408889634f;
  const float gq0 = p.mla_g_qnorm[lane], gq1 = p.mla_g_qnorm[64 + lane], gq2 = p.mla_g_qnorm[128 + lane];
  const float gk0 = p.mla_g_knorm[lane], gk1 = p.mla_g_knorm[64 + lane], gk2 = p.mla_g_knorm[128 + lane];
  M3_SYNC();
  const float kr = bf2f(Lk[1024 + lane]);
#pragma unroll
  for (int hd = 0; hd < 8; ++hd) {
    bf16_t* qp = Lq + hd * 192;
    float v0 = bf2f(qp[lane]), v1 = bf2f(qp[64 + lane]), v2 = bf2f(qp[128 + lane]);
    float ss = wave_sum(v0 * v0 + v1 * v1 + v2 * v2);
    float rs = rsqrtf(ss * (1.0f / 192.0f) + 1e-6f);
    v0 *= rs * gq0; v1 *= rs * gq1; v2 *= rs * gq2;
    float pr = __shfl_xor(v2, 32);
    float o2 = v2 * c + sgn * pr * s;
    qp[lane] = f2bf(v0 * qscale); qp[64 + lane] = f2bf(v1 * qscale); qp[128 + lane] = f2bf(o2 * qscale);
    const bf16_t* kp = Lk + hd * 128;
    float k0 = bf2f(kp[lane]), k1 = bf2f(kp[64 + lane]), k2 = kr;
    ss = wave_sum(k0 * k0 + k1 * k1 + k2 * k2);
    rs = rsqrtf(ss * (1.0f / 192.0f) + 1e-6f);
    k0 *= rs * gk0; k1 *= rs * gk1; k2 *= rs * gk2;
    pr = __shfl_xor(k2, 32);
    o2 = k2 * c + sgn * pr * s;
    bf16_t* ko = Lo + hd * 192;
    ko[lane] = f2bf(k0); ko[64 + lane] = f2bf(k1); ko[128 + lane] = f2bf(o2);
  }
  M3_SYNC();
  if (live || c == 1.2345e-30f) {
#pragma unroll
    for (int i = 0; i < 3; ++i) {
      *(u32x4*)(Q + (size_t)row * 1536 + (lane + 64 * i) * 8) = *(const u32x4*)(Lq + (lane + 64 * i) * 8);
      *(u32x4*)(KF + (size_t)row * 1536 + (lane + 64 * i) * 8) = *(const u32x4*)(Lo + (lane + 64 * i) * 8);
    }
  }
  M3_SYNC();
#undef M3_SYNC
}

DI void attn_unit(const Params& p, int unit, char* smem) {
  bf16_t* Ks = (bf16_t*)smem;
  bf16_t* VTs = (bf16_t*)(smem + 51200);
  const bf16_t* Q = (const bf16_t*)(p.ws + PB_OFF + 20 * MiB);
  const bf16_t* KF = (const bf16_t*)(p.ws + SB_OFF);
  const bf16_t* VT = (const bf16_t*)(p.ws + VTB_OFF);
  bf16_t* AO = (bf16_t*)(p.ws + AO_OFF);
  const int hd = unit & 7, qb = (unit < 256) ? 63 - (unit >> 3) : ((unit - 256) >> 3);
  const int gt = gtid_(), wave = gt >> 6, lane = gt & 63, r = lane & 31, h = lane >> 5;
  const int qrow = qb * 256 + 32 * wave + r;
  bf16x8 qf[12];
#pragma unroll
  for (int ks = 0; ks < 12; ++ks) qf[ks] = *(const bf16x8*)(Q + (size_t)qrow * 1536 + hd * 192 + 16 * ks + 8 * h);
  const int nkt = 4 * qb + 4;
  const int kmax_w = (qb * 256 + 32 * wave + 31) >> 6;
  const int kmask_w = (qb * 256 + 32 * wave) >> 6;
  float m = -1e30f, l = 0.f;
  f32x16 oacc[4];
#pragma unroll
  for (int i = 0; i < 4; ++i) oacc[i] = zero16();
  u32x4 rk[3], rv[2];
  const bf16_t* KFh = KF + hd * 192;
  const bf16_t* VTh = VT + (size_t)(hd * 128) * VTS;
#define A_LOAD(K0) { _Pragma("unroll") for (int i = 0; i < 3; ++i) { const int id = gt + 512 * i, kr = id / 24, ch = id % 24; rk[i] = *(const u32x4*)(KFh + (size_t)((K0) + kr) * 1536 + ch * 8); } \
                     _Pragma("unroll") for (int i = 0; i < 2; ++i) { const int id = gt + 512 * i, v = id >> 3, c8 = id & 7; rv[i] = *(const u32x4*)(VTh + (size_t)v * VTS + (K0) + c8 * 8); } }
#define A_STORE(BUF) { _Pragma("unroll") for (int i = 0; i < 3; ++i) { const int id = gt + 512 * i, kr = id / 24, ch = id % 24; *(u32x4*)(Ks + (BUF) * 12800 + kr * 200 + ch * 8) = rk[i]; } \
                       _Pragma("unroll") for (int i = 0; i < 2; ++i) { const int id = gt + 512 * i, v = id >> 3, c8 = id & 7; *(u32x4*)(VTs + (BUF) * 9216 + v * 72 + c8 * 8) = rv[i]; } }
  A_LOAD(0);
  __syncthreads();
  A_STORE(0);
  __syncthreads();
  for (int kt = 0; kt < nkt; ++kt) {
    const int buf = kt & 1;
    if (kt + 1 < nkt) A_LOAD((kt + 1) * 64);
    if (kt <= kmax_w) {
      const bf16_t* Kb = Ks + buf * 12800; const bf16_t* Vb = VTs + buf * 9216;
      f32x16 sa[2]; sa[0] = zero16(); sa[1] = zero16();
#pragma unroll
      for (int ks = 0; ks < 12; ++ks) {
        const bf16x8 a0 = *(const bf16x8*)(Kb + r * 200 + 16 * ks + 8 * h);
        const bf16x8 a1 = *(const bf16x8*)(Kb + (32 + r) * 200 + 16 * ks + 8 * h);
        sa[0] = MFMA(a0, qf[ks], sa[0]); sa[1] = MFMA(a1, qf[ks], sa[1]);
      }
      if (kt >= kmask_w) {
#pragma unroll
        for (int n = 0; n < 2; ++n)
#pragma unroll
          for (int i = 0; i < 16; ++i) { const int key = kt * 64 + 32 * n + crow(i, h); if (key > qrow) sa[n][i] = -1e30f; }
      }
      float mx = -1e30f;
#pragma unroll
      for (int n = 0; n < 2; ++n)
#pragma unroll
        for (int i = 0; i < 16; ++i) mx = fmaxf(mx, sa[n][i]);
      mx = fmaxf(mx, __shfl_xor(mx, 32));
      const float mnew = fmaxf(m, mx);
      const float alpha = exp2f(m - mnew);
      m = mnew;
      float rsum = 0.f;
#pragma unroll
      for (int n = 0; n < 2; ++n)
#pragma unroll
        for (int i = 0; i < 16; ++i) { const float pv = exp2f(sa[n][i] - mnew); sa[n][i] = pv; rsum += pv; }
      rsum += __shfl_xor(rsum, 32);
      l = l * alpha + rsum;
#pragma unroll
      for (int mt = 0; mt < 4; ++mt) {
        if (__builtin_amdgcn_ballot_w64(alpha != 1.0f) != 0ull) {
#pragma unroll
          for (int i = 0; i < 16; ++i) oacc[mt][i] *= alpha;
        }
      }
      bf16x8 pf[4];
#pragma unroll
      for (int n = 0; n < 2; ++n)
#pragma unroll
        for (int s2 = 0; s2 < 2; ++s2) {
          u32x4 pk;
          pk.x = pack2(sa[n][8 * s2 + 0], sa[n][8 * s2 + 1]); pk.y = pack2(sa[n][8 * s2 + 2], sa[n][8 * s2 + 3]);
          pk.z = pack2(sa[n][8 * s2 + 4], sa[n][8 * s2 + 5]); pk.w = pack2(sa[n][8 * s2 + 6], sa[n][8 * s2 + 7]);
          pf[n * 2 + s2] = __builtin_bit_cast(bf16x8, pk);
        }
#pragma unroll
      for (int mt = 0; mt < 4; ++mt)
#pragma unroll
        for (int f = 0; f < 4; ++f) {
          const bf16_t* vp = Vb + (32 * mt + r) * 72 + 16 * f + 4 * h;
          const u32x2 lo = *(const u32x2*)vp, hi = *(const u32x2*)(vp + 8);
          u32x4 av; av.x = lo.x; av.y = lo.y; av.z = hi.x; av.w = hi.y;
          oacc[mt] = MFMA(__builtin_bit_cast(bf16x8, av), pf[f], oacc[mt]);
        }
    }
    if (kt + 1 < nkt) A_STORE(buf ^ 1);
    __syncthreads();
  }
#undef A_LOAD
#undef A_STORE
  const float inv = 1.0f / l;
#pragma unroll
  for (int mt = 0; mt < 4; ++mt)
#pragma unroll
    for (int g = 0; g < 4; ++g) {
      u32x2 o; o.x = pack2(oacc[mt][4 * g] * inv, oacc[mt][4 * g + 1] * inv); o.y = pack2(oacc[mt][4 * g + 2] * inv, oacc[mt][4 * g + 3] * inv);
      *(u32x2*)(AO + (size_t)qrow * 1024 + hd * 128 + 32 * mt + 8 * g + 4 * h) = o;
    }
}

enum { ST_N1 = 0, ST_IN, ST_GATE, ST_S1, ST_S2, ST_S3, ST_S1B, ST_S2B, ST_S3B, ST_M1, ST_M2, ST_M3, ST_ATT, ST_OUT, ST_N2, ST_F1, ST_F2 };
__device__ __constant__ signed char c_steps[4][13] = {
  { ST_N1, ST_IN, ST_S1, ST_S2, ST_S3, ST_OUT, ST_F1, ST_F2, -1, -1, -1, -1, -1 },
  { ST_IN, ST_GATE, ST_S1, ST_S2, ST_S3, ST_OUT, ST_F1, ST_F2, -1, -1, -1, -1, -1 },
  { ST_IN, ST_S1, ST_S2, ST_S3, ST_S1B, ST_S2B, ST_S3B, ST_OUT, ST_F1, ST_F2, -1, -1, -1 },
  { ST_IN, ST_M1, ST_M2, ST_M3, ST_ATT, ST_OUT, ST_F1, ST_F2, -1, -1, -1, -1, -1 } };
constexpr int N_PHASES = 8 + 8 + 10 + 8;

struct ConvJob { const float* src; int K, N, Np, mode; bf16_t* dst; };
DI int conv_tiles(const ConvJob& j) { return (j.Np >> 6) * (j.K >> 6); }

DI bf16_t* wm_of(const Params& p, int layer) { return (bf16_t*)(p.ws + ((layer & 1) ? WMB_OFF : WM_OFF)); }
DI bool mixer_job(const Params& p, int layer, int j, ConvJob& o) {
  bf16_t* WM = wm_of(p, layer);
  if (layer == 0) {
    if (j == 0) { o = ConvJob{ p.hgrn_w_in, 1024, 4096, 4096, 0, WM }; return true; }
    if (j == 1) { o = ConvJob{ p.hgrn_w_out, 1024, 1024, 1024, 0, WM + 4194304 }; return true; }
  } else if (layer == 1) {
    if (j == 0) { o = ConvJob{ p.gla_w_in, 1024, 3088, 3328, 0, WM }; return true; }
    if (j == 1) { o = ConvJob{ p.gla_w_out, 1024, 1024, 1024, 0, WM + 3407872 }; return true; }
  } else if (layer == 2) {
    if (j == 0) { o = ConvJob{ p.ret_w_in, 1024, 6144, 6144, 0, WM }; return true; }
    if (j == 1) { o = ConvJob{ p.ret_w_out, 2048, 1024, 1024, 0, WM + 6291456 }; return true; }
  } else {
    if (j == 0) { o = ConvJob{ p.mla_w_in, 1024, 576, 768, 0, WM }; return true; }
    if (j == 1) { o = ConvJob{ p.mla_w_uq, 384, 1536, 1536, 0, WM + 786432 }; return true; }
    if (j == 2) { o = ConvJob{ p.mla_w_ukv, 128, 2048, 2048, 0, WM + 1376256 }; return true; }
    if (j == 3) { o = ConvJob{ p.mla_w_out, 1024, 1024, 1024, 0, WM + 1638400 }; return true; }
  }
  return false;
}
DI void run_conv(const ConvJob& job, int& off, char* sm) {
  const int G = VG_(), cnt = conv_tiles(job);
  const int start = (VB_() - (off % G) + G) % G;
  for (int t0 = 0; t0 < cnt; t0 += G) {
    int t = t0 + start; if (t >= cnt) t = cnt - 1;
    conv_tile(job.src, job.K, job.N, job.mode, job.dst, t, sm);
  }
  off += cnt;
}

DI ScanDesc make_scan(const Params& p, int layer, int grp) {
  ScanDesc d;
  bf16_t* P = (bf16_t*)(p.ws + PB_OFF);
  if (layer == 0) { d.q = P; d.k = P; d.g = P + 1024; d.ldp = 3072; d.ldg = 3072; d.gate = P + 2048; d.gnorm = p.hgrn_g_norm; d.mode = 0; d.H0 = 0; d.Hg = 8; d.dv = 128; }
  else if (layer == 1) { d.q = P; d.k = P + 512; d.g = (const bf16_t*)(p.ws + HB_OFF); d.ldp = 2176; d.ldg = 512; d.gate = P + 1024; d.gnorm = p.gla_g_norm; d.mode = 1; d.H0 = 0; d.Hg = 4; d.dv = 256; }
  else { d.q = P; d.k = P + 1024; d.g = P; d.ldp = 4160; d.ldg = 4160; d.gate = P + 2048; d.gnorm = nullptr; d.mode = 2; d.H0 = 4 * grp; d.Hg = 4; d.dv = 256; }
  return d;
}

DI void run_phase(const Params& p, int layer, int step, char* smem, bool live) {
  const int G = VG_(), B = VB_();
  char* sm = smem + (B & 1) * HALF_LDS;
  bf16_t* WM = wm_of(p, layer); bf16_t* WF = (bf16_t*)(p.ws + WF_OFF);
  bf16_t* H = (bf16_t*)(p.ws + HB_OFF); bf16_t* P = (bf16_t*)(p.ws + PB_OFF);
  switch (step) {
    case ST_N1: {
      for (int it = B; it < 4096; it += G) norm_item(p.x, p.norm_mix, H, it);
      for (int it = B; it < 4096; it += G) table_item(p, it);
      for (int it = B; it < 4; it += G) lb_item(p, it);
      { float* z = (float*)(p.ws + SSQA_OFF); for (int i = B * 256 + tid_(); i < 2 * 16384; i += G * 256) z[i] = 0.f; }
      int off = 0;
      for (int j = 0; j < 2; ++j) { ConvJob job; if (mixer_job(p, 0, j, job)) run_conv(job, off, sm); }
    } break;
    case ST_GATE: gla_gate_phase(p); break;
    case ST_S1: case ST_S1B: {
      const ScanDesc d = make_scan(p, layer, step == ST_S1B);
      const int n = 256 * d.Hg * (d.dv >> 7);
      scan1_run(p, d, n, sm);
    } break;
    case ST_S2: case ST_S2B: {
      const ScanDesc d = make_scan(p, layer, step == ST_S2B); scan2_phase(p, d, live);
      if (step == ST_S2) {
        int off = 0;
        { ConvJob job{ p.ffn_w_gate_up + (size_t)layer * 1024 * 5632, 1024, 5632, 5632, 1, WF }; run_conv(job, off, sm); }
        { ConvJob job{ p.ffn_w_down + (size_t)layer * 2816 * 1024, 2816, 1024, 1024, 0, WF + 5767168 }; run_conv(job, off, sm); }
        for (int j = 0; j < 4; ++j) { ConvJob job; if (mixer_job(p, layer + 1, j, job)) run_conv(job, off, sm); }
      }
    } break;
    case ST_S3: case ST_S3B: {
      const ScanDesc d = make_scan(p, layer, step == ST_S3B);
      const int n = 256 * d.Hg;
      for (int u0 = 0; u0 < n; u0 += G) { int u = u0 + B; const bool valid = (u < n) && live; if (u >= n) u = n - 1; scan3_unit(p, d, u, valid, sm); }
    } break;
    case ST_M1: {
      for (int it = B; it < 4096; it += G) mla_m1_item(p, it, live);
      int off = 0;
      { ConvJob job{ p.ffn_w_gate_up + (size_t)layer * 1024 * 5632, 1024, 5632, 5632, 1, WF }; run_conv(job, off, sm); }
      { ConvJob job{ p.ffn_w_down + (size_t)layer * 2816 * 1024, 2816, 1024, 1024, 0, WF + 5767168 }; run_conv(job, off, sm); }
    } break;
    case ST_M3: for (int it = B; it < 4096; it += G) mla_m3_item(p, it, live, sm); break;
    case ST_ATT: for (int u = blockIdx.x; u < 512; u += gridDim.x) attn_unit(p, u, smem); break;
    case ST_IN: case ST_M2: case ST_OUT: case ST_F1: case ST_F2: {
      const bf16_t* A = H; int lda = 1024; const bf16_t* W = WM; int K = 1024, ntn = 4, gid = G_OUT;
      const bf16_t* A2 = H; int lda2 = 0; const bf16_t* W2 = WM; int K2 = 0, ntn2 = 0, gid2 = 0;
      if (step == ST_IN) {
        if (layer == 0) { ntn = 16; gid = G_HGRN_IN; } else if (layer == 1) { ntn = 13; gid = G_GLA_IN; }
        else if (layer == 2) { ntn = 24; gid = G_RET_IN; } else { ntn = 3; gid = G_MLA_IN; }
      } else if (step == ST_M2) {
        A = P; lda = 640; W = WM + 786432; K = 384; ntn = 6; gid = G_MLA_Q;
        A2 = P + 384; lda2 = 640; W2 = WM + 1376256; K2 = 128; ntn2 = 8; gid2 = G_MLA_KV;
      } else if (step == ST_OUT) {
        if (layer == 0) { A = P + 2048; lda = 3072; W = WM + 4194304; }
        else if (layer == 1) { A = P + 1024; lda = 2176; W = WM + 3407872; }
        else if (layer == 2) { A = P + 2048; lda = 4160; W = WM + 6291456; K = 2048; }
        else { A = (const bf16_t*)(p.ws + AO_OFF); W = WM + 1638400; }
      } else if (step == ST_F1) { W = WF; ntn = 22; gid = G_FFN1; }
      else { A = P; lda = 2816; W = WF + 5767168; K = 2816; gid = G_FFN2; }
      if (step == ST_IN && layer > 0) { float* z = (float*)(p.ws + SSQA_OFF); for (int i = blockIdx.x * 512 + gtid_(); i < 16384; i += gridDim.x * 512) z[i] = 0.f; }
      if (step == ST_F1) { float* z = (float*)(p.ws + SSQB_OFF); for (int i = blockIdx.x * 512 + gtid_(); i < 16384; i += gridDim.x * 512) z[i] = 0.f; }
      const int nall = ntn + ntn2, nM = 64, total = nM * nall;
      for (int t = blockIdx.x; t < total; t += gridDim.x) {
        int wg = t; { const int q = total / 8, rr = total % 8, xcd = wg % 8, o = wg / 8; wg = (xcd < rr ? xcd * (q + 1) : rr * (q + 1) + (xcd - rr) * q) + o; }
        const int nig = 8 * nall, g0 = wg / nig, fm = g0 * 8, gsz = (nM - fm) < 8 ? (nM - fm) : 8;
        const int mt = fm + (wg % nig) % gsz; int n = (wg % nig) / gsz;
        const bf16_t* Ax = A; int ldx = lda; const bf16_t* Wx = W; int Kx = K, gx = gid;
        if (n >= ntn) { n -= ntn; Ax = A2; ldx = lda2; Wx = W2; Kx = K2; gx = gid2; }
        gemm_tile(p, Ax, ldx, Wx, Kx, gx, mt, n, layer, smem);
      }
    } break;
    default: break;
  }
}

#define XB_TMO      128
#define XB_XCNT(j)  (256  + 64 * (j))
#define XB_XSUB(j)  (1280 + 64 * (j))
#define XB_XGEN(j)  (2304 + 64 * (j))
#define XB_TOP      3328
#define XB_TOPGEN   3392
#define XCD_BAR_WORDS 3456
#define XB_SPIN_CAP (1u << 18)

__device__ __forceinline__ unsigned xb_ld(unsigned* p)              { return __hip_atomic_load(p, __ATOMIC_RELAXED, __HIP_MEMORY_SCOPE_AGENT); }
__device__ __forceinline__ unsigned xb_add(unsigned* p, unsigned v) { return __hip_atomic_fetch_add(p, v, __ATOMIC_RELAXED, __HIP_MEMORY_SCOPE_AGENT); }
__device__ __forceinline__ unsigned xb_xcc_id() { return (unsigned)__builtin_amdgcn_s_getreg((3 << 11) | 20) & 0xFu; }
#define XB_SPIN(cond, bar) do { unsigned _sp = 0; while (cond) { __builtin_amdgcn_s_sleep(1); \
    if ((++_sp & 255u) == 0u) { if (xb_ld(&(bar)[XB_TMO])) break; if (_sp > XB_SPIN_CAP) { atomicAdd(&(bar)[XB_TMO], 1u); break; } } } } while (0)

struct XcdBarrier {
    unsigned* bar; unsigned x;
    volatile unsigned* st;
};

__device__ __forceinline__ XcdBarrier xcd_barrier_post(unsigned* bar, volatile unsigned* st) {
    XcdBarrier b; b.bar = bar; b.x = xb_xcc_id(); b.st = st;
    if (threadIdx.x == 0) (void)xb_add(&bar[XB_XCNT(b.x)], 1u);
    return b;
}
__device__ __forceinline__ void xcd_barrier_complete(unsigned* bar, unsigned x, unsigned& nloc, unsigned& nx) {
    const unsigned G = gridDim.x * gridDim.y * gridDim.z;
    unsigned sum, cnt, mine, sp = 0u;
    for (;;) {
        sum = 0u; cnt = 0u; mine = 0u;
#pragma unroll
        for (unsigned j = 0; j < 16; ++j) { const unsigned c = xb_ld(&bar[XB_XCNT(j)]); sum += c; cnt += (c > 0u) ? 1u : 0u; mine = (j == x) ? c : mine; }
        if (sum == G) break;
        __builtin_amdgcn_s_sleep(1);
        if ((++sp & 255u) == 0u) { if (xb_ld(&bar[XB_TMO])) break; if (sp > XB_SPIN_CAP) { atomicAdd(&bar[XB_TMO], 1u); break; } }
    }
    nloc = mine > 0u ? mine : 1u; nx = cnt > 0u ? cnt : 1u;
}

__device__ __forceinline__ void xcd_barrier(const XcdBarrier& b) {
    asm volatile("s_waitcnt vmcnt(0)" ::: "memory");
    __syncthreads();
    if (threadIdx.x == 0) {
        unsigned* bar = b.bar;
        __builtin_amdgcn_s_waitcnt(0);
        unsigned nloc = b.st[0], nx = b.st[1];
        if (nloc == 0u) { xcd_barrier_complete(bar, b.x, nloc, nx); b.st[0] = nloc; b.st[1] = nx; }
        const unsigned old = xb_add(&bar[XB_XSUB(b.x)], 1u);
        const unsigned gen = old / nloc;
        if (old + 1u == (gen + 1u) * nloc) {
            __builtin_amdgcn_fence(__ATOMIC_RELEASE, "agent");
            asm volatile("s_waitcnt vmcnt(0)" ::: "memory");
            const unsigned og = xb_add(&bar[XB_TOP], 1u);
            const unsigned tg = og / nx;
            if (og + 1u == (tg + 1u) * nx) xb_add(&bar[XB_TOPGEN], 1u);
            else XB_SPIN(xb_ld(&bar[XB_TOPGEN]) == tg, bar);
            __builtin_amdgcn_fence(__ATOMIC_ACQUIRE, "agent");
            xb_add(&bar[XB_XGEN(b.x)], 1u);
            asm volatile("s_waitcnt vmcnt(0)" ::: "memory");
        } else {
            XB_SPIN(xb_ld(&bar[XB_XGEN(b.x)]) == gen, bar);
            __builtin_amdgcn_fence(__ATOMIC_ACQUIRE, "agent");
            asm volatile("s_waitcnt vmcnt(0)" ::: "memory");
        }
    }
    __syncthreads();
}


DI void grid_barrier(unsigned* ctr, unsigned& epoch) {
  asm volatile("s_waitcnt vmcnt(0)" ::: "memory");
  __syncthreads();
  epoch += gridDim.x;
  if (threadIdx.x < 64) {
    if (threadIdx.x == 0) {
      __builtin_amdgcn_fence(__ATOMIC_RELEASE, "agent");
      asm volatile("s_waitcnt vmcnt(0)" ::: "memory");
      __hip_atomic_fetch_add(ctr, 1u, __ATOMIC_RELAXED, __HIP_MEMORY_SCOPE_AGENT);
      while (__hip_atomic_load(ctr, __ATOMIC_RELAXED, __HIP_MEMORY_SCOPE_AGENT) < epoch) __builtin_amdgcn_s_sleep(1);
    }
    __builtin_amdgcn_fence(__ATOMIC_ACQUIRE, "agent");
    asm volatile("s_waitcnt vmcnt(0)" ::: "memory");
  }
  __syncthreads();
}

__global__ void __launch_bounds__(512) fwd_megakernel(Params p, int ph_lo, int ph_hi) {
  extern __shared__ __attribute__((aligned(16))) char smem[];
  cg::grid_group grid = cg::this_grid();
  volatile unsigned* xst = (volatile unsigned*)(smem + 147456);
  if (threadIdx.x == 0) { xst[0] = 0u; xst[1] = 0u; }
  __syncthreads();
  const XcdBarrier xb = xcd_barrier_post((unsigned*)(p.ws + LB_OFF + 262144), xst);
  int ph = 0;
  for (int layer = 0; layer < 4; ++layer) {
    for (int si = 0; si < 13; ++si) {
      const int step = c_steps[layer][si];
      if (step < 0) break;
      if (ph >= ph_lo && ph < ph_hi) {
        run_phase(p, layer, step, smem, true);
        if (ph + 1 < ph_hi) { if (ph_hi > 1000) grid.sync(); else xcd_barrier(xb); }
      }
      ++ph;
    }
  }
}

extern "C" void kernel_launch(void* const* d_in, const int* in_sizes, int n_in, void* d_out, int out_size, void* d_ws, size_t ws_size, hipStream_t stream) {
  static int grid_blocks = 0;
  Params p{};
  const float** fp = (const float**)&p;
  p.x = (const float*)d_in[0]; p.pos = (const int*)d_in[1];
  for (int i = 2; i < 25; ++i) fp[i] = (const float*)d_in[i];
  p.out = (float*)d_out; p.ws = (char*)d_ws;
  int lo = 0, hi = N_PHASES;
  void* args[] = { &p, &lo, &hi };
  if (!grid_blocks) {
    int dev = 0, cus = 0;
    (void)hipGetDevice(&dev);
    (void)hipDeviceGetAttribute(&cus, hipDeviceAttributeMultiprocessorCount, dev);
    (void)hipFuncSetAttribute((const void*)fwd_megakernel, hipFuncAttributeMaxDynamicSharedMemorySize, LDS_BYTES);
    grid_blocks = cus;
  }
  (void)hipMemsetAsync((char*)d_ws + LB_OFF + 262144, 0, XCD_BAR_WORDS * 4, stream);
  hipError_t e = hipLaunchCooperativeKernel((const void*)fwd_megakernel, dim3(grid_blocks), dim3(NT), args, LDS_BYTES, stream);
  if (e != hipSuccess) fprintf(stderr, "cooperative launch failed: %s (grid %d)\n", hipGetErrorString(e), grid_blocks);
}
```

```cpp
#include <hip/hip_runtime.h>
#include <hip/hip_cooperative_groups.h>
#include <stdint.h>
#include <cstdio>
namespace cg = cooperative_groups;

typedef unsigned short bf16_t;
typedef short bf16x8 __attribute__((ext_vector_type(8)));
typedef float f32x16 __attribute__((ext_vector_type(16)));
typedef float f32x4 __attribute__((ext_vector_type(4)));
typedef float f32x2 __attribute__((ext_vector_type(2)));
typedef unsigned u32x4 __attribute__((ext_vector_type(4)));
typedef unsigned u32x2 __attribute__((ext_vector_type(2)));

#define DI __device__ __forceinline__
#define MFMA(a, b, c) __builtin_amdgcn_mfma_f32_32x32x16_bf16((a), (b), (c), 0, 0, 0)

constexpr int S = 16384;
constexpr int VTS = 16384 + 192;
constexpr int NT = 512;
constexpr int LDS_BYTES = 147456 + 16;
constexpr int HALF_LDS = 73728;
constexpr size_t MiB = 1048576;
constexpr size_t WM_OFF = 0, WF_OFF = 17 * MiB, HB_OFF = 34 * MiB, PB_OFF = 66 * MiB, VTB_OFF = 198 * MiB,
                 SB_OFF = 263 * MiB, DB_OFF = 327 * MiB, TABR_OFF = 328 * MiB, TABM_OFF = 336 * MiB, LB_OFF = 340 * MiB,
                 SSQA_OFF = LB_OFF + 8192, SSQB_OFF = LB_OFF + 8192 + 65536, WMB_OFF = 341 * MiB, AO_OFF = PB_OFF + 100 * MiB;

struct Params {
  const float* x; const int* pos; const float* norm_mix; const float* norm_ffn;
  const float* hgrn_w_in; const float* hgrn_g_norm; const float* hgrn_w_out; const float* hgrn_lb;
  const float* gla_w_in; const float* gla_w_gk_up; const float* gla_b_gk; const float* gla_g_norm; const float* gla_w_out;
  const float* ret_w_in; const float* ret_w_out;
  const float* mla_w_in; const float* mla_g_q_lora; const float* mla_g_kv_lora; const float* mla_w_uq; const float* mla_w_ukv;
  const float* mla_g_qnorm; const float* mla_g_knorm; const float* mla_w_out;
  const float* ffn_w_gate_up; const float* ffn_w_down;
  float* out; char* ws;
};

DI int tid_() { int t = threadIdx.x & 255; asm volatile("" : "+v"(t)); return t; }
DI int gtid_() { int t = threadIdx.x; asm volatile("" : "+v"(t)); return t; }
DI int VB_() { int hv = __builtin_amdgcn_readfirstlane((int)(threadIdx.x >> 8)); asm volatile("" : "+s"(hv)); return blockIdx.x * 2 + hv; }
DI int VG_() { return gridDim.x * 2; }
typedef __bf16 bf16n2 __attribute__((ext_vector_type(2)));
DI bf16_t f2bf(float x) { return __builtin_bit_cast(bf16_t, (__bf16)x); }
DI float bf2f(bf16_t b) { return __uint_as_float(((unsigned)b) << 16); }
DI unsigned pack2(float a, float b) { bf16n2 v; v[0] = (__bf16)a; v[1] = (__bf16)b; return __builtin_bit_cast(unsigned, v); }
DI float lo2f(unsigned u) { return __uint_as_float(u << 16); }
DI float hi2f(unsigned u) { return __uint_as_float(u & 0xffff0000u); }
DI int crow(int i, int h) { return (i & 3) + 8 * (i >> 2) + 4 * h; }
DI float sigmoidf_(float x) { return __builtin_amdgcn_rcpf(1.0f + __expf(-x)); }
DI float siluf_(float x) { return x * __builtin_amdgcn_rcpf(1.0f + __expf(-x)); }
DI float clampe(float e) { return fminf(fmaxf(e, -80.f), 80.f); }
#define DPP_ADD(v, ctrl) v += __int_as_float(__builtin_amdgcn_mov_dpp(__float_as_int(v), ctrl, 0xF, 0xF, true))
DI float wave_sum(float v) {
  DPP_ADD(v, 0xB1); DPP_ADD(v, 0x4E); DPP_ADD(v, 0x141); DPP_ADD(v, 0x140);
  return (__int_as_float(__builtin_amdgcn_readlane(__float_as_int(v), 0)) + __int_as_float(__builtin_amdgcn_readlane(__float_as_int(v), 16))) +
         (__int_as_float(__builtin_amdgcn_readlane(__float_as_int(v), 32)) + __int_as_float(__builtin_amdgcn_readlane(__float_as_int(v), 48)));
}
DI f32x16 zero16() { f32x16 z; for (int i = 0; i < 16; ++i) z[i] = 0.f; return z; }

DI void conv_tile(const float* __restrict__ src, int K, int N, int mode, bf16_t* __restrict__ dst, int tile, char* smem) {
  float* T = (float*)smem;
  const int nkt = K >> 6, rt = tile / nkt, kt = tile % nkt, tid = tid_();
  const int R0 = rt * 64;
  int n0 = R0;
  if (mode == 1) { const int q = R0 >> 7, t = (R0 & 127) >> 6; n0 = t * 2816 + q * 64; }
#pragma unroll
  for (int i = 0; i < 4; ++i) {
    const int id = tid + 256 * i, kr = id >> 4, c4 = id & 15;
    f32x4 v = {0.f, 0.f, 0.f, 0.f};
    if (n0 + 4 * c4 < N) v = *(const f32x4*)(src + (size_t)(kt * 64 + kr) * N + n0 + 4 * c4);
    *(f32x4*)(T + kr * 68 + 4 * c4) = v;
  }
  __syncthreads();
  const int r = tid >> 2, seg = tid & 3;
  u32x4 o0, o1;
  const float* tp = T + (seg * 16) * 68 + r;
  o0.x = pack2(tp[0 * 68], tp[1 * 68]); o0.y = pack2(tp[2 * 68], tp[3 * 68]); o0.z = pack2(tp[4 * 68], tp[5 * 68]); o0.w = pack2(tp[6 * 68], tp[7 * 68]);
  o1.x = pack2(tp[8 * 68], tp[9 * 68]); o1.y = pack2(tp[10 * 68], tp[11 * 68]); o1.z = pack2(tp[12 * 68], tp[13 * 68]); o1.w = pack2(tp[14 * 68], tp[15 * 68]);
  bf16_t* d = dst + (size_t)(R0 + r) * K + kt * 64 + seg * 16;
  *(u32x4*)d = o0; *(u32x4*)(d + 8) = o1;
  __syncthreads();
}

DI void norm_item(const float* __restrict__ x, const float* __restrict__ gain, bf16_t* __restrict__ H, int item) {
  const int wave = tid_() >> 6, lane = tid_() & 63;
  const int row = item * 4 + wave;
  const f32x4* xr = (const f32x4*)(x + (size_t)row * 1024);
  f32x4 v[4]; float ss = 0.f;
#pragma unroll
  for (int j = 0; j < 4; ++j) { v[j] = xr[lane + 64 * j]; ss += v[j].x * v[j].x + v[j].y * v[j].y + v[j].z * v[j].z + v[j].w * v[j].w; }
  ss = wave_sum(ss);
  const float rstd = rsqrtf(ss * (1.0f / 1024.0f) + 1e-6f);
  const f32x4* g4 = (const f32x4*)gain;
#pragma unroll
  for (int j = 0; j < 4; ++j) {
    const f32x4 g = g4[lane + 64 * j];
    u32x2 o; o.x = pack2(v[j].x * rstd * g.x, v[j].y * rstd * g.y); o.y = pack2(v[j].z * rstd * g.z, v[j].w * rstd * g.w);
    *(u32x2*)(H + (size_t)row * 1024 + 4 * (lane + 64 * j)) = o;
  }
}

DI void sincos_acc(float ang, float& c, float& s) {
  const double x = (double)ang;
  const double q = __builtin_rint(x * 0.63661977236758134308);
  const double y = x - q * 1.57079632679489661923;
  const double y2 = y * y;
  double sp = y * (1.0 + y2 * (-1.0 / 6 + y2 * (1.0 / 120 + y2 * (-1.0 / 5040 + y2 * (1.0 / 362880 + y2 * (-1.0 / 39916800))))));
  double cp = 1.0 + y2 * (-0.5 + y2 * (1.0 / 24 + y2 * (-1.0 / 720 + y2 * (1.0 / 40320 + y2 * (-1.0 / 3628800 + y2 * (1.0 / 479001600))))));
  const int k = ((int)q) & 3;
  double sr, cr;
  if (k == 0) { sr = sp; cr = cp; } else if (k == 1) { sr = cp; cr = -sp; } else if (k == 2) { sr = -sp; cr = -cp; } else { sr = -cp; cr = sp; }
  c = (float)cr; s = (float)sr;
}
DI void table_item(const Params& p, int item) {
  const int row = item * 4 + (tid_() >> 6), j = tid_() & 63;
  const float pf = (float)p.pos[row];
  float* tr = (float*)(p.ws + TABR_OFF); float* tm = (float*)(p.ws + TABM_OFF);
  {
    const float inv = 1.0f / exp2f((float)j * (13.287712379549449f / 64.0f));
    float c, s; sincos_acc(pf * inv, c, s);
    tr[(size_t)row * 64 + j] = c; tr[(size_t)S * 64 + (size_t)row * 64 + j] = s;
  }
  if (j < 32) {
    const float inv = 1.0f / exp2f((float)j * (13.287712379549449f / 32.0f));
    float c, s; sincos_acc(pf * inv, c, s);
    tm[(size_t)row * 32 + j] = c; tm[(size_t)S * 32 + (size_t)row * 32 + j] = s;
  }
}
DI void lb_item(const Params& p, int item) {
  const int c = item * 256 + tid_();
  float l[5], mx = -1e30f;
  for (int j = 0; j < 5; ++j) { l[j] = p.hgrn_lb[j * 1024 + c]; mx = fmaxf(mx, l[j]); }
  float sum = 0.f; for (int j = 0; j < 5; ++j) sum += __expf(l[j] - mx);
  ((float*)(p.ws + LB_OFF))[c] = __expf(l[0] - mx) / sum;
}

enum { EP_BF16 = 0, EP_SILU = 1, EP_LOGF = 2, EP_ROPE = 3, EP_VT = 4, EP_RESID = 5, EP_SWIGLU = 6, EP_NONE = 7 };
enum { G_HGRN_IN = 0, G_GLA_IN, G_RET_IN, G_MLA_IN, G_MLA_Q, G_MLA_KV, G_OUT, G_FFN1, G_FFN2 };
struct Epi { int mode; bf16_t* dst; int ld; int dcol0; float scale; const float* xin; float* xout; const float* rs_in; float* ssq_out; const float* gnext; };

DI Epi get_epi(const Params& p, int gid, int nt, int layer) {
  Epi e; e.mode = EP_BF16; e.dst = (bf16_t*)(p.ws + PB_OFF); e.ld = 0; e.dcol0 = 0; e.scale = 1.f; e.xin = nullptr; e.xout = nullptr; e.rs_in = nullptr; e.ssq_out = nullptr; e.gnext = nullptr;
  float* ssqA = (float*)(p.ws + SSQA_OFF); float* ssqB = (float*)(p.ws + SSQB_OFF);
  if (gid <= G_MLA_IN && layer > 0) e.rs_in = ssqB;
  if (gid == G_FFN1) e.rs_in = ssqA;
  bf16_t* VT = (bf16_t*)(p.ws + VTB_OFF);
  const float isq = 0.08838834764831845f;
  if (gid == G_HGRN_IN) {
    e.ld = 3072;
    if (nt < 8) { e.mode = EP_SILU; e.scale = isq; e.dcol0 = nt * 128; }
    else if (nt < 16) { e.mode = EP_LOGF; e.dcol0 = nt * 128; }
    else if (nt < 24) { e.mode = EP_VT; e.dst = VT; e.dcol0 = (nt - 16) * 128; }
    else { e.dcol0 = 2048 + (nt - 24) * 128; }
  } else if (gid == G_GLA_IN) {
    e.ld = 2176;
    if (nt < 4) { e.scale = isq; e.dcol0 = nt * 128; }
    else if (nt < 8) { e.dcol0 = nt * 128; }
    else if (nt < 16) { e.mode = EP_VT; e.dst = VT; e.dcol0 = (nt - 8) * 128; }
    else if (nt < 24) { e.dcol0 = 1024 + (nt - 16) * 128; }
    else if (nt == 24) { e.dcol0 = 2048; }
    else { e.mode = EP_NONE; }
  } else if (gid == G_RET_IN) {
    e.ld = 4160;
    if (nt < 8) { e.mode = EP_ROPE; e.dcol0 = nt * 128; }
    else if (nt < 16) { e.mode = EP_ROPE; e.scale = isq; e.dcol0 = nt * 128; }
    else if (nt < 32) { e.mode = EP_VT; e.dst = VT; e.dcol0 = (nt - 16) * 128; }
    else { e.dcol0 = 2048 + (nt - 32) * 128; }
  } else if (gid == G_MLA_IN) {
    e.ld = 640; e.dcol0 = nt * 128; if (nt >= 5) e.mode = EP_NONE;
  } else if (gid == G_MLA_Q) {
    e.dst = (bf16_t*)(p.ws + PB_OFF + 20 * MiB); e.ld = 1536; e.dcol0 = nt * 128;
  } else if (gid == G_MLA_KV) {
    if (nt & 1) { e.mode = EP_VT; e.dst = VT; e.dcol0 = (nt >> 1) * 128; }
    else { e.dst = (bf16_t*)(p.ws + PB_OFF + 68 * MiB); e.ld = 1024; e.dcol0 = (nt >> 1) * 128; }
  } else if (gid == G_OUT) {
    e.mode = EP_RESID; e.xin = (layer == 0) ? p.x : p.out; e.xout = p.out; e.dcol0 = nt * 128; e.ssq_out = ssqA; e.gnext = p.norm_ffn + layer * 1024;
  } else if (gid == G_FFN1) {
    e.mode = EP_SWIGLU; e.ld = 2816; e.dcol0 = nt * 64;
  } else {
    e.mode = EP_RESID; e.xin = p.out; e.xout = p.out; e.dcol0 = nt * 128; if (layer < 3) { e.ssq_out = ssqB; e.gnext = p.norm_mix + (layer + 1) * 1024; }
  }
  return e;
}

DI void gemm_tile(const Params& p, const bf16_t* __restrict__ A, int lda, const bf16_t* __restrict__ W, int K, int gid, int mt, int nt, int layer, char* smem) {
  const int gt = gtid_(), wave = gt >> 6, lane = gt & 63, r = lane & 31, h = lane >> 5, wr = wave >> 2, wc = wave & 3, grp = wc >> 1, wcl = wc & 1;
  const Epi e = get_epi(p, gid, nt * 2 + grp, layer);
  const bool swapped = (e.mode == EP_VT);
  const int nk = K >> 5;
  f32x16 acc[4][2];
#pragma unroll
  for (int a = 0; a < 4; ++a)
#pragma unroll
    for (int b = 0; b < 2; ++b) acc[a][b] = zero16();
  const int lrow = lane >> 2, lch = (lane & 3) ^ (lrow >> 2);
  const bf16_t* Ag = A + (size_t)(mt * 256 + 32 * wave + lrow) * lda + lch * 8;
  const bf16_t* Wg = W + (size_t)(nt * 256 + 32 * wave + lrow) * K + lch * 8;
  const unsigned a16 = (unsigned)(16 * lda), w16 = (unsigned)(16 * K);
  char* ldsw = smem + (32 * wave) * 64;
#define G_ISSUE(KT) { char* st_ = ldsw + ((KT) & 3) * 32768; const unsigned ko_ = (unsigned)((KT) * 32); \
    __builtin_amdgcn_global_load_lds((const unsigned*)(Ag + ko_), (unsigned*)(st_), 16, 0, 0); \
    __builtin_amdgcn_global_load_lds((const unsigned*)(Ag + a16 + ko_), (unsigned*)(st_ + 1024), 16, 0, 0); \
    __builtin_amdgcn_global_load_lds((const unsigned*)(Wg + ko_), (unsigned*)(st_ + 16384), 16, 0, 0); \
    __builtin_amdgcn_global_load_lds((const unsigned*)(Wg + w16 + ko_), (unsigned*)(st_ + 16384 + 1024), 16, 0, 0); }
#define RAW_BARRIER() { asm volatile("s_waitcnt lgkmcnt(0)" ::: "memory"); __builtin_amdgcn_s_barrier(); asm volatile("" ::: "memory"); }
  const int sw = (r >> 2) & 3;
  const int xo0 = ((0 + h) ^ sw) * 16, xo1 = ((2 + h) ^ sw) * 16;
  const char* Afr = smem + (wr * 128 + r) * 64;
  const char* Bfr = smem + 16384 + (grp * 128 + wcl * 32 + r) * 64;
  RAW_BARRIER();
  G_ISSUE(0); G_ISSUE(1);
  for (int kt = 0; kt < nk; ++kt) {
    asm volatile("s_waitcnt vmcnt(4)" ::: "memory");
    RAW_BARRIER();
    const char* Ab = Afr + (kt & 3) * 32768; const char* Bb = Bfr + (kt & 3) * 32768;
    bf16x8 fa[2][4], fb[2][2];
#pragma unroll
    for (int ks = 0; ks < 2; ++ks) {
      const int xo = ks ? xo1 : xo0;
      fb[ks][0] = *(const bf16x8*)(Bb + xo); fb[ks][1] = *(const bf16x8*)(Bb + 64 * 64 + xo);
#pragma unroll
      for (int a = 0; a < 4; ++a) fa[ks][a] = *(const bf16x8*)(Ab + a * 32 * 64 + xo);
    }
    const int ktn = (kt + 2 < nk) ? kt + 2 : nk - 1;
    char* st_ = ldsw + ((kt + 2) & 3) * 32768; const unsigned ko_ = (unsigned)(ktn * 32);
#define MMN(ks, a) { acc[a][0] = MFMA(fb[ks][0], fa[ks][a], acc[a][0]); acc[a][1] = MFMA(fb[ks][1], fa[ks][a], acc[a][1]); }
#define SB() __builtin_amdgcn_sched_barrier(0)
#define SEQ(MM) { MM(0, 0); MM(0, 1); SB(); \
    __builtin_amdgcn_global_load_lds((const unsigned*)(Ag + ko_), (unsigned*)(st_), 16, 0, 0); \
    SB(); MM(0, 2); MM(0, 3); SB(); \
    __builtin_amdgcn_global_load_lds((const unsigned*)(Ag + a16 + ko_), (unsigned*)(st_ + 1024), 16, 0, 0); \
    SB(); MM(1, 0); MM(1, 1); SB(); \
    __builtin_amdgcn_global_load_lds((const unsigned*)(Wg + ko_), (unsigned*)(st_ + 16384), 16, 0, 0); \
    SB(); MM(1, 2); MM(1, 3); SB(); \
    __builtin_amdgcn_global_load_lds((const unsigned*)(Wg + w16 + ko_), (unsigned*)(st_ + 16384 + 1024), 16, 0, 0); \
    SB(); }
    SEQ(MMN)
#undef MMN
#undef SEQ
#undef SB
  }
  asm volatile("s_waitcnt vmcnt(0)" ::: "memory");
  RAW_BARRIER();
#undef G_ISSUE
#undef RAW_BARRIER
  const int rowbase = mt * 256 + wr * 128;
  if (e.mode == EP_NONE) return;
  char* wl = smem + wave * 18432;
#define WAVE_SYNC() { asm volatile("" ::: "memory"); __builtin_amdgcn_wave_barrier(); asm volatile("s_waitcnt lgkmcnt(0)" ::: "memory"); }
  if (e.rs_in) {
#pragma unroll
    for (int a = 0; a < 4; ++a) {
      const float rs = rsqrtf(e.rs_in[rowbase + 32 * a + r] * (1.0f / 1024.0f) + 1e-6f);
#pragma unroll
      for (int i = 0; i < 16; ++i) { acc[a][0][i] *= rs; acc[a][1][i] *= rs; }
    }
  }
  const int c0 = 4 * h;
  if (e.mode == EP_VT) {
    bf16_t* St = (bf16_t*)wl;
#pragma unroll
    for (int a = 0; a < 4; ++a)
#pragma unroll
      for (int b = 0; b < 2; ++b)
#pragma unroll
        for (int i = 0; i < 16; ++i) St[(32 * b + crow(i, h)) * 136 + 32 * a + r] = f2bf(acc[a][b][i]);
    WAVE_SYNC();
#pragma unroll
    for (int j = 0; j < 16; ++j) {
      const int id = lane + 64 * j, nl = id >> 4, ch = id & 15;
      const int n = 32 * wcl + 64 * (nl >> 5) + (nl & 31);
      *(u32x4*)(e.dst + (unsigned)((e.dcol0 + n) * VTS + rowbase + ch * 8)) = *(const u32x4*)(St + nl * 136 + ch * 8);
    }
    return;
  }
  if (e.mode == EP_RESID) {
    float* St = (float*)wl;
#pragma unroll
    for (int ps = 0; ps < 2; ++ps) {
#pragma unroll
      for (int a2 = 0; a2 < 2; ++a2)
#pragma unroll
        for (int b = 0; b < 2; ++b)
#pragma unroll
          for (int g = 0; g < 4; ++g) {
            f32x4 v; v.x = acc[2 * ps + a2][b][4 * g]; v.y = acc[2 * ps + a2][b][4 * g + 1]; v.z = acc[2 * ps + a2][b][4 * g + 2]; v.w = acc[2 * ps + a2][b][4 * g + 3];
            *(f32x4*)(St + (32 * a2 + r) * 68 + 32 * b + 8 * g + c0) = v;
          }
      WAVE_SYNC();
      const int pc = lane & 15, piece = pc >> 3, c4 = pc & 7, colx = e.dcol0 + 32 * wcl + 64 * piece + c4 * 4;
      f32x4 g4 = {1.f, 1.f, 1.f, 1.f};
      if (e.ssq_out) g4 = *(const f32x4*)(e.gnext + colx);
#pragma unroll
      for (int j = 0; j < 16; ++j) {
        const int id = lane + 64 * j, rw = id >> 4;
        const unsigned off = (unsigned)((rowbase + 64 * ps + rw) * 1024 + colx);
        const f32x4 xv = *(const f32x4*)(e.xin + off);
        const f32x4 av = *(const f32x4*)(St + rw * 68 + piece * 32 + c4 * 4);
        const f32x4 xn = xv + av;
        *(f32x4*)(e.xout + off) = xn;
        if (e.ssq_out) {
          u32x2 hb; hb.x = pack2(xn.x * g4.x, xn.y * g4.y); hb.y = pack2(xn.z * g4.z, xn.w * g4.w);
          *(u32x2*)((bf16_t*)(p.ws + HB_OFF) + off) = hb;
          float sq = xn.x * xn.x + xn.y * xn.y + xn.z * xn.z + xn.w * xn.w;
          DPP_ADD(sq, 0xB1); DPP_ADD(sq, 0x4E); DPP_ADD(sq, 0x141); DPP_ADD(sq, 0x140);
          if ((lane & 15) == 0) atomicAdd(e.ssq_out + (rowbase + 64 * ps + rw), sq);
        }
      }
      WAVE_SYNC();
    }
    return;
  }
  if (e.mode == EP_SWIGLU) {
    bf16_t* St = (bf16_t*)wl;
#pragma unroll
    for (int a = 0; a < 4; ++a)
#pragma unroll
      for (int g = 0; g < 4; ++g) {
        u32x2 o;
        o.x = pack2(siluf_(acc[a][0][4 * g]) * acc[a][1][4 * g], siluf_(acc[a][0][4 * g + 1]) * acc[a][1][4 * g + 1]);
        o.y = pack2(siluf_(acc[a][0][4 * g + 2]) * acc[a][1][4 * g + 2], siluf_(acc[a][0][4 * g + 3]) * acc[a][1][4 * g + 3]);
        *(u32x2*)(St + (32 * a + r) * 40 + 8 * g + c0) = o;
      }
    WAVE_SYNC();
#pragma unroll
    for (int j = 0; j < 8; ++j) {
      const int id = lane + 64 * j, rw = id >> 2, c4 = id & 3;
      *(u32x4*)(e.dst + (unsigned)((rowbase + rw) * 2816 + e.dcol0 + 32 * wcl + c4 * 8)) = *(const u32x4*)(St + rw * 40 + c4 * 8);
    }
    return;
  }
  bf16_t* St = (bf16_t*)wl;
  if (e.mode == EP_ROPE) {
    const float* ct = (const float*)(p.ws + TABR_OFF); const float* st = ct + (size_t)S * 64;
#pragma unroll
    for (int a = 0; a < 4; ++a)
#pragma unroll
      for (int g = 0; g < 4; ++g) {
        const unsigned ti = (unsigned)((rowbase + 32 * a + r) * 64 + 32 * wcl + 8 * g + c0);
        const f32x4 c = *(const f32x4*)(ct + ti), sn = *(const f32x4*)(st + ti);
        const float x10 = acc[a][0][4 * g], x11 = acc[a][0][4 * g + 1], x12 = acc[a][0][4 * g + 2], x13 = acc[a][0][4 * g + 3];
        const float x20 = acc[a][1][4 * g], x21 = acc[a][1][4 * g + 1], x22 = acc[a][1][4 * g + 2], x23 = acc[a][1][4 * g + 3];
        u32x2 o1, o2;
        o1.x = pack2((x10 * c.x - x20 * sn.x) * e.scale, (x11 * c.y - x21 * sn.y) * e.scale); o1.y = pack2((x12 * c.z - x22 * sn.z) * e.scale, (x13 * c.w - x23 * sn.w) * e.scale);
        o2.x = pack2((x20 * c.x + x10 * sn.x) * e.scale, (x21 * c.y + x11 * sn.y) * e.scale); o2.y = pack2((x22 * c.z + x12 * sn.z) * e.scale, (x23 * c.w + x13 * sn.w) * e.scale);
        *(u32x2*)(St + (32 * a + r) * 72 + 8 * g + c0) = o1;
        *(u32x2*)(St + (32 * a + r) * 72 + 32 + 8 * g + c0) = o2;
      }
  } else {
#pragma unroll
    for (int b = 0; b < 2; ++b)
#pragma unroll
      for (int g = 0; g < 4; ++g) {
        f32x4 lbv = {0.f, 0.f, 0.f, 0.f};
        if (e.mode == EP_LOGF) lbv = *(const f32x4*)((const float*)(p.ws + LB_OFF) + (e.dcol0 - 1024 + 32 * wcl + 64 * b + 8 * g + c0));
#pragma unroll
        for (int a = 0; a < 4; ++a) {
          float v0 = acc[a][b][4 * g], v1 = acc[a][b][4 * g + 1], v2 = acc[a][b][4 * g + 2], v3 = acc[a][b][4 * g + 3];
          if (e.mode == EP_SILU) { v0 = siluf_(v0) * e.scale; v1 = siluf_(v1) * e.scale; v2 = siluf_(v2) * e.scale; v3 = siluf_(v3) * e.scale; }
          else if (e.mode == EP_LOGF) {
            v0 = __logf(lbv.x + (1.f - lbv.x) * sigmoidf_(v0)); v1 = __logf(lbv.y + (1.f - lbv.y) * sigmoidf_(v1));
            v2 = __logf(lbv.z + (1.f - lbv.z) * sigmoidf_(v2)); v3 = __logf(lbv.w + (1.f - lbv.w) * sigmoidf_(v3));
          } else { v0 *= e.scale; v1 *= e.scale; v2 *= e.scale; v3 *= e.scale; }
          u32x2 o; o.x = pack2(v0, v1); o.y = pack2(v2, v3);
          *(u32x2*)(St + (32 * a + r) * 72 + 32 * b + 8 * g + c0) = o;
        }
      }
  }
  WAVE_SYNC();
#pragma unroll
  for (int j = 0; j < 16; ++j) {
    const int id = lane + 64 * j, rw = id >> 3, pc = id & 7, piece = pc >> 2, c4 = pc & 3;
    *(u32x4*)(e.dst + (unsigned)((rowbase + rw) * e.ld + e.dcol0 + 32 * wcl + 64 * piece + c4 * 8)) = *(const u32x4*)(St + rw * 72 + piece * 32 + c4 * 8);
  }
#undef WAVE_SYNC
}

struct ScanDesc {
  const bf16_t* q; const bf16_t* k; const bf16_t* g; int ldp, ldg;
  bf16_t* gate;
  const float* gnorm;
  int mode;
  int H0, Hg, dv;
};
DI float ret_lg(int hh) { return __logf(1.0f - exp2f(-5.0f - (float)hh)); }

DI void scan1_run(const Params& p, const ScanDesc& d, int n, char* smem) {
  bf16_t* Gs = (bf16_t*)smem;
  bf16_t* Kr = (bf16_t*)(smem + 16384);
  bf16_t* KmT = (bf16_t*)(smem + 32768);
  bf16_t* VTs = (bf16_t*)(smem + 51200);
  float* tot = (float*)(smem + 69632);
  float* fac = (float*)(smem + 70656);
  const int ndvb = d.dv >> 7;
  const int G = VG_(), B = VB_();
  const int tid = tid_(), kk = tid & 127, half = tid >> 7;
  const int wave = tid >> 6, lane = tid & 63, r = lane & 31, h = lane >> 5;
  const bf16_t* VT = (const bf16_t*)(p.ws + VTB_OFF);
  u32x4 pg[4], pk[4], pv[4];
#define S1_ISSUE(U) { const int dvb_ = (U) % ndvb, hl_ = ((U) / ndvb) % d.Hg, c_ = (U) / (ndvb * d.Hg), hh_ = d.H0 + hl_, row0_ = c_ * 64; \
    _Pragma("unroll") for (int i = 0; i < 4; ++i) { const int id = tid + 256 * i, rw = id >> 4, ch = id & 15; \
      if (d.mode != 2) pg[i] = *(const u32x4*)(d.g + (size_t)(row0_ + rw) * d.ldg + hh_ * 128 + ch * 8); \
      if (d.mode != 0) pk[i] = *(const u32x4*)(d.k + (size_t)(row0_ + rw) * d.ldp + hh_ * 128 + ch * 8); \
      const int v = id >> 3, c8 = id & 7; \
      pv[i] = *(const u32x4*)(VT + (size_t)(hh_ * d.dv + dvb_ * 128 + v) * VTS + row0_ + c8 * 8); } }
  { int u = B; if (u >= n) u = n - 1; S1_ISSUE(u); }
  for (int u0 = 0; u0 < n; u0 += G) {
    int unit = u0 + B; if (unit >= n) unit = n - 1;
    const int dvb = unit % ndvb, hl = (unit / ndvb) % d.Hg, c = unit / (ndvb * d.Hg);
    const int hh = d.H0 + hl;
#pragma unroll
    for (int i = 0; i < 4; ++i) {
      const int id = tid + 256 * i, rw = id >> 4, ch = id & 15;
      if (d.mode != 2) *(u32x4*)(Gs + rw * 128 + ch * 8) = pg[i];
      if (d.mode != 0) *(u32x4*)(Kr + rw * 128 + ch * 8) = pk[i];
      const int v = id >> 3, c8 = id & 7;
      *(u32x4*)(VTs + v * 72 + c8 * 8) = pv[i];
    }
    __syncthreads();
    if (u0 + G < n) { int un = u0 + G + B; if (un >= n) un = n - 1; S1_ISSUE(un); }
    float gv[32];
    float tsum = 0.f;
    if (d.mode == 2) { const float lg = ret_lg(hh);
#pragma unroll
      for (int j = 0; j < 32; ++j) gv[j] = lg;
      tsum = 32.f * lg;
    } else {
#pragma unroll
      for (int j = 0; j < 32; ++j) { gv[j] = bf2f(Gs[(32 * half + j) * 128 + kk]); tsum += gv[j]; }
    }
    tot[half * 128 + kk] = tsum;
    __syncthreads();
    const float cum31 = tot[kk], last = cum31 + tot[128 + kk];
    if (half == 0) {
      fac[kk] = __expf(clampe(last - cum31));
      if (dvb == 0) ((float*)(p.ws + DB_OFF))[(size_t)(c * d.Hg + hl) * 128 + kk] = __expf(last);
    }
    float crun = half ? cum31 : 0.f;
#pragma unroll
    for (int g8 = 0; g8 < 4; ++g8) {
      float km[8];
#pragma unroll
      for (int j8 = 0; j8 < 8; ++j8) {
        const int j = g8 * 8 + j8;
        crun += gv[j];
        const float kval = (d.mode == 0) ? (1.0f - __expf(gv[j])) : bf2f(Kr[(32 * half + j) * 128 + kk]);
        km[j8] = kval * __expf(clampe(cum31 - crun));
      }
      u32x4 o; o.x = pack2(km[0], km[1]); o.y = pack2(km[2], km[3]); o.z = pack2(km[4], km[5]); o.w = pack2(km[6], km[7]);
      *(u32x4*)(KmT + kk * 72 + 32 * half + 8 * g8) = o;
    }
    __syncthreads();
    f32x16 acc[4];
#pragma unroll
    for (int nn = 0; nn < 4; ++nn) acc[nn] = zero16();
#pragma unroll
    for (int ks = 0; ks < 4; ++ks) {
      const bf16x8 a = *(const bf16x8*)(VTs + (32 * wave + r) * 72 + 16 * ks + 8 * h);
#pragma unroll
      for (int nn = 0; nn < 4; ++nn) {
        const bf16x8 bb = *(const bf16x8*)(KmT + (32 * nn + r) * 72 + 16 * ks + 8 * h);
        acc[nn] = MFMA(a, bb, acc[nn]);
      }
    }
#pragma unroll
    for (int nn = 0; nn < 4; ++nn) {
      const float f = fac[32 * nn + r];
#pragma unroll
      for (int i = 0; i < 16; ++i) Gs[(32 * wave + crow(i, h)) * 128 + 32 * nn + r] = f2bf(acc[nn][i] * f);
    }
    __syncthreads();
    bf16_t* Sb = (bf16_t*)(p.ws + SB_OFF) + ((size_t)(c * d.Hg + hl) * d.dv + dvb * 128) * 128;
#pragma unroll
    for (int i = 0; i < 8; ++i) { const int id = tid + 256 * i; *(u32x4*)(Sb + id * 8) = *(const u32x4*)(Gs + id * 8); }
    __syncthreads();
  }
#undef S1_ISSUE
}

DI void scan2_phase(const Params& p, const ScanDesc& d, bool live) {
  bf16_t* Sb = (bf16_t*)(p.ws + SB_OFF);
  const float* Db = (const float*)(p.ws + DB_OFF);
  const int per_c = d.Hg * d.dv * 128;
  const int n8 = per_c >> 3;
  const int tid = tid_();
  if (tid >= 32) return;
  for (int e8 = VB_() * 32 + tid; e8 < n8; e8 += VG_() * 32) {
    const int hl = e8 / (d.dv * 16), kk = (e8 & 15) * 8;
    bf16_t* sp = Sb + (size_t)e8 * 8; const float* dp = Db + hl * 128 + kk;
    float r[8];
#pragma unroll
    for (int q = 0; q < 8; ++q) r[q] = 0.f;
    for (int c0 = 0; c0 < 256; c0 += 8) {
      u32x4 L[8]; f32x4 d0[8], d1[8];
#pragma unroll
      for (int j = 0; j < 8; ++j) {
        L[j] = *(const u32x4*)(sp + (size_t)(c0 + j) * per_c);
        d0[j] = *(const f32x4*)(dp + (size_t)(c0 + j) * d.Hg * 128); d1[j] = *(const f32x4*)(dp + (size_t)(c0 + j) * d.Hg * 128 + 4);
      }
#pragma unroll
      for (int j = 0; j < 8; ++j) {
        u32x4 o; o.x = pack2(r[0], r[1]); o.y = pack2(r[2], r[3]); o.z = pack2(r[4], r[5]); o.w = pack2(r[6], r[7]);
        if (live) *(u32x4*)(sp + (size_t)(c0 + j) * per_c) = o;
        r[0] = d0[j].x * r[0] + lo2f(L[j].x); r[1] = d0[j].y * r[1] + hi2f(L[j].x); r[2] = d0[j].z * r[2] + lo2f(L[j].y); r[3] = d0[j].w * r[3] + hi2f(L[j].y);
        r[4] = d1[j].x * r[4] + lo2f(L[j].z); r[5] = d1[j].y * r[5] + hi2f(L[j].z); r[6] = d1[j].z * r[6] + lo2f(L[j].w); r[7] = d1[j].w * r[7] + hi2f(L[j].w);
      }
    }
    if (!live && r[0] == 1.2345e-30f) sp[0] = 0;
  }
}

DI void scan3_unit(const Params& p, const ScanDesc& d, int unit, bool valid, char* smem) {
  bf16_t* Qm = (bf16_t*)smem;
  bf16_t* Km = (bf16_t*)(smem + 17408);
  bf16_t* VTs = Km;
  bf16_t* Pm = (bf16_t*)(smem + 35840);
  bf16_t* Gs = Pm;
  bf16_t* Ss = (bf16_t*)(smem + 45056);
  float* tot = (float*)(smem + 63488);
  float* e31 = (float*)(smem + 64512);
  float* red = (float*)(smem + 65024);
  const int hl = unit % d.Hg, c = unit / d.Hg;
  const int hh = d.H0 + hl, row0 = c * 64;
  const int tid = tid_(), kk = tid & 127, half = tid >> 7;
  const int wave = tid >> 6, lane = tid & 63, r = lane & 31, h = lane >> 5;
#pragma unroll
  for (int i = 0; i < 4; ++i) {
    const int id = tid + 256 * i, rw = id >> 4, ch = id & 15;
    if (d.mode != 2) *(u32x4*)(Gs + rw * 128 + ch * 8) = *(const u32x4*)(d.g + (size_t)(row0 + rw) * d.ldg + hh * 128 + ch * 8);
    if (d.mode != 0) *(u32x4*)(Km + rw * 136 + ch * 8) = *(const u32x4*)(d.k + (size_t)(row0 + rw) * d.ldp + hh * 128 + ch * 8);
    *(u32x4*)(Qm + rw * 136 + ch * 8) = *(const u32x4*)(d.q + (size_t)(row0 + rw) * d.ldp + hh * 128 + ch * 8);
  }
  __syncthreads();
  {
    float gv[32];
    float tsum = 0.f;
    if (d.mode == 2) { const float lg = ret_lg(hh);
#pragma unroll
      for (int j = 0; j < 32; ++j) gv[j] = lg;
      tsum = 32.f * lg;
    } else {
#pragma unroll
      for (int j = 0; j < 32; ++j) { gv[j] = bf2f(Gs[(32 * half + j) * 128 + kk]); tsum += gv[j]; }
    }
    tot[half * 128 + kk] = tsum;
    __syncthreads();
    const float cum31 = tot[kk];
    if (half == 0) e31[kk] = __expf(cum31);
    float crun = half ? cum31 : 0.f;
#pragma unroll
    for (int j = 0; j < 32; ++j) {
      crun += gv[j];
      const float e = clampe(crun - cum31);
      const int idx = (32 * half + j) * 136 + kk;
      const float kval = (d.mode == 0) ? (1.0f - __expf(gv[j])) : bf2f(Km[idx]);
      const float qval = bf2f(Qm[idx]);
      Qm[idx] = f2bf(qval * __expf(e));
      Km[idx] = f2bf(kval * __expf(-e));
    }
  }
  __syncthreads();
  if (wave < 3) {
    const int I = (wave >= 1), J = (wave == 2);
    f32x16 sc = zero16();
#pragma unroll
    for (int ks = 0; ks < 8; ++ks) {
      const bf16x8 a = *(const bf16x8*)(Qm + (32 * I + r) * 136 + 16 * ks + 8 * h);
      const bf16x8 b = *(const bf16x8*)(Km + (32 * J + r) * 136 + 16 * ks + 8 * h);
      sc = MFMA(a, b, sc);
    }
#pragma unroll
    for (int i = 0; i < 16; ++i) {
      const int t = crow(i, h);
      float v = sc[i];
      if (I == J) v = (r <= t) ? v : 0.f;
      Pm[(32 * I + t) * 72 + 32 * J + r] = f2bf(v);
    }
  }
  __syncthreads();
  const int ndvb = d.dv >> 7;
  f32x16 acc[2][2];
#pragma unroll
  for (int a = 0; a < 2; ++a)
#pragma unroll
    for (int b = 0; b < 2; ++b) acc[a][b] = zero16();
  const bf16_t* VT = (const bf16_t*)(p.ws + VTB_OFF);
#pragma unroll
  for (int dvb = 0; dvb < 2; ++dvb) {
    if (dvb < ndvb) {
      const bf16_t* Sg = (const bf16_t*)(p.ws + SB_OFF) + ((size_t)(c * d.Hg + hl) * d.dv + dvb * 128) * 128;
#pragma unroll
      for (int i = 0; i < 4; ++i) {
        const int id = tid + 256 * i, v = id >> 3, ch = id & 7;
        *(u32x4*)(VTs + v * 72 + ch * 8) = *(const u32x4*)(VT + (size_t)(hh * d.dv + dvb * 128 + v) * VTS + row0 + ch * 8);
      }
#pragma unroll
      for (int hk = 0; hk < 2; ++hk) {
#pragma unroll
        for (int i = 0; i < 4; ++i) {
          const int id = tid + 256 * i, v = id >> 3, ch = id & 7;
          const u32x4 sv = *(const u32x4*)(Sg + (size_t)v * 128 + hk * 64 + ch * 8);
          const float* ef = e31 + hk * 64 + ch * 8;
          u32x4 o;
          o.x = pack2(lo2f(sv.x) * ef[0], hi2f(sv.x) * ef[1]); o.y = pack2(lo2f(sv.y) * ef[2], hi2f(sv.y) * ef[3]);
          o.z = pack2(lo2f(sv.z) * ef[4], hi2f(sv.z) * ef[5]); o.w = pack2(lo2f(sv.w) * ef[6], hi2f(sv.w) * ef[7]);
          *(u32x4*)(Ss + v * 72 + ch * 8) = o;
        }
        __syncthreads();
#pragma unroll
        for (int mt2 = 0; mt2 < 2; ++mt2) {
          if (hk == 0) {
#pragma unroll
            for (int ks = 0; ks < 4; ++ks) {
              if (mt2 == 1 || ks < 2) {
                const bf16x8 a = *(const bf16x8*)(Pm + (32 * mt2 + r) * 72 + 16 * ks + 8 * h);
                const bf16x8 b = *(const bf16x8*)(VTs + (32 * wave + r) * 72 + 16 * ks + 8 * h);
                acc[dvb][mt2] = MFMA(a, b, acc[dvb][mt2]);
              }
            }
          }
#pragma unroll
          for (int ks = 0; ks < 4; ++ks) {
            const bf16x8 a = *(const bf16x8*)(Qm + (32 * mt2 + r) * 136 + hk * 64 + 16 * ks + 8 * h);
            const bf16x8 b = *(const bf16x8*)(Ss + (32 * wave + r) * 72 + 16 * ks + 8 * h);
            acc[dvb][mt2] = MFMA(a, b, acc[dvb][mt2]);
          }
        }
        __syncthreads();
      }
    }
  }
#pragma unroll
  for (int mt2 = 0; mt2 < 2; ++mt2)
#pragma unroll
    for (int i = 0; i < 16; ++i) {
      float ssq = acc[0][mt2][i] * acc[0][mt2][i];
      if (ndvb == 2) ssq += acc[1][mt2][i] * acc[1][mt2][i];
      DPP_ADD(ssq, 0xB1); DPP_ADD(ssq, 0x4E); DPP_ADD(ssq, 0x141); DPP_ADD(ssq, 0x140);
      const float s0 = __int_as_float(__builtin_amdgcn_readlane(__float_as_int(ssq), 0)) + __int_as_float(__builtin_amdgcn_readlane(__float_as_int(ssq), 16));
      const float s1 = __int_as_float(__builtin_amdgcn_readlane(__float_as_int(ssq), 32)) + __int_as_float(__builtin_amdgcn_readlane(__float_as_int(ssq), 48));
      if (r == 0) red[wave * 64 + 32 * mt2 + crow(i, h)] = h ? s1 : s0;
    }
  __syncthreads();
  const float invdv = 1.0f / (float)d.dv;
  bf16_t* Ot = Qm;
#pragma unroll
  for (int dvb = 0; dvb < 2; ++dvb) {
    if (dvb < ndvb) {
      const int v = dvb * 128 + 32 * wave + r;
      const float gn = d.gnorm ? d.gnorm[v] : 1.0f;
#pragma unroll
      for (int mt2 = 0; mt2 < 2; ++mt2)
#pragma unroll
        for (int i = 0; i < 16; ++i) {
          const int t = 32 * mt2 + crow(i, h);
          const float tsq = red[t] + red[64 + t] + red[128 + t] + red[192 + t];
          const float rstd = rsqrtf(tsq * invdv + 1e-6f);
          Ot[t * 136 + 32 * wave + r] = f2bf(acc[dvb][mt2][i] * rstd * gn);
        }
      __syncthreads();
#pragma unroll
      for (int i = 0; i < 4; ++i) {
        const int id = tid + 256 * i, t = id >> 4, ch = id & 15;
        bf16_t* gp = d.gate + (size_t)(row0 + t) * d.ldp + hh * d.dv + dvb * 128 + ch * 8;
        const u32x4 gt = *(const u32x4*)gp;
        const u32x4 ov = *(const u32x4*)(Ot + t * 136 + ch * 8);
        u32x4 o;
        o.x = pack2(lo2f(ov.x) * siluf_(lo2f(gt.x)), hi2f(ov.x) * siluf_(hi2f(gt.x)));
        o.y = pack2(lo2f(ov.y) * siluf_(lo2f(gt.y)), hi2f(ov.y) * siluf_(hi2f(gt.y)));
        o.z = pack2(lo2f(ov.z) * siluf_(lo2f(gt.z)), hi2f(ov.z) * siluf_(hi2f(gt.z)));
        o.w = pack2(lo2f(ov.w) * siluf_(lo2f(gt.w)), hi2f(ov.w) * siluf_(hi2f(gt.w)));
        if (valid) *(u32x4*)gp = o;
      }
      __syncthreads();
    }
  }
}

DI void gla_gate_phase(const Params& p) {
  const bf16_t* P = (const bf16_t*)(p.ws + PB_OFF);
  bf16_t* G = (bf16_t*)(p.ws + HB_OFF);
  const int tid = tid_();
  float w0[16], w1[16];
#pragma unroll
  for (int j = 0; j < 16; ++j) { w0[j] = p.gla_w_gk_up[j * 512 + 2 * tid]; w1[j] = p.gla_w_gk_up[j * 512 + 2 * tid + 1]; }
  const float b0 = p.gla_b_gk[2 * tid], b1 = p.gla_b_gk[2 * tid + 1];
  for (int row = VB_(); row < S; row += VG_()) {
    const u32x4 g0 = *(const u32x4*)(P + (size_t)row * 2176 + 2048), g1 = *(const u32x4*)(P + (size_t)row * 2176 + 2056);
    float gl[16];
    gl[0] = lo2f(g0.x); gl[1] = hi2f(g0.x); gl[2] = lo2f(g0.y); gl[3] = hi2f(g0.y); gl[4] = lo2f(g0.z); gl[5] = hi2f(g0.z); gl[6] = lo2f(g0.w); gl[7] = hi2f(g0.w);
    gl[8] = lo2f(g1.x); gl[9] = hi2f(g1.x); gl[10] = lo2f(g1.y); gl[11] = hi2f(g1.y); gl[12] = lo2f(g1.z); gl[13] = hi2f(g1.z); gl[14] = lo2f(g1.w); gl[15] = hi2f(g1.w);
    float z0 = b0, z1 = b1;
#pragma unroll
    for (int j = 0; j < 16; ++j) { z0 += gl[j] * w0[j]; z1 += gl[j] * w1[j]; }
    const float l0 = (fminf(z0, 0.f) - __logf(1.0f + __expf(-fabsf(z0)))) * 0.0625f;
    const float l1 = (fminf(z1, 0.f) - __logf(1.0f + __expf(-fabsf(z1)))) * 0.0625f;
    *(unsigned*)(G + (size_t)row * 512 + 2 * tid) = pack2(l0, l1);
  }
}

DI void mla_m1_item(const Params& p, int item, bool live) {
  bf16_t* P1 = (bf16_t*)(p.ws + PB_OFF);
  const int wave = tid_() >> 6, lane = tid_() & 63;
  const int row = item * 4 + wave;
  unsigned* rp = (unsigned*)(P1 + (size_t)row * 640);
  unsigned a[3]; float ss = 0.f;
#pragma unroll
  for (int j = 0; j < 3; ++j) { a[j] = rp[lane + 64 * j]; const float x0 = lo2f(a[j]), x1 = hi2f(a[j]); ss += x0 * x0 + x1 * x1; }
  const unsigned b = rp[192 + lane]; const float y0 = lo2f(b), y1 = hi2f(b);
  float s2 = y0 * y0 + y1 * y1;
  ss = wave_sum(ss); s2 = wave_sum(s2);
  const float r1 = rsqrtf(ss * (1.0f / 384.0f) + 1e-6f), r2 = rsqrtf(s2 * (1.0f / 128.0f) + 1e-6f);
  if (live || r2 == 1.2345e-30f)
#pragma unroll
  for (int j = 0; j < 3; ++j) { const int c = 2 * (lane + 64 * j); rp[lane + 64 * j] = pack2(lo2f(a[j]) * r1 * p.mla_g_q_lora[c], hi2f(a[j]) * r1 * p.mla_g_q_lora[c + 1]); }
  if (live || r1 == 1.2345e-30f) rp[192 + lane] = pack2(y0 * r2 * p.mla_g_kv_lora[2 * lane], y1 * r2 * p.mla_g_kv_lora[2 * lane + 1]);
}
DI void mla_m3_item(const Params& p, int item, bool live, char* sm) {
  const bf16_t* P1 = (const bf16_t*)(p.ws + PB_OFF);
  bf16_t* Q = (bf16_t*)(p.ws + PB_OFF + 20 * MiB);
  const bf16_t* KR = (const bf16_t*)(p.ws + PB_OFF + 68 * MiB);
  bf16_t* KF = (bf16_t*)(p.ws + SB_OFF);
  const float* ct = (const float*)(p.ws + TABM_OFF); const float* st = ct + (size_t)S * 32;
  const int wave = tid_() >> 6, lane = tid_() & 63;
  const int row = item * 4 + wave, j = lane & 31;
  bf16_t* Lq = (bf16_t*)(sm + wave * 8448);
  bf16_t* Lk = Lq + 1536;
  bf16_t* Lo = Lk + 1088;
#define M3_SYNC() { asm volatile("" ::: "memory"); __builtin_amdgcn_wave_barrier(); asm volatile("s_waitcnt lgkmcnt(0)" ::: "memory"); }
#pragma unroll
  for (int i = 0; i < 3; ++i) *(u32x4*)(Lq + (lane + 64 * i) * 8) = *(const u32x4*)(Q + (size_t)row * 1536 + (lane + 64 * i) * 8);
#pragma unroll
  for (int i = 0; i < 2; ++i) *(u32x4*)(Lk + (lane + 64 * i) * 8) = *(const u32x4*)(KR + (size_t)row * 1024 + (lane + 64 * i) * 8);
  if (lane < 8) *(u32x4*)(Lk + 1024 + lane * 8) = *(const u32x4*)(P1 + (size_t)row * 640 + 512 + lane * 8);
  const float c = ct[(size_t)row * 32 + j], s = st[(size_t)row * 32 + j];
  const float sgn = (lane < 32) ? -1.f : 1.f;
  const float qscale = 0.07216878364870322f * 1.4426950408889634f;
  const float gq0 = p.mla_g_qnorm[lane], gq1 = p.mla_g_qnorm[64 + lane], gq2 = p.mla_g_qnorm[128 + lane];
  const float gk0 = p.mla_g_knorm[lane], gk1 = p.mla_g_knorm[64 + lane], gk2 = p.mla_g_knorm[128 + lane];
  M3_SYNC();
  const float kr = bf2f(Lk[1024 + lane]);
#pragma unroll
  for (int hd = 0; hd < 8; ++hd) {
    bf16_t* qp = Lq + hd * 192;
    float v0 = bf2f(qp[lane]), v1 = bf2f(qp[64 + lane]), v2 = bf2f(qp[128 + lane]);
    float ss = wave_sum(v0 * v0 + v1 * v1 + v2 * v2);
    float rs = rsqrtf(ss * (1.0f / 192.0f) + 1e-6f);
    v0 *= rs * gq0; v1 *= rs * gq1; v2 *= rs * gq2;
    float pr = __shfl_xor(v2, 32);
    float o2 = v2 * c + sgn * pr * s;
    qp[lane] = f2bf(v0 * qscale); qp[64 + lane] = f2bf(v1 * qscale); qp[128 + lane] = f2bf(o2 * qscale);
    const bf16_t* kp = Lk + hd * 128;
    float k0 = bf2f(kp[lane]), k1 = bf2f(kp[64 + lane]), k2 = kr;
    ss = wave_sum(k0 * k0 + k1 * k1 + k2 * k2);
    rs = rsqrtf(ss * (1.0f / 192.0f) + 1e-6f);
    k0 *= rs * gk0; k1 *= rs * gk1; k2 *= rs * gk2;
    pr = __shfl_xor(k2, 32);
    o2 = k2 * c + sgn * pr * s;
    bf16_t* ko = Lo + hd * 192;
    ko[lane] = f2bf(k0); ko[64 + lane] = f2bf(k1); ko[128 + lane] = f2bf(o2);
  }
  M3_SYNC();
  if (live || c == 1.2345e-30f) {
#pragma unroll
    for (int i = 0; i < 3; ++i) {
      *(u32x4*)(Q + (size_t)row * 1536 + (lane + 64 * i) * 8) = *(const u32x4*)(Lq + (lane + 64 * i) * 8);
      *(u32x4*)(KF + (size_t)row * 1536 + (lane + 64 * i) * 8) = *(const u32x4*)(Lo + (lane + 64 * i) * 8);
    }
  }
  M3_SYNC();
#undef M3_SYNC
}

DI void attn_unit(const Params& p, int unit, char* smem) {
  bf16_t* Ks = (bf16_t*)smem;
  bf16_t* VTs = (bf16_t*)(smem + 51200);
  const bf16_t* Q = (const bf16_t*)(p.ws + PB_OFF + 20 * MiB);
  const bf16_t* KF = (const bf16_t*)(p.ws + SB_OFF);
  const bf16_t* VT = (const bf16_t*)(p.ws + VTB_OFF);
  bf16_t* AO = (bf16_t*)(p.ws + AO_OFF);
  const int hd = unit & 7, qb = (unit < 256) ? 63 - (unit >> 3) : ((unit - 256) >> 3);
  const int gt = gtid_(), wave = gt >> 6, lane = gt & 63, r = lane & 31, h = lane >> 5;
  const int qrow = qb * 256 + 32 * wave + r;
  bf16x8 qf[12];
#pragma unroll
  for (int ks = 0; ks < 12; ++ks) qf[ks] = *(const bf16x8*)(Q + (size_t)qrow * 1536 + hd * 192 + 16 * ks + 8 * h);
  const int nkt = 4 * qb + 4;
  const int kmax_w = (qb * 256 + 32 * wave + 31) >> 6;
  const int kmask_w = (qb * 256 + 32 * wave) >> 6;
  float m = -1e30f, l = 0.f;
  f32x16 oacc[4];
#pragma unroll
  for (int i = 0; i < 4; ++i) oacc[i] = zero16();
  u32x4 rk[3], rv[2];
  const bf16_t* KFh = KF + hd * 192;
  const bf16_t* VTh = VT + (size_t)(hd * 128) * VTS;
#define A_LOAD(K0) { _Pragma("unroll") for (int i = 0; i < 3; ++i) { const int id = gt + 512 * i, kr = id / 24, ch = id % 24; rk[i] = *(const u32x4*)(KFh + (size_t)((K0) + kr) * 1536 + ch * 8); } \
                     _Pragma("unroll") for (int i = 0; i < 2; ++i) { const int id = gt + 512 * i, v = id >> 3, c8 = id & 7; rv[i] = *(const u32x4*)(VTh + (size_t)v * VTS + (K0) + c8 * 8); } }
#define A_STORE(BUF) { _Pragma("unroll") for (int i = 0; i < 3; ++i) { const int id = gt + 512 * i, kr = id / 24, ch = id % 24; *(u32x4*)(Ks + (BUF) * 12800 + kr * 200 + ch * 8) = rk[i]; } \
                       _Pragma("unroll") for (int i = 0; i < 2; ++i) { const int id = gt + 512 * i, v = id >> 3, c8 = id & 7; *(u32x4*)(VTs + (BUF) * 9216 + v * 72 + c8 * 8) = rv[i]; } }
  A_LOAD(0);
  __syncthreads();
  A_STORE(0);
  __syncthreads();
  for (int kt = 0; kt < nkt; ++kt) {
    const int buf = kt & 1;
    if (kt + 1 < nkt) A_LOAD((kt + 1) * 64);
    if (kt <= kmax_w) {
      const bf16_t* Kb = Ks + buf * 12800; const bf16_t* Vb = VTs + buf * 9216;
      f32x16 sa[2]; sa[0] = zero16(); sa[1] = zero16();
#pragma unroll
      for (int ks = 0; ks < 12; ++ks) {
        const bf16x8 a0 = *(const bf16x8*)(Kb + r * 200 + 16 * ks + 8 * h);
        const bf16x8 a1 = *(const bf16x8*)(Kb + (32 + r) * 200 + 16 * ks + 8 * h);
        sa[0] = MFMA(a0, qf[ks], sa[0]); sa[1] = MFMA(a1, qf[ks], sa[1]);
      }
      if (kt >= kmask_w) {
#pragma unroll
        for (int n = 0; n < 2; ++n)
#pragma unroll
          for (int i = 0; i < 16; ++i) { const int key = kt * 64 + 32 * n + crow(i, h); if (key > qrow) sa[n][i] = -1e30f; }
      }
      float mx = -1e30f;
#pragma unroll
      for (int n = 0; n < 2; ++n)
#pragma unroll
        for (int i = 0; i < 16; ++i) mx = fmaxf(mx, sa[n][i]);
      mx = fmaxf(mx, __shfl_xor(mx, 32));
      const float mnew = fmaxf(m, mx);
      const float alpha = __builtin_amdgcn_exp2f(m - mnew);
      m = mnew;
      float rsum = 0.f;
#pragma unroll
      for (int n = 0; n < 2; ++n)
#pragma unroll
        for (int i = 0; i < 16; ++i) { const float pv = __builtin_amdgcn_exp2f(sa[n][i] - mnew); sa[n][i] = pv; rsum += pv; }
      rsum += __shfl_xor(rsum, 32);
      l = l * alpha + rsum;
#pragma unroll
      for (int mt = 0; mt < 4; ++mt) {
        if (__builtin_amdgcn_ballot_w64(alpha != 1.0f) != 0ull) {
#pragma unroll
          for (int i = 0; i < 16; ++i) oacc[mt][i] *= alpha;
        }
      }
      bf16x8 pf[4];
#pragma unroll
      for (int n = 0; n < 2; ++n)
#pragma unroll
        for (int s2 = 0; s2 < 2; ++s2) {
          u32x4 pk;
          pk.x = pack2(sa[n][8 * s2 + 0], sa[n][8 * s2 + 1]); pk.y = pack2(sa[n][8 * s2 + 2], sa[n][8 * s2 + 3]);
          pk.z = pack2(sa[n][8 * s2 + 4], sa[n][8 * s2 + 5]); pk.w = pack2(sa[n][8 * s2 + 6], sa[n][8 * s2 + 7]);
          pf[n * 2 + s2] = __builtin_bit_cast(bf16x8, pk);
        }
#pragma unroll
      for (int mt = 0; mt < 4; ++mt)
#pragma unroll
        for (int f = 0; f < 4; ++f) {
          const bf16_t* vp = Vb + (32 * mt + r) * 72 + 16 * f + 4 * h;
          const u32x2 lo = *(const u32x2*)vp, hi = *(const u32x2*)(vp + 8);
          u32x4 av; av.x = lo.x; av.y = lo.y; av.z = hi.x; av.w = hi.y;
          oacc[mt] = MFMA(__builtin_bit_cast(bf16x8, av), pf[f], oacc[mt]);
        }
    }
    if (kt + 1 < nkt) A_STORE(buf ^ 1);
    __syncthreads();
  }
#undef A_LOAD
#undef A_STORE
  const float inv = 1.0f / l;
#pragma unroll
  for (int mt = 0; mt < 4; ++mt)
#pragma unroll
    for (int g = 0; g < 4; ++g) {
      u32x2 o; o.x = pack2(oacc[mt][4 * g] * inv, oacc[mt][4 * g + 1] * inv); o.y = pack2(oacc[mt][4 * g + 2] * inv, oacc[mt][4 * g + 3] * inv);
      *(u32x2*)(AO + (size_t)qrow * 1024 + hd * 128 + 32 * mt + 8 * g + 4 * h) = o;
    }
}

enum { ST_N1 = 0, ST_IN, ST_GATE, ST_S1, ST_S2, ST_S3, ST_S1B, ST_S2B, ST_S3B, ST_M1, ST_M2, ST_M3, ST_ATT, ST_OUT, ST_N2, ST_F1, ST_F2 };
__device__ __constant__ signed char c_steps[4][13] = {
  { ST_N1, ST_IN, ST_S1, ST_S2, ST_S3, ST_OUT, ST_F1, ST_F2, -1, -1, -1, -1, -1 },
  { ST_IN, ST_GATE, ST_S1, ST_S2, ST_S3, ST_OUT, ST_F1, ST_F2, -1, -1, -1, -1, -1 },
  { ST_IN, ST_S1, ST_S2, ST_S3, ST_S1B, ST_S2B, ST_S3B, ST_OUT, ST_F1, ST_F2, -1, -1, -1 },
  { ST_IN, ST_M1, ST_M2, ST_M3, ST_ATT, ST_OUT, ST_F1, ST_F2, -1, -1, -1, -1, -1 } };
constexpr int N_PHASES = 8 + 8 + 10 + 8;

struct ConvJob { const float* src; int K, N, Np, mode; bf16_t* dst; };
DI int conv_tiles(const ConvJob& j) { return (j.Np >> 6) * (j.K >> 6); }

DI bf16_t* wm_of(const Params& p, int layer) { return (bf16_t*)(p.ws + ((layer & 1) ? WMB_OFF : WM_OFF)); }
DI bool mixer_job(const Params& p, int layer, int j, ConvJob& o) {
  bf16_t* WM = wm_of(p, layer);
  if (layer == 0) {
    if (j == 0) { o = ConvJob{ p.hgrn_w_in, 1024, 4096, 4096, 0, WM }; return true; }
    if (j == 1) { o = ConvJob{ p.hgrn_w_out, 1024, 1024, 1024, 0, WM + 4194304 }; return true; }
  } else if (layer == 1) {
    if (j == 0) { o = ConvJob{ p.gla_w_in, 1024, 3088, 3328, 0, WM }; return true; }
    if (j == 1) { o = ConvJob{ p.gla_w_out, 1024, 1024, 1024, 0, WM + 3407872 }; return true; }
  } else if (layer == 2) {
    if (j == 0) { o = ConvJob{ p.ret_w_in, 1024, 6144, 6144, 0, WM }; return true; }
    if (j == 1) { o = ConvJob{ p.ret_w_out, 2048, 1024, 1024, 0, WM + 6291456 }; return true; }
  } else {
    if (j == 0) { o = ConvJob{ p.mla_w_in, 1024, 576, 768, 0, WM }; return true; }
    if (j == 1) { o = ConvJob{ p.mla_w_uq, 384, 1536, 1536, 0, WM + 786432 }; return true; }
    if (j == 2) { o = ConvJob{ p.mla_w_ukv, 128, 2048, 2048, 0, WM + 1376256 }; return true; }
    if (j == 3) { o = ConvJob{ p.mla_w_out, 1024, 1024, 1024, 0, WM + 1638400 }; return true; }
  }
  return false;
}
DI void run_conv(const ConvJob& job, int& off, char* sm) {
  const int G = VG_(), cnt = conv_tiles(job);
  const int start = (VB_() - (off % G) + G) % G;
  for (int t0 = 0; t0 < cnt; t0 += G) {
    int t = t0 + start; if (t >= cnt) t = cnt - 1;
    conv_tile(job.src, job.K, job.N, job.mode, job.dst, t, sm);
  }
  off += cnt;
}

DI ScanDesc make_scan(const Params& p, int layer, int grp) {
  ScanDesc d;
  bf16_t* P = (bf16_t*)(p.ws + PB_OFF);
  if (layer == 0) { d.q = P; d.k = P; d.g = P + 1024; d.ldp = 3072; d.ldg = 3072; d.gate = P + 2048; d.gnorm = p.hgrn_g_norm; d.mode = 0; d.H0 = 0; d.Hg = 8; d.dv = 128; }
  else if (layer == 1) { d.q = P; d.k = P + 512; d.g = (const bf16_t*)(p.ws + HB_OFF); d.ldp = 2176; d.ldg = 512; d.gate = P + 1024; d.gnorm = p.gla_g_norm; d.mode = 1; d.H0 = 0; d.Hg = 4; d.dv = 256; }
  else { d.q = P; d.k = P + 1024; d.g = P; d.ldp = 4160; d.ldg = 4160; d.gate = P + 2048; d.gnorm = nullptr; d.mode = 2; d.H0 = 4 * grp; d.Hg = 4; d.dv = 256; }
  return d;
}

DI void run_phase(const Params& p, int layer, int step, char* smem, bool live) {
  const int G = VG_(), B = VB_();
  char* sm = smem + (B & 1) * HALF_LDS;
  bf16_t* WM = wm_of(p, layer); bf16_t* WF = (bf16_t*)(p.ws + WF_OFF);
  bf16_t* H = (bf16_t*)(p.ws + HB_OFF); bf16_t* P = (bf16_t*)(p.ws + PB_OFF);
  switch (step) {
    case ST_N1: {
      for (int it = B; it < 4096; it += G) norm_item(p.x, p.norm_mix, H, it);
      for (int it = B; it < 4096; it += G) table_item(p, it);
      for (int it = B; it < 4; it += G) lb_item(p, it);
      { float* z = (float*)(p.ws + SSQA_OFF); for (int i = B * 256 + tid_(); i < 2 * 16384; i += G * 256) z[i] = 0.f; }
      int off = 0;
      for (int j = 0; j < 2; ++j) { ConvJob job; if (mixer_job(p, 0, j, job)) run_conv(job, off, sm); }
    } break;
    case ST_GATE: gla_gate_phase(p); break;
    case ST_S1: case ST_S1B: {
      const ScanDesc d = make_scan(p, layer, step == ST_S1B);
      const int n = 256 * d.Hg * (d.dv >> 7);
      scan1_run(p, d, n, sm);
    } break;
    case ST_S2: case ST_S2B: {
      const ScanDesc d = make_scan(p, layer, step == ST_S2B); scan2_phase(p, d, live);
      if (step == ST_S2) {
        int off = 0;
        { ConvJob job{ p.ffn_w_gate_up + (size_t)layer * 1024 * 5632, 1024, 5632, 5632, 1, WF }; run_conv(job, off, sm); }
        { ConvJob job{ p.ffn_w_down + (size_t)layer * 2816 * 1024, 2816, 1024, 1024, 0, WF + 5767168 }; run_conv(job, off, sm); }
        for (int j = 0; j < 4; ++j) { ConvJob job; if (mixer_job(p, layer + 1, j, job)) run_conv(job, off, sm); }
      }
    } break;
    case ST_S3: case ST_S3B: {
      const ScanDesc d = make_scan(p, layer, step == ST_S3B);
      const int n = 256 * d.Hg;
      for (int u0 = 0; u0 < n; u0 += G) { int u = u0 + B; const bool valid = (u < n) && live; if (u >= n) u = n - 1; scan3_unit(p, d, u, valid, sm); }
    } break;
    case ST_M1: {
      for (int it = B; it < 4096; it += G) mla_m1_item(p, it, live);
      int off = 0;
      { ConvJob job{ p.ffn_w_gate_up + (size_t)layer * 1024 * 5632, 1024, 5632, 5632, 1, WF }; run_conv(job, off, sm); }
      { ConvJob job{ p.ffn_w_down + (size_t)layer * 2816 * 1024, 2816, 1024, 1024, 0, WF + 5767168 }; run_conv(job, off, sm); }
    } break;
    case ST_M3: for (int it = B; it < 4096; it += G) mla_m3_item(p, it, live, sm); break;
    case ST_ATT: for (int u = blockIdx.x; u < 512; u += gridDim.x) attn_unit(p, u, smem); break;
    case ST_IN: case ST_M2: case ST_OUT: case ST_F1: case ST_F2: {
      const bf16_t* A = H; int lda = 1024; const bf16_t* W = WM; int K = 1024, ntn = 4, gid = G_OUT;
      const bf16_t* A2 = H; int lda2 = 0; const bf16_t* W2 = WM; int K2 = 0, ntn2 = 0, gid2 = 0;
      if (step == ST_IN) {
        if (layer == 0) { ntn = 16; gid = G_HGRN_IN; } else if (layer == 1) { ntn = 13; gid = G_GLA_IN; }
        else if (layer == 2) { ntn = 24; gid = G_RET_IN; } else { ntn = 3; gid = G_MLA_IN; }
      } else if (step == ST_M2) {
        A = P; lda = 640; W = WM + 786432; K = 384; ntn = 6; gid = G_MLA_Q;
        A2 = P + 384; lda2 = 640; W2 = WM + 1376256; K2 = 128; ntn2 = 8; gid2 = G_MLA_KV;
      } else if (step == ST_OUT) {
        if (layer == 0) { A = P + 2048; lda = 3072; W = WM + 4194304; }
        else if (layer == 1) { A = P + 1024; lda = 2176; W = WM + 3407872; }
        else if (layer == 2) { A = P + 2048; lda = 4160; W = WM + 6291456; K = 2048; }
        else { A = (const bf16_t*)(p.ws + AO_OFF); W = WM + 1638400; }
      } else if (step == ST_F1) { W = WF; ntn = 22; gid = G_FFN1; }
      else { A = P; lda = 2816; W = WF + 5767168; K = 2816; gid = G_FFN2; }
      if (step == ST_IN && layer > 0) { float* z = (float*)(p.ws + SSQA_OFF); for (int i = blockIdx.x * 512 + gtid_(); i < 16384; i += gridDim.x * 512) z[i] = 0.f; }
      if (step == ST_F1) { float* z = (float*)(p.ws + SSQB_OFF); for (int i = blockIdx.x * 512 + gtid_(); i < 16384; i += gridDim.x * 512) z[i] = 0.f; }
      const int nall = ntn + ntn2, nM = 64, total = nM * nall;
      for (int t = blockIdx.x; t < total; t += gridDim.x) {
        int wg = t; { const int q = total / 8, rr = total % 8, xcd = wg % 8, o = wg / 8; wg = (xcd < rr ? xcd * (q + 1) : rr * (q + 1) + (xcd - rr) * q) + o; }
        const int nig = 8 * nall, g0 = wg / nig, fm = g0 * 8, gsz = (nM - fm) < 8 ? (nM - fm) : 8;
        const int mt = fm + (wg % nig) % gsz; int n = (wg % nig) / gsz;
        const bf16_t* Ax = A; int ldx = lda; const bf16_t* Wx = W; int Kx = K, gx = gid;
        if (n >= ntn) { n -= ntn; Ax = A2; ldx = lda2; Wx = W2; Kx = K2; gx = gid2; }
        gemm_tile(p, Ax, ldx, Wx, Kx, gx, mt, n, layer, smem);
      }
    } break;
    default: break;
  }
}

#define XB_TMO      128
#define XB_XCNT(j)  (256  + 64 * (j))
#define XB_XSUB(j)  (1280 + 64 * (j))
#define XB_XGEN(j)  (2304 + 64 * (j))
#define XB_TOP      3328
#define XB_TOPGEN   3392
#define XCD_BAR_WORDS 3456
#define XB_SPIN_CAP (1u << 18)

__device__ __forceinline__ unsigned xb_ld(unsigned* p)              { return __hip_atomic_load(p, __ATOMIC_RELAXED, __HIP_MEMORY_SCOPE_AGENT); }
__device__ __forceinline__ unsigned xb_add(unsigned* p, unsigned v) { return __hip_atomic_fetch_add(p, v, __ATOMIC_RELAXED, __HIP_MEMORY_SCOPE_AGENT); }
__device__ __forceinline__ unsigned xb_xcc_id() { return (unsigned)__builtin_amdgcn_s_getreg((3 << 11) | 20) & 0xFu; }
#define XB_SPIN(cond, bar) do { unsigned _sp = 0; while (cond) { __builtin_amdgcn_s_sleep(1); \
    if ((++_sp & 255u) == 0u) { if (xb_ld(&(bar)[XB_TMO])) break; if (_sp > XB_SPIN_CAP) { atomicAdd(&(bar)[XB_TMO], 1u); break; } } } } while (0)

struct XcdBarrier {
    unsigned* bar; unsigned x;
    volatile unsigned* st;
};

__device__ __forceinline__ XcdBarrier xcd_barrier_post(unsigned* bar, volatile unsigned* st) {
    XcdBarrier b; b.bar = bar; b.x = xb_xcc_id(); b.st = st;
    if (threadIdx.x == 0) (void)xb_add(&bar[XB_XCNT(b.x)], 1u);
    return b;
}
__device__ __forceinline__ void xcd_barrier_complete(unsigned* bar, unsigned x, unsigned& nloc, unsigned& nx) {
    const unsigned G = gridDim.x * gridDim.y * gridDim.z;
    unsigned sum, cnt, mine, sp = 0u;
    for (;;) {
        sum = 0u; cnt = 0u; mine = 0u;
#pragma unroll
        for (unsigned j = 0; j < 16; ++j) { const unsigned c = xb_ld(&bar[XB_XCNT(j)]); sum += c; cnt += (c > 0u) ? 1u : 0u; mine = (j == x) ? c : mine; }
        if (sum == G) break;
        __builtin_amdgcn_s_sleep(1);
        if ((++sp & 255u) == 0u) { if (xb_ld(&bar[XB_TMO])) break; if (sp > XB_SPIN_CAP) { atomicAdd(&bar[XB_TMO], 1u); break; } }
    }
    nloc = mine > 0u ? mine : 1u; nx = cnt > 0u ? cnt : 1u;
}

__device__ __forceinline__ void xcd_barrier(const XcdBarrier& b) {
    asm volatile("s_waitcnt vmcnt(0)" ::: "memory");
    __syncthreads();
    if (threadIdx.x == 0) {
        unsigned* bar = b.bar;
        __builtin_amdgcn_s_waitcnt(0);
        unsigned nloc = b.st[0], nx = b.st[1];
        if (nloc == 0u) { xcd_barrier_complete(bar, b.x, nloc, nx); b.st[0] = nloc; b.st[1] = nx; }
        const unsigned old = xb_add(&bar[XB_XSUB(b.x)], 1u);
        const unsigned gen = old / nloc;
        if (old + 1u == (gen + 1u) * nloc) {
            __builtin_amdgcn_fence(__ATOMIC_RELEASE, "agent");
            asm volatile("s_waitcnt vmcnt(0)" ::: "memory");
            const unsigned og = xb_add(&bar[XB_TOP], 1u);
            const unsigned tg = og / nx;
            if (og + 1u == (tg + 1u) * nx) xb_add(&bar[XB_TOPGEN], 1u);
            else XB_SPIN(xb_ld(&bar[XB_TOPGEN]) == tg, bar);
            __builtin_amdgcn_fence(__ATOMIC_ACQUIRE, "agent");
            xb_add(&bar[XB_XGEN(b.x)], 1u);
            asm volatile("s_waitcnt vmcnt(0)" ::: "memory");
        } else {
            XB_SPIN(xb_ld(&bar[XB_XGEN(b.x)]) == gen, bar);
            __builtin_amdgcn_fence(__ATOMIC_ACQUIRE, "agent");
            asm volatile("s_waitcnt vmcnt(0)" ::: "memory");
        }
    }
    __syncthreads();
}


DI void grid_barrier(unsigned* ctr, unsigned& epoch) {
  asm volatile("s_waitcnt vmcnt(0)" ::: "memory");
  __syncthreads();
  epoch += gridDim.x;
  if (threadIdx.x < 64) {
    if (threadIdx.x == 0) {
      __builtin_amdgcn_fence(__ATOMIC_RELEASE, "agent");
      asm volatile("s_waitcnt vmcnt(0)" ::: "memory");
      __hip_atomic_fetch_add(ctr, 1u, __ATOMIC_RELAXED, __HIP_MEMORY_SCOPE_AGENT);
      while (__hip_atomic_load(ctr, __ATOMIC_RELAXED, __HIP_MEMORY_SCOPE_AGENT) < epoch) __builtin_amdgcn_s_sleep(1);
    }
    __builtin_amdgcn_fence(__ATOMIC_ACQUIRE, "agent");
    asm volatile("s_waitcnt vmcnt(0)" ::: "memory");
  }
  __syncthreads();
}

__global__ void __launch_bounds__(512) fwd_megakernel(Params p, int ph_lo, int ph_hi) {
  extern __shared__ __attribute__((aligned(16))) char smem[];
  cg::grid_group grid = cg::this_grid();
  volatile unsigned* xst = (volatile unsigned*)(smem + 147456);
  if (threadIdx.x == 0) { xst[0] = 0u; xst[1] = 0u; }
  __syncthreads();
  const XcdBarrier xb = xcd_barrier_post((unsigned*)(p.ws + LB_OFF + 262144), xst);
  int ph = 0;
  for (int layer = 0; layer < 4; ++layer) {
    for (int si = 0; si < 13; ++si) {
      const int step = c_steps[layer][si];
      if (step < 0) break;
      if (ph >= ph_lo && ph < ph_hi) {
        run_phase(p, layer, step, smem, true);
        if (ph + 1 < ph_hi) { if (ph_hi > 1000) grid.sync(); else xcd_barrier(xb); }
      }
      ++ph;
    }
  }
}

extern "C" void kernel_launch(void* const* d_in, const int* in_sizes, int n_in, void* d_out, int out_size, void* d_ws, size_t ws_size, hipStream_t stream) {
  static int grid_blocks = 0;
  Params p{};
  const float** fp = (const float**)&p;
  p.x = (const float*)d_in[0]; p.pos = (const int*)d_in[1];
  for (int i = 2; i < 25; ++i) fp[i] = (const float*)d_in[i];
  p.out = (float*)d_out; p.ws = (char*)d_ws;
  int lo = 0, hi = N_PHASES;
  void* args[] = { &p, &lo, &hi };
  if (!grid_blocks) {
    int dev = 0, cus = 0;
    (void)hipGetDevice(&dev);
    (void)hipDeviceGetAttribute(&cus, hipDeviceAttributeMultiprocessorCount, dev);
    (void)hipFuncSetAttribute((const void*)fwd_megakernel, hipFuncAttributeMaxDynamicSharedMemorySize, LDS_BYTES);
    grid_blocks = cus;
  }
  (void)hipMemsetAsync((char*)d_ws + LB_OFF + 262144, 0, XCD_BAR_WORDS * 4, stream);
  hipError_t e = hipLaunchCooperativeKernel((const void*)fwd_megakernel, dim3(grid_blocks), dim3(NT), args, LDS_BYTES, stream);
  if (e != hipSuccess) fprintf(stderr, "cooperative launch failed: %s (grid %d)\n", hipGetErrorString(e), grid_blocks);
}
```

```cpp
#include <hip/hip_runtime.h>
#include <hip/hip_cooperative_groups.h>
#include <stdint.h>
#include <cstdio>
namespace cg = cooperative_groups;

typedef unsigned short bf16_t;
typedef short bf16x8 __attribute__((ext_vector_type(8)));
typedef float f32x16 __attribute__((ext_vector_type(16)));
typedef float f32x4 __attribute__((ext_vector_type(4)));
typedef float f32x2 __attribute__((ext_vector_type(2)));
typedef unsigned u32x4 __attribute__((ext_vector_type(4)));
typedef unsigned u32x2 __attribute__((ext_vector_type(2)));

#define DI __device__ __forceinline__
#define MFMA(a, b, c) __builtin_amdgcn_mfma_f32_32x32x16_bf16((a), (b), (c), 0, 0, 0)

constexpr int S = 16384;
constexpr int VTS = 16384 + 192;
constexpr int NT = 512;
constexpr int LDS_BYTES = 147456 + 16;
constexpr int HALF_LDS = 73728;
constexpr size_t MiB = 1048576;
constexpr size_t WM_OFF = 0, WF_OFF = 17 * MiB, HB_OFF = 34 * MiB, PB_OFF = 66 * MiB, VTB_OFF = 198 * MiB,
                 SB_OFF = 263 * MiB, DB_OFF = 327 * MiB, TABR_OFF = 328 * MiB, TABM_OFF = 336 * MiB, LB_OFF = 340 * MiB,
                 SSQA_OFF = LB_OFF + 8192, SSQB_OFF = LB_OFF + 8192 + 65536, WMB_OFF = 341 * MiB, AO_OFF = PB_OFF + 100 * MiB;

struct Params {
  const float* x; const int* pos; const float* norm_mix; const float* norm_ffn;
  const float* hgrn_w_in; const float* hgrn_g_norm; const float* hgrn_w_out; const float* hgrn_lb;
  const float* gla_w_in; const float* gla_w_gk_up; const float* gla_b_gk; const float* gla_g_norm; const float* gla_w_out;
  const float* ret_w_in; const float* ret_w_out;
  const float* mla_w_in; const float* mla_g_q_lora; const float* mla_g_kv_lora; const float* mla_w_uq; const float* mla_w_ukv;
  const float* mla_g_qnorm; const float* mla_g_knorm; const float* mla_w_out;
  const float* ffn_w_gate_up; const float* ffn_w_down;
  float* out; char* ws;
};

DI int tid_() { int t = threadIdx.x & 255; asm volatile("" : "+v"(t)); return t; }
DI int gtid_() { int t = threadIdx.x; asm volatile("" : "+v"(t)); return t; }
DI int VB_() { int hv = __builtin_amdgcn_readfirstlane((int)(threadIdx.x >> 8)); asm volatile("" : "+s"(hv)); return blockIdx.x * 2 + hv; }
DI int VG_() { return gridDim.x * 2; }
typedef __bf16 bf16n2 __attribute__((ext_vector_type(2)));
DI bf16_t f2bf(float x) { return __builtin_bit_cast(bf16_t, (__bf16)x); }
DI float bf2f(bf16_t b) { return __uint_as_float(((unsigned)b) << 16); }
DI unsigned pack2(float a, float b) { bf16n2 v; v[0] = (__bf16)a; v[1] = (__bf16)b; return __builtin_bit_cast(unsigned, v); }
DI float lo2f(unsigned u) { return __uint_as_float(u << 16); }
DI float hi2f(unsigned u) { return __uint_as_float(u & 0xffff0000u); }
DI int crow(int i, int h) { return (i & 3) + 8 * (i >> 2) + 4 * h; }
DI float sigmoidf_(float x) { return __builtin_amdgcn_rcpf(1.0f + __expf(-x)); }
DI float siluf_(float x) { return x * __builtin_amdgcn_rcpf(1.0f + __expf(-x)); }
DI float clampe(float e) { return fminf(fmaxf(e, -80.f), 80.f); }
#define DPP_ADD(v, ctrl) v += __int_as_float(__builtin_amdgcn_mov_dpp(__float_as_int(v), ctrl, 0xF, 0xF, true))
DI float wave_sum(float v) {
  DPP_ADD(v, 0xB1); DPP_ADD(v, 0x4E); DPP_ADD(v, 0x141); DPP_ADD(v, 0x140);
  return (__int_as_float(__builtin_amdgcn_readlane(__float_as_int(v), 0)) + __int_as_float(__builtin_amdgcn_readlane(__float_as_int(v), 16))) +
         (__int_as_float(__builtin_amdgcn_readlane(__float_as_int(v), 32)) + __int_as_float(__builtin_amdgcn_readlane(__float_as_int(v), 48)));
}
DI f32x16 zero16() { f32x16 z; for (int i = 0; i < 16; ++i) z[i] = 0.f; return z; }

DI void conv_tile(const float* __restrict__ src, int K, int N, int mode, bf16_t* __restrict__ dst, int tile, char* smem) {
  float* T = (float*)smem;
  const int nkt = K >> 6, rt = tile / nkt, kt = tile % nkt, tid = tid_();
  const int R0 = rt * 64;
  int n0 = R0;
  if (mode == 1) { const int q = R0 >> 7, t = (R0 & 127) >> 6; n0 = t * 2816 + q * 64; }
#pragma unroll
  for (int i = 0; i < 4; ++i) {
    const int id = tid + 256 * i, kr = id >> 4, c4 = id & 15;
    f32x4 v = {0.f, 0.f, 0.f, 0.f};
    if (n0 + 4 * c4 < N) v = *(const f32x4*)(src + (size_t)(kt * 64 + kr) * N + n0 + 4 * c4);
    *(f32x4*)(T + kr * 68 + 4 * c4) = v;
  }
  __syncthreads();
  const int r = tid >> 2, seg = tid & 3;
  u32x4 o0, o1;
  const float* tp = T + (seg * 16) * 68 + r;
  o0.x = pack2(tp[0 * 68], tp[1 * 68]); o0.y = pack2(tp[2 * 68], tp[3 * 68]); o0.z = pack2(tp[4 * 68], tp[5 * 68]); o0.w = pack2(tp[6 * 68], tp[7 * 68]);
  o1.x = pack2(tp[8 * 68], tp[9 * 68]); o1.y = pack2(tp[10 * 68], tp[11 * 68]); o1.z = pack2(tp[12 * 68], tp[13 * 68]); o1.w = pack2(tp[14 * 68], tp[15 * 68]);
  bf16_t* d = dst + (size_t)(R0 + r) * K + kt * 64 + seg * 16;
  *(u32x4*)d = o0; *(u32x4*)(d + 8) = o1;
  __syncthreads();
}

DI void norm_item(const float* __restrict__ x, const float* __restrict__ gain, bf16_t* __restrict__ H, int item) {
  const int wave = tid_() >> 6, lane = tid_() & 63;
  const int row = item * 4 + wave;
  const f32x4* xr = (const f32x4*)(x + (size_t)row * 1024);
  f32x4 v[4]; float ss = 0.f;
#pragma unroll
  for (int j = 0; j < 4; ++j) { v[j] = xr[lane + 64 * j]; ss += v[j].x * v[j].x + v[j].y * v[j].y + v[j].z * v[j].z + v[j].w * v[j].w; }
  ss = wave_sum(ss);
  const float rstd = rsqrtf(ss * (1.0f / 1024.0f) + 1e-6f);
  const f32x4* g4 = (const f32x4*)gain;
#pragma unroll
  for (int j = 0; j < 4; ++j) {
    const f32x4 g = g4[lane + 64 * j];
    u32x2 o; o.x = pack2(v[j].x * rstd * g.x, v[j].y * rstd * g.y); o.y = pack2(v[j].z * rstd * g.z, v[j].w * rstd * g.w);
    *(u32x2*)(H + (size_t)row * 1024 + 4 * (lane + 64 * j)) = o;
  }
}

DI void sincos_acc(float ang, float& c, float& s) {
  const double x = (double)ang;
  const double q = __builtin_rint(x * 0.63661977236758134308);
  const double y = x - q * 1.57079632679489661923;
  const double y2 = y * y;
  double sp = y * (1.0 + y2 * (-1.0 / 6 + y2 * (1.0 / 120 + y2 * (-1.0 / 5040 + y2 * (1.0 / 362880 + y2 * (-1.0 / 39916800))))));
  double cp = 1.0 + y2 * (-0.5 + y2 * (1.0 / 24 + y2 * (-1.0 / 720 + y2 * (1.0 / 40320 + y2 * (-1.0 / 3628800 + y2 * (1.0 / 479001600))))));
  const int k = ((int)q) & 3;
  double sr, cr;
  if (k == 0) { sr = sp; cr = cp; } else if (k == 1) { sr = cp; cr = -sp; } else if (k == 2) { sr = -sp; cr = -cp; } else { sr = -cp; cr = sp; }
  c = (float)cr; s = (float)sr;
}
DI void table_item(const Params& p, int item) {
  const int row = item * 4 + (tid_() >> 6), j = tid_() & 63;
  const float pf = (float)p.pos[row];
  float* tr = (float*)(p.ws + TABR_OFF); float* tm = (float*)(p.ws + TABM_OFF);
  {
    const float inv = 1.0f / exp2f((float)j * (13.287712379549449f / 64.0f));
    float c, s; sincos_acc(pf * inv, c, s);
    tr[(size_t)row * 64 + j] = c; tr[(size_t)S * 64 + (size_t)row * 64 + j] = s;
  }
  if (j < 32) {
    const float inv = 1.0f / exp2f((float)j * (13.287712379549449f / 32.0f));
    float c, s; sincos_acc(pf * inv, c, s);
    tm[(size_t)row * 32 + j] = c; tm[(size_t)S * 32 + (size_t)row * 32 + j] = s;
  }
}
DI void lb_item(const Params& p, int item) {
  const int c = item * 256 + tid_();
  float l[5], mx = -1e30f;
  for (int j = 0; j < 5; ++j) { l[j] = p.hgrn_lb[j * 1024 + c]; mx = fmaxf(mx, l[j]); }
  float sum = 0.f; for (int j = 0; j < 5; ++j) sum += __expf(l[j] - mx);
  ((float*)(p.ws + LB_OFF))[c] = __expf(l[0] - mx) / sum;
}

enum { EP_BF16 = 0, EP_SILU = 1, EP_LOGF = 2, EP_ROPE = 3, EP_VT = 4, EP_RESID = 5, EP_SWIGLU = 6, EP_NONE = 7 };
enum { G_HGRN_IN = 0, G_GLA_IN, G_RET_IN, G_MLA_IN, G_MLA_Q, G_MLA_KV, G_OUT, G_FFN1, G_FFN2 };
struct Epi { int mode; bf16_t* dst; int ld; int dcol0; float scale; const float* xin; float* xout; const float* rs_in; float* ssq_out; const float* gnext; };

DI Epi get_epi(const Params& p, int gid, int nt, int layer) {
  Epi e; e.mode = EP_BF16; e.dst = (bf16_t*)(p.ws + PB_OFF); e.ld = 0; e.dcol0 = 0; e.scale = 1.f; e.xin = nullptr; e.xout = nullptr; e.rs_in = nullptr; e.ssq_out = nullptr; e.gnext = nullptr;
  float* ssqA = (float*)(p.ws + SSQA_OFF); float* ssqB = (float*)(p.ws + SSQB_OFF);
  if (gid <= G_MLA_IN && layer > 0) e.rs_in = ssqB;
  if (gid == G_FFN1) e.rs_in = ssqA;
  bf16_t* VT = (bf16_t*)(p.ws + VTB_OFF);
  const float isq = 0.08838834764831845f;
  if (gid == G_HGRN_IN) {
    e.ld = 3072;
    if (nt < 8) { e.mode = EP_SILU; e.scale = isq; e.dcol0 = nt * 128; }
    else if (nt < 16) { e.mode = EP_LOGF; e.dcol0 = nt * 128; }
    else if (nt < 24) { e.mode = EP_VT; e.dst = VT; e.dcol0 = (nt - 16) * 128; }
    else { e.dcol0 = 2048 + (nt - 24) * 128; }
  } else if (gid == G_GLA_IN) {
    e.ld = 2176;
    if (nt < 4) { e.scale = isq; e.dcol0 = nt * 128; }
    else if (nt < 8) { e.dcol0 = nt * 128; }
    else if (nt < 16) { e.mode = EP_VT; e.dst = VT; e.dcol0 = (nt - 8) * 128; }
    else if (nt < 24) { e.dcol0 = 1024 + (nt - 16) * 128; }
    else if (nt == 24) { e.dcol0 = 2048; }
    else { e.mode = EP_NONE; }
  } else if (gid == G_RET_IN) {
    e.ld = 4160;
    if (nt < 8) { e.mode = EP_ROPE; e.dcol0 = nt * 128; }
    else if (nt < 16) { e.mode = EP_ROPE; e.scale = isq; e.dcol0 = nt * 128; }
    else if (nt < 32) { e.mode = EP_VT; e.dst = VT; e.dcol0 = (nt - 16) * 128; }
    else { e.dcol0 = 2048 + (nt - 32) * 128; }
  } else if (gid == G_MLA_IN) {
    e.ld = 640; e.dcol0 = nt * 128; if (nt >= 5) e.mode = EP_NONE;
  } else if (gid == G_MLA_Q) {
    e.dst = (bf16_t*)(p.ws + PB_OFF + 20 * MiB); e.ld = 1536; e.dcol0 = nt * 128;
  } else if (gid == G_MLA_KV) {
    if (nt & 1) { e.mode = EP_VT; e.dst = VT; e.dcol0 = (nt >> 1) * 128; }
    else { e.dst = (bf16_t*)(p.ws + PB_OFF + 68 * MiB); e.ld = 1024; e.dcol0 = (nt >> 1) * 128; }
  } else if (gid == G_OUT) {
    e.mode = EP_RESID; e.xin = (layer == 0) ? p.x : p.out; e.xout = p.out; e.dcol0 = nt * 128; e.ssq_out = ssqA; e.gnext = p.norm_ffn + layer * 1024;
  } else if (gid == G_FFN1) {
    e.mode = EP_SWIGLU; e.ld = 2816; e.dcol0 = nt * 64;
  } else {
    e.mode = EP_RESID; e.xin = p.out; e.xout = p.out; e.dcol0 = nt * 128; if (layer < 3) { e.ssq_out = ssqB; e.gnext = p.norm_mix + (layer + 1) * 1024; }
  }
  return e;
}

#define MFMA16(a, b, c) __builtin_amdgcn_mfma_f32_16x16x32_bf16((a), (b), (c), 0, 0, 0)
DI void gemm_tile(const Params& p, const bf16_t* __restrict__ A, int lda, const bf16_t* __restrict__ W, int K, int gid, int mt, int nt, int layer, char* smem) {
  const int gt = gtid_(), wave = gt >> 6, lane = gt & 63, l15 = lane & 15, q = lane >> 4, wr = wave >> 2, wc = wave & 3, grp = wc >> 1, wcl = wc & 1;
  const Epi e = get_epi(p, gid, nt * 2 + grp, layer);
  const int nk = K >> 5;
  f32x4 acc[4][2][4];
#pragma unroll
  for (int a = 0; a < 4; ++a)
#pragma unroll
    for (int b = 0; b < 2; ++b)
#pragma unroll
      for (int g = 0; g < 4; ++g) acc[a][b][g] = (f32x4){0.f, 0.f, 0.f, 0.f};
  const int lrow = lane >> 2, lch = (lane & 3) ^ ((0x78 >> (2 * (lrow >> 2))) & 3);
  const bf16_t* Ag = A + (size_t)(mt * 256 + 32 * wave + lrow) * lda + lch * 8;
  const bf16_t* Wg = W + (size_t)(nt * 256 + 32 * wave + lrow) * K + lch * 8;
  const unsigned a16 = (unsigned)(16 * lda), w16 = (unsigned)(16 * K);
  char* ldsw = smem + (32 * wave) * 64;
#define G_ISSUE(KT) { char* st_ = ldsw + ((KT) & 3) * 32768; const unsigned ko_ = (unsigned)((KT) * 32); \
    __builtin_amdgcn_global_load_lds((const unsigned*)(Ag + ko_), (unsigned*)(st_), 16, 0, 0); \
    __builtin_amdgcn_global_load_lds((const unsigned*)(Ag + a16 + ko_), (unsigned*)(st_ + 1024), 16, 0, 0); \
    __builtin_amdgcn_global_load_lds((const unsigned*)(Wg + ko_), (unsigned*)(st_ + 16384), 16, 0, 0); \
    __builtin_amdgcn_global_load_lds((const unsigned*)(Wg + w16 + ko_), (unsigned*)(st_ + 16384 + 1024), 16, 0, 0); }
#define RAW_BARRIER() { asm volatile("s_waitcnt lgkmcnt(0)" ::: "memory"); __builtin_amdgcn_s_barrier(); asm volatile("" ::: "memory"); }
  const int xo = (q ^ ((0x78 >> (2 * (l15 >> 2))) & 3)) * 16;
  const char* Afr = smem + (wr * 128 + l15) * 64 + xo;
  const char* Bfr = smem + 16384 + (grp * 128 + wcl * 32 + l15) * 64 + xo;
  RAW_BARRIER();
  G_ISSUE(0); G_ISSUE(1);
  for (int kt = 0; kt < nk; ++kt) {
    asm volatile("s_waitcnt vmcnt(4)" ::: "memory");
    RAW_BARRIER();
    const char* Ab = Afr + (kt & 3) * 32768; const char* Bb = Bfr + (kt & 3) * 32768;
    bf16x8 wf[2][2], af[4][2];
#pragma unroll
    for (int b = 0; b < 2; ++b)
#pragma unroll
      for (int t = 0; t < 2; ++t) wf[b][t] = *(const bf16x8*)(Bb + (b * 64 + t * 16) * 64);
#pragma unroll
    for (int a = 0; a < 4; ++a)
#pragma unroll
      for (int u2 = 0; u2 < 2; ++u2) af[a][u2] = *(const bf16x8*)(Ab + (a * 32 + u2 * 16) * 64);
    const int ktn = (kt + 2 < nk) ? kt + 2 : nk - 1;
    char* st_ = ldsw + ((kt + 2) & 3) * 32768; const unsigned ko_ = (unsigned)(ktn * 32);
#define MMA(a) { _Pragma("unroll") for (int u2 = 0; u2 < 2; ++u2) _Pragma("unroll") for (int b = 0; b < 2; ++b) _Pragma("unroll") for (int t = 0; t < 2; ++t) \
      acc[a][b][2 * u2 + t] = MFMA16(wf[b][t], af[a][u2], acc[a][b][2 * u2 + t]); }
#define SB() __builtin_amdgcn_sched_barrier(0)
    MMA(0); SB();
    __builtin_amdgcn_global_load_lds((const unsigned*)(Ag + ko_), (unsigned*)(st_), 16, 0, 0);
    SB(); MMA(1); SB();
    __builtin_amdgcn_global_load_lds((const unsigned*)(Ag + a16 + ko_), (unsigned*)(st_ + 1024), 16, 0, 0);
    SB(); MMA(2); SB();
    __builtin_amdgcn_global_load_lds((const unsigned*)(Wg + ko_), (unsigned*)(st_ + 16384), 16, 0, 0);
    SB(); MMA(3); SB();
    __builtin_amdgcn_global_load_lds((const unsigned*)(Wg + w16 + ko_), (unsigned*)(st_ + 16384 + 1024), 16, 0, 0);
    SB();
#undef MMA
#undef SB
  }
  asm volatile("s_waitcnt vmcnt(0)" ::: "memory");
  RAW_BARRIER();
#undef G_ISSUE
#undef RAW_BARRIER
  const int rowbase = mt * 256 + wr * 128;
  if (e.mode == EP_NONE) return;
  char* wl = smem + wave * 18432;
#define WAVE_SYNC() { asm volatile("" ::: "memory"); __builtin_amdgcn_wave_barrier(); asm volatile("s_waitcnt lgkmcnt(0)" ::: "memory"); }
#define RL(a, u2) (32 * (a) + 16 * (u2) + l15)
#define CL(t) (16 * (t) + 4 * q)
  if (e.rs_in) {
#pragma unroll
    for (int a = 0; a < 4; ++a)
#pragma unroll
      for (int u2 = 0; u2 < 2; ++u2) {
        const float rs = rsqrtf(e.rs_in[rowbase + RL(a, u2)] * (1.0f / 1024.0f) + 1e-6f);
#pragma unroll
        for (int b = 0; b < 2; ++b)
#pragma unroll
          for (int t = 0; t < 2; ++t) acc[a][b][2 * u2 + t] = acc[a][b][2 * u2 + t] * rs;
      }
  }
  if (e.mode == EP_VT) {
    bf16_t* St = (bf16_t*)wl;
#pragma unroll
    for (int a = 0; a < 4; ++a)
#pragma unroll
      for (int b = 0; b < 2; ++b)
#pragma unroll
        for (int u2 = 0; u2 < 2; ++u2)
#pragma unroll
          for (int t = 0; t < 2; ++t)
#pragma unroll
            for (int j = 0; j < 4; ++j) St[(32 * b + CL(t) + j) * 136 + RL(a, u2)] = f2bf(acc[a][b][2 * u2 + t][j]);
    WAVE_SYNC();
#pragma unroll
    for (int j = 0; j < 16; ++j) {
      const int id = lane + 64 * j, nl = id >> 4, ch = id & 15;
      const int n = 32 * wcl + 64 * (nl >> 5) + (nl & 31);
      *(u32x4*)(e.dst + (unsigned)((e.dcol0 + n) * VTS + rowbase + ch * 8)) = *(const u32x4*)(St + nl * 136 + ch * 8);
    }
    return;
  }
  if (e.mode == EP_RESID) {
    float* St = (float*)wl;
#pragma unroll
    for (int ps = 0; ps < 2; ++ps) {
#pragma unroll
      for (int a2 = 0; a2 < 2; ++a2)
#pragma unroll
        for (int b = 0; b < 2; ++b)
#pragma unroll
          for (int u2 = 0; u2 < 2; ++u2)
#pragma unroll
            for (int t = 0; t < 2; ++t) *(f32x4*)(St + RL(a2, u2) * 68 + 32 * b + CL(t)) = acc[2 * ps + a2][b][2 * u2 + t];
      WAVE_SYNC();
      const int pc = lane & 15, piece = pc >> 3, c4 = pc & 7, colx = e.dcol0 + 32 * wcl + 64 * piece + c4 * 4;
      f32x4 g4 = {1.f, 1.f, 1.f, 1.f};
      if (e.ssq_out) g4 = *(const f32x4*)(e.gnext + colx);
#pragma unroll
      for (int j = 0; j < 16; ++j) {
        const int id = lane + 64 * j, rw = id >> 4;
        const unsigned off = (unsigned)((rowbase + 64 * ps + rw) * 1024 + colx);
        const f32x4 xv = *(const f32x4*)(e.xin + off);
        const f32x4 av = *(const f32x4*)(St + rw * 68 + piece * 32 + c4 * 4);
        const f32x4 xn = xv + av;
        *(f32x4*)(e.xout + off) = xn;
        if (e.ssq_out) {
          u32x2 hb; hb.x = pack2(xn.x * g4.x, xn.y * g4.y); hb.y = pack2(xn.z * g4.z, xn.w * g4.w);
          *(u32x2*)((bf16_t*)(p.ws + HB_OFF) + off) = hb;
          float sq = xn.x * xn.x + xn.y * xn.y + xn.z * xn.z + xn.w * xn.w;
          DPP_ADD(sq, 0xB1); DPP_ADD(sq, 0x4E); DPP_ADD(sq, 0x141); DPP_ADD(sq, 0x140);
          if ((lane & 15) == 0) atomicAdd(e.ssq_out + (rowbase + 64 * ps + rw), sq);
        }
      }
      WAVE_SYNC();
    }
    return;
  }
  if (e.mode == EP_SWIGLU) {
    bf16_t* St = (bf16_t*)wl;
#pragma unroll
    for (int a = 0; a < 4; ++a)
#pragma unroll
      for (int u2 = 0; u2 < 2; ++u2)
#pragma unroll
        for (int t = 0; t < 2; ++t) {
          const f32x4 x = acc[a][0][2 * u2 + t], y = acc[a][1][2 * u2 + t];
          u32x2 o;
          o.x = pack2(siluf_(x.x) * y.x, siluf_(x.y) * y.y); o.y = pack2(siluf_(x.z) * y.z, siluf_(x.w) * y.w);
          *(u32x2*)(St + RL(a, u2) * 40 + CL(t)) = o;
        }
    WAVE_SYNC();
#pragma unroll
    for (int j = 0; j < 8; ++j) {
      const int id = lane + 64 * j, rw = id >> 2, c4 = id & 3;
      *(u32x4*)(e.dst + (unsigned)((rowbase + rw) * 2816 + e.dcol0 + 32 * wcl + c4 * 8)) = *(const u32x4*)(St + rw * 40 + c4 * 8);
    }
    return;
  }
  bf16_t* St = (bf16_t*)wl;
  if (e.mode == EP_ROPE) {
    const float* ct = (const float*)(p.ws + TABR_OFF); const float* st = ct + (size_t)S * 64;
#pragma unroll
    for (int a = 0; a < 4; ++a)
#pragma unroll
      for (int u2 = 0; u2 < 2; ++u2)
#pragma unroll
        for (int t = 0; t < 2; ++t) {
          const unsigned ti = (unsigned)((rowbase + RL(a, u2)) * 64 + 32 * wcl + CL(t));
          const f32x4 c = *(const f32x4*)(ct + ti), sn = *(const f32x4*)(st + ti);
          const f32x4 x1 = acc[a][0][2 * u2 + t], x2 = acc[a][1][2 * u2 + t];
          u32x2 o1, o2;
          o1.x = pack2((x1.x * c.x - x2.x * sn.x) * e.scale, (x1.y * c.y - x2.y * sn.y) * e.scale); o1.y = pack2((x1.z * c.z - x2.z * sn.z) * e.scale, (x1.w * c.w - x2.w * sn.w) * e.scale);
          o2.x = pack2((x2.x * c.x + x1.x * sn.x) * e.scale, (x2.y * c.y + x1.y * sn.y) * e.scale); o2.y = pack2((x2.z * c.z + x1.z * sn.z) * e.scale, (x2.w * c.w + x1.w * sn.w) * e.scale);
          *(u32x2*)(St + RL(a, u2) * 72 + CL(t)) = o1;
          *(u32x2*)(St + RL(a, u2) * 72 + 32 + CL(t)) = o2;
        }
  } else {
#pragma unroll
    for (int b = 0; b < 2; ++b)
#pragma unroll
      for (int t = 0; t < 2; ++t) {
        f32x4 lbv = {0.f, 0.f, 0.f, 0.f};
        if (e.mode == EP_LOGF) lbv = *(const f32x4*)((const float*)(p.ws + LB_OFF) + (e.dcol0 - 1024 + 32 * wcl + 64 * b + CL(t)));
#pragma unroll
        for (int a = 0; a < 4; ++a)
#pragma unroll
          for (int u2 = 0; u2 < 2; ++u2) {
            const f32x4 v = acc[a][b][2 * u2 + t];
            float v0 = v.x, v1 = v.y, v2 = v.z, v3 = v.w;
            if (e.mode == EP_SILU) { v0 = siluf_(v0) * e.scale; v1 = siluf_(v1) * e.scale; v2 = siluf_(v2) * e.scale; v3 = siluf_(v3) * e.scale; }
            else if (e.mode == EP_LOGF) {
              v0 = __logf(lbv.x + (1.f - lbv.x) * sigmoidf_(v0)); v1 = __logf(lbv.y + (1.f - lbv.y) * sigmoidf_(v1));
              v2 = __logf(lbv.z + (1.f - lbv.z) * sigmoidf_(v2)); v3 = __logf(lbv.w + (1.f - lbv.w) * sigmoidf_(v3));
            } else { v0 *= e.scale; v1 *= e.scale; v2 *= e.scale; v3 *= e.scale; }
            u32x2 o; o.x = pack2(v0, v1); o.y = pack2(v2, v3);
            *(u32x2*)(St + RL(a, u2) * 72 + 32 * b + CL(t)) = o;
          }
      }
  }
  WAVE_SYNC();
#pragma unroll
  for (int j = 0; j < 16; ++j) {
    const int id = lane + 64 * j, rw = id >> 3, pc = id & 7, piece = pc >> 2, c4 = pc & 3;
    *(u32x4*)(e.dst + (unsigned)((rowbase + rw) * e.ld + e.dcol0 + 32 * wcl + 64 * piece + c4 * 8)) = *(const u32x4*)(St + rw * 72 + piece * 32 + c4 * 8);
  }
#undef WAVE_SYNC
#undef RL
#undef CL
}

struct ScanDesc {
  const bf16_t* q; const bf16_t* k; const bf16_t* g; int ldp, ldg;
  bf16_t* gate;
  const float* gnorm;
  int mode;
  int H0, Hg, dv;
};
DI float ret_lg(int hh) { return __logf(1.0f - exp2f(-5.0f - (float)hh)); }

DI void scan1_run(const Params& p, const ScanDesc& d, int n, char* smem) {
  bf16_t* Gs = (bf16_t*)smem;
  bf16_t* Kr = (bf16_t*)(smem + 16384);
  bf16_t* KmT = (bf16_t*)(smem + 32768);
  bf16_t* VTs = (bf16_t*)(smem + 51200);
  float* tot = (float*)(smem + 69632);
  float* fac = (float*)(smem + 70656);
  const int ndvb = d.dv >> 7;
  const int G = VG_(), B = VB_();
  const int tid = tid_(), kk = tid & 127, half = tid >> 7;
  const int wave = tid >> 6, lane = tid & 63, r = lane & 31, h = lane >> 5;
  const bf16_t* VT = (const bf16_t*)(p.ws + VTB_OFF);
  u32x4 pg[4], pk[4], pv[4];
#define S1_ISSUE(U) { const int dvb_ = (U) % ndvb, hl_ = ((U) / ndvb) % d.Hg, c_ = (U) / (ndvb * d.Hg), hh_ = d.H0 + hl_, row0_ = c_ * 64; \
    _Pragma("unroll") for (int i = 0; i < 4; ++i) { const int id = tid + 256 * i, rw = id >> 4, ch = id & 15; \
      if (d.mode != 2) pg[i] = *(const u32x4*)(d.g + (size_t)(row0_ + rw) * d.ldg + hh_ * 128 + ch * 8); \
      if (d.mode != 0) pk[i] = *(const u32x4*)(d.k + (size_t)(row0_ + rw) * d.ldp + hh_ * 128 + ch * 8); \
      const int v = id >> 3, c8 = id & 7; \
      pv[i] = *(const u32x4*)(VT + (size_t)(hh_ * d.dv + dvb_ * 128 + v) * VTS + row0_ + c8 * 8); } }
  { int u = B; if (u >= n) u = n - 1; S1_ISSUE(u); }
  for (int u0 = 0; u0 < n; u0 += G) {
    int unit = u0 + B; if (unit >= n) unit = n - 1;
    const int dvb = unit % ndvb, hl = (unit / ndvb) % d.Hg, c = unit / (ndvb * d.Hg);
    const int hh = d.H0 + hl;
#pragma unroll
    for (int i = 0; i < 4; ++i) {
      const int id = tid + 256 * i, rw = id >> 4, ch = id & 15;
      if (d.mode != 2) *(u32x4*)(Gs + rw * 128 + ch * 8) = pg[i];
      if (d.mode != 0) *(u32x4*)(Kr + rw * 128 + ch * 8) = pk[i];
      const int v = id >> 3, c8 = id & 7;
      *(u32x4*)(VTs + v * 72 + c8 * 8) = pv[i];
    }
    __syncthreads();
    if (u0 + G < n) { int un = u0 + G + B; if (un >= n) un = n - 1; S1_ISSUE(un); }
    float gv[32];
    float tsum = 0.f;
    if (d.mode == 2) { const float lg = ret_lg(hh);
#pragma unroll
      for (int j = 0; j < 32; ++j) gv[j] = lg;
      tsum = 32.f * lg;
    } else {
#pragma unroll
      for (int j = 0; j < 32; ++j) { gv[j] = bf2f(Gs[(32 * half + j) * 128 + kk]); tsum += gv[j]; }
    }
    tot[half * 128 + kk] = tsum;
    __syncthreads();
    const float cum31 = tot[kk], last = cum31 + tot[128 + kk];
    if (half == 0) {
      fac[kk] = __expf(clampe(last - cum31));
      if (dvb == 0) ((float*)(p.ws + DB_OFF))[(size_t)(c * d.Hg + hl) * 128 + kk] = __expf(last);
    }
    float crun = half ? cum31 : 0.f;
#pragma unroll
    for (int g8 = 0; g8 < 4; ++g8) {
      float km[8];
#pragma unroll
      for (int j8 = 0; j8 < 8; ++j8) {
        const int j = g8 * 8 + j8;
        crun += gv[j];
        const float kval = (d.mode == 0) ? (1.0f - __expf(gv[j])) : bf2f(Kr[(32 * half + j) * 128 + kk]);
        km[j8] = kval * __expf(clampe(cum31 - crun));
      }
      u32x4 o; o.x = pack2(km[0], km[1]); o.y = pack2(km[2], km[3]); o.z = pack2(km[4], km[5]); o.w = pack2(km[6], km[7]);
      *(u32x4*)(KmT + kk * 72 + 32 * half + 8 * g8) = o;
    }
    __syncthreads();
    f32x16 acc[4];
#pragma unroll
    for (int nn = 0; nn < 4; ++nn) acc[nn] = zero16();
#pragma unroll
    for (int ks = 0; ks < 4; ++ks) {
      const bf16x8 a = *(const bf16x8*)(VTs + (32 * wave + r) * 72 + 16 * ks + 8 * h);
#pragma unroll
      for (int nn = 0; nn < 4; ++nn) {
        const bf16x8 bb = *(const bf16x8*)(KmT + (32 * nn + r) * 72 + 16 * ks + 8 * h);
        acc[nn] = MFMA(a, bb, acc[nn]);
      }
    }
#pragma unroll
    for (int nn = 0; nn < 4; ++nn) {
      const float f = fac[32 * nn + r];
#pragma unroll
      for (int i = 0; i < 16; ++i) Gs[(32 * wave + crow(i, h)) * 128 + 32 * nn + r] = f2bf(acc[nn][i] * f);
    }
    __syncthreads();
    bf16_t* Sb = (bf16_t*)(p.ws + SB_OFF) + ((size_t)(c * d.Hg + hl) * d.dv + dvb * 128) * 128;
#pragma unroll
    for (int i = 0; i < 8; ++i) { const int id = tid + 256 * i; *(u32x4*)(Sb + id * 8) = *(const u32x4*)(Gs + id * 8); }
    __syncthreads();
  }
#undef S1_ISSUE
}

DI void scan2_phase(const Params& p, const ScanDesc& d, bool live) {
  bf16_t* Sb = (bf16_t*)(p.ws + SB_OFF);
  const float* Db = (const float*)(p.ws + DB_OFF);
  const int per_c = d.Hg * d.dv * 128;
  const int n8 = per_c >> 3;
  const int tid = tid_();
  if (tid >= 32) return;
  for (int e8 = VB_() * 32 + tid; e8 < n8; e8 += VG_() * 32) {
    const int hl = e8 / (d.dv * 16), kk = (e8 & 15) * 8;
    bf16_t* sp = Sb + (size_t)e8 * 8; const float* dp = Db + hl * 128 + kk;
    float r[8];
#pragma unroll
    for (int q = 0; q < 8; ++q) r[q] = 0.f;
    for (int c0 = 0; c0 < 256; c0 += 8) {
      u32x4 L[8]; f32x4 d0[8], d1[8];
#pragma unroll
      for (int j = 0; j < 8; ++j) {
        L[j] = *(const u32x4*)(sp + (size_t)(c0 + j) * per_c);
        d0[j] = *(const f32x4*)(dp + (size_t)(c0 + j) * d.Hg * 128); d1[j] = *(const f32x4*)(dp + (size_t)(c0 + j) * d.Hg * 128 + 4);
      }
#pragma unroll
      for (int j = 0; j < 8; ++j) {
        u32x4 o; o.x = pack2(r[0], r[1]); o.y = pack2(r[2], r[3]); o.z = pack2(r[4], r[5]); o.w = pack2(r[6], r[7]);
        if (live) *(u32x4*)(sp + (size_t)(c0 + j) * per_c) = o;
        r[0] = d0[j].x * r[0] + lo2f(L[j].x); r[1] = d0[j].y * r[1] + hi2f(L[j].x); r[2] = d0[j].z * r[2] + lo2f(L[j].y); r[3] = d0[j].w * r[3] + hi2f(L[j].y);
        r[4] = d1[j].x * r[4] + lo2f(L[j].z); r[5] = d1[j].y * r[5] + hi2f(L[j].z); r[6] = d1[j].z * r[6] + lo2f(L[j].w); r[7] = d1[j].w * r[7] + hi2f(L[j].w);
      }
    }
    if (!live && r[0] == 1.2345e-30f) sp[0] = 0;
  }
}

DI void scan3_unit(const Params& p, const ScanDesc& d, int unit, bool valid, char* smem) {
  bf16_t* Qm = (bf16_t*)smem;
  bf16_t* Km = (bf16_t*)(smem + 17408);
  bf16_t* VTs = Km;
  bf16_t* Pm = (bf16_t*)(smem + 35840);
  bf16_t* Gs = Pm;
  bf16_t* Ss = (bf16_t*)(smem + 45056);
  float* tot = (float*)(smem + 63488);
  float* e31 = (float*)(smem + 64512);
  float* red = (float*)(smem + 65024);
  const int hl = unit % d.Hg, c = unit / d.Hg;
  const int hh = d.H0 + hl, row0 = c * 64;
  const int tid = tid_(), kk = tid & 127, half = tid >> 7;
  const int wave = tid >> 6, lane = tid & 63, r = lane & 31, h = lane >> 5;
#pragma unroll
  for (int i = 0; i < 4; ++i) {
    const int id = tid + 256 * i, rw = id >> 4, ch = id & 15;
    if (d.mode != 2) *(u32x4*)(Gs + rw * 128 + ch * 8) = *(const u32x4*)(d.g + (size_t)(row0 + rw) * d.ldg + hh * 128 + ch * 8);
    if (d.mode != 0) *(u32x4*)(Km + rw * 136 + ch * 8) = *(const u32x4*)(d.k + (size_t)(row0 + rw) * d.ldp + hh * 128 + ch * 8);
    *(u32x4*)(Qm + rw * 136 + ch * 8) = *(const u32x4*)(d.q + (size_t)(row0 + rw) * d.ldp + hh * 128 + ch * 8);
  }
  __syncthreads();
  {
    float gv[32];
    float tsum = 0.f;
    if (d.mode == 2) { const float lg = ret_lg(hh);
#pragma unroll
      for (int j = 0; j < 32; ++j) gv[j] = lg;
      tsum = 32.f * lg;
    } else {
#pragma unroll
      for (int j = 0; j < 32; ++j) { gv[j] = bf2f(Gs[(32 * half + j) * 128 + kk]); tsum += gv[j]; }
    }
    tot[half * 128 + kk] = tsum;
    __syncthreads();
    const float cum31 = tot[kk];
    if (half == 0) e31[kk] = __expf(cum31);
    float crun = half ? cum31 : 0.f;
#pragma unroll
    for (int j = 0; j < 32; ++j) {
      crun += gv[j];
      const float e = clampe(crun - cum31);
      const int idx = (32 * half + j) * 136 + kk;
      const float kval = (d.mode == 0) ? (1.0f - __expf(gv[j])) : bf2f(Km[idx]);
      const float qval = bf2f(Qm[idx]);
      Qm[idx] = f2bf(qval * __expf(e));
      Km[idx] = f2bf(kval * __expf(-e));
    }
  }
  __syncthreads();
  if (wave < 3) {
    const int I = (wave >= 1), J = (wave == 2);
    f32x16 sc = zero16();
#pragma unroll
    for (int ks = 0; ks < 8; ++ks) {
      const bf16x8 a = *(const bf16x8*)(Qm + (32 * I + r) * 136 + 16 * ks + 8 * h);
      const bf16x8 b = *(const bf16x8*)(Km + (32 * J + r) * 136 + 16 * ks + 8 * h);
      sc = MFMA(a, b, sc);
    }
#pragma unroll
    for (int i = 0; i < 16; ++i) {
      const int t = crow(i, h);
      float v = sc[i];
      if (I == J) v = (r <= t) ? v : 0.f;
      Pm[(32 * I + t) * 72 + 32 * J + r] = f2bf(v);
    }
  }
  __syncthreads();
  const int ndvb = d.dv >> 7;
  f32x16 acc[2][2];
#pragma unroll
  for (int a = 0; a < 2; ++a)
#pragma unroll
    for (int b = 0; b < 2; ++b) acc[a][b] = zero16();
  const bf16_t* VT = (const bf16_t*)(p.ws + VTB_OFF);
#pragma unroll
  for (int dvb = 0; dvb < 2; ++dvb) {
    if (dvb < ndvb) {
      const bf16_t* Sg = (const bf16_t*)(p.ws + SB_OFF) + ((size_t)(c * d.Hg + hl) * d.dv + dvb * 128) * 128;
#pragma unroll
      for (int i = 0; i < 4; ++i) {
        const int id = tid + 256 * i, v = id >> 3, ch = id & 7;
        *(u32x4*)(VTs + v * 72 + ch * 8) = *(const u32x4*)(VT + (size_t)(hh * d.dv + dvb * 128 + v) * VTS + row0 + ch * 8);
      }
#pragma unroll
      for (int hk = 0; hk < 2; ++hk) {
#pragma unroll
        for (int i = 0; i < 4; ++i) {
          const int id = tid + 256 * i, v = id >> 3, ch = id & 7;
          const u32x4 sv = *(const u32x4*)(Sg + (size_t)v * 128 + hk * 64 + ch * 8);
          const float* ef = e31 + hk * 64 + ch * 8;
          u32x4 o;
          o.x = pack2(lo2f(sv.x) * ef[0], hi2f(sv.x) * ef[1]); o.y = pack2(lo2f(sv.y) * ef[2], hi2f(sv.y) * ef[3]);
          o.z = pack2(lo2f(sv.z) * ef[4], hi2f(sv.z) * ef[5]); o.w = pack2(lo2f(sv.w) * ef[6], hi2f(sv.w) * ef[7]);
          *(u32x4*)(Ss + v * 72 + ch * 8) = o;
        }
        __syncthreads();
#pragma unroll
        for (int mt2 = 0; mt2 < 2; ++mt2) {
          if (hk == 0) {
#pragma unroll
            for (int ks = 0; ks < 4; ++ks) {
              if (mt2 == 1 || ks < 2) {
                const bf16x8 a = *(const bf16x8*)(Pm + (32 * mt2 + r) * 72 + 16 * ks + 8 * h);
                const bf16x8 b = *(const bf16x8*)(VTs + (32 * wave + r) * 72 + 16 * ks + 8 * h);
                acc[dvb][mt2] = MFMA(a, b, acc[dvb][mt2]);
              }
            }
          }
#pragma unroll
          for (int ks = 0; ks < 4; ++ks) {
            const bf16x8 a = *(const bf16x8*)(Qm + (32 * mt2 + r) * 136 + hk * 64 + 16 * ks + 8 * h);
            const bf16x8 b = *(const bf16x8*)(Ss + (32 * wave + r) * 72 + 16 * ks + 8 * h);
            acc[dvb][mt2] = MFMA(a, b, acc[dvb][mt2]);
          }
        }
        __syncthreads();
      }
    }
  }
#pragma unroll
  for (int mt2 = 0; mt2 < 2; ++mt2)
#pragma unroll
    for (int i = 0; i < 16; ++i) {
      float ssq = acc[0][mt2][i] * acc[0][mt2][i];
      if (ndvb == 2) ssq += acc[1][mt2][i] * acc[1][mt2][i];
      DPP_ADD(ssq, 0xB1); DPP_ADD(ssq, 0x4E); DPP_ADD(ssq, 0x141); DPP_ADD(ssq, 0x140);
      const float s0 = __int_as_float(__builtin_amdgcn_readlane(__float_as_int(ssq), 0)) + __int_as_float(__builtin_amdgcn_readlane(__float_as_int(ssq), 16));
      const float s1 = __int_as_float(__builtin_amdgcn_readlane(__float_as_int(ssq), 32)) + __int_as_float(__builtin_amdgcn_readlane(__float_as_int(ssq), 48));
      if (r == 0) red[wave * 64 + 32 * mt2 + crow(i, h)] = h ? s1 : s0;
    }
  __syncthreads();
  const float invdv = 1.0f / (float)d.dv;
  bf16_t* Ot = Qm;
#pragma unroll
  for (int dvb = 0; dvb < 2; ++dvb) {
    if (dvb < ndvb) {
      const int v = dvb * 128 + 32 * wave + r;
      const float gn = d.gnorm ? d.gnorm[v] : 1.0f;
#pragma unroll
      for (int mt2 = 0; mt2 < 2; ++mt2)
#pragma unroll
        for (int i = 0; i < 16; ++i) {
          const int t = 32 * mt2 + crow(i, h);
          const float tsq = red[t] + red[64 + t] + red[128 + t] + red[192 + t];
          const float rstd = rsqrtf(tsq * invdv + 1e-6f);
          Ot[t * 136 + 32 * wave + r] = f2bf(acc[dvb][mt2][i] * rstd * gn);
        }
      __syncthreads();
#pragma unroll
      for (int i = 0; i < 4; ++i) {
        const int id = tid + 256 * i, t = id >> 4, ch = id & 15;
        bf16_t* gp = d.gate + (size_t)(row0 + t) * d.ldp + hh * d.dv + dvb * 128 + ch * 8;
        const u32x4 gt = *(const u32x4*)gp;
        const u32x4 ov = *(const u32x4*)(Ot + t * 136 + ch * 8);
        u32x4 o;
        o.x = pack2(lo2f(ov.x) * siluf_(lo2f(gt.x)), hi2f(ov.x) * siluf_(hi2f(gt.x)));
        o.y = pack2(lo2f(ov.y) * siluf_(lo2f(gt.y)), hi2f(ov.y) * siluf_(hi2f(gt.y)));
        o.z = pack2(lo2f(ov.z) * siluf_(lo2f(gt.z)), hi2f(ov.z) * siluf_(hi2f(gt.z)));
        o.w = pack2(lo2f(ov.w) * siluf_(lo2f(gt.w)), hi2f(ov.w) * siluf_(hi2f(gt.w)));
        if (valid) *(u32x4*)gp = o;
      }
      __syncthreads();
    }
  }
}

DI void gla_gate_phase(const Params& p) {
  const bf16_t* P = (const bf16_t*)(p.ws + PB_OFF);
  bf16_t* G = (bf16_t*)(p.ws + HB_OFF);
  const int tid = tid_();
  float w0[16], w1[16];
#pragma unroll
  for (int j = 0; j < 16; ++j) { w0[j] = p.gla_w_gk_up[j * 512 + 2 * tid]; w1[j] = p.gla_w_gk_up[j * 512 + 2 * tid + 1]; }
  const float b0 = p.gla_b_gk[2 * tid], b1 = p.gla_b_gk[2 * tid + 1];
  for (int row = VB_(); row < S; row += VG_()) {
    const u32x4 g0 = *(const u32x4*)(P + (size_t)row * 2176 + 2048), g1 = *(const u32x4*)(P + (size_t)row * 2176 + 2056);
    float gl[16];
    gl[0] = lo2f(g0.x); gl[1] = hi2f(g0.x); gl[2] = lo2f(g0.y); gl[3] = hi2f(g0.y); gl[4] = lo2f(g0.z); gl[5] = hi2f(g0.z); gl[6] = lo2f(g0.w); gl[7] = hi2f(g0.w);
    gl[8] = lo2f(g1.x); gl[9] = hi2f(g1.x); gl[10] = lo2f(g1.y); gl[11] = hi2f(g1.y); gl[12] = lo2f(g1.z); gl[13] = hi2f(g1.z); gl[14] = lo2f(g1.w); gl[15] = hi2f(g1.w);
    float z0 = b0, z1 = b1;
#pragma unroll
    for (int j = 0; j < 16; ++j) { z0 += gl[j] * w0[j]; z1 += gl[j] * w1[j]; }
    const float l0 = (fminf(z0, 0.f) - __logf(1.0f + __expf(-fabsf(z0)))) * 0.0625f;
    const float l1 = (fminf(z1, 0.f) - __logf(1.0f + __expf(-fabsf(z1)))) * 0.0625f;
    *(unsigned*)(G + (size_t)row * 512 + 2 * tid) = pack2(l0, l1);
  }
}

DI void mla_m1_item(const Params& p, int item, bool live) {
  bf16_t* P1 = (bf16_t*)(p.ws + PB_OFF);
  const int wave = tid_() >> 6, lane = tid_() & 63;
  const int row = item * 4 + wave;
  unsigned* rp = (unsigned*)(P1 + (size_t)row * 640);
  unsigned a[3]; float ss = 0.f;
#pragma unroll
  for (int j = 0; j < 3; ++j) { a[j] = rp[lane + 64 * j]; const float x0 = lo2f(a[j]), x1 = hi2f(a[j]); ss += x0 * x0 + x1 * x1; }
  const unsigned b = rp[192 + lane]; const float y0 = lo2f(b), y1 = hi2f(b);
  float s2 = y0 * y0 + y1 * y1;
  ss = wave_sum(ss); s2 = wave_sum(s2);
  const float r1 = rsqrtf(ss * (1.0f / 384.0f) + 1e-6f), r2 = rsqrtf(s2 * (1.0f / 128.0f) + 1e-6f);
  if (live || r2 == 1.2345e-30f)
#pragma unroll
  for (int j = 0; j < 3; ++j) { const int c = 2 * (lane + 64 * j); rp[lane + 64 * j] = pack2(lo2f(a[j]) * r1 * p.mla_g_q_lora[c], hi2f(a[j]) * r1 * p.mla_g_q_lora[c + 1]); }
  if (live || r1 == 1.2345e-30f) rp[192 + lane] = pack2(y0 * r2 * p.mla_g_kv_lora[2 * lane], y1 * r2 * p.mla_g_kv_lora[2 * lane + 1]);
}
DI void mla_m3_item(const Params& p, int item, bool live, char* sm) {
  const bf16_t* P1 = (const bf16_t*)(p.ws + PB_OFF);
  bf16_t* Q = (bf16_t*)(p.ws + PB_OFF + 20 * MiB);
  const bf16_t* KR = (const bf16_t*)(p.ws + PB_OFF + 68 * MiB);
  bf16_t* KF = (bf16_t*)(p.ws + SB_OFF);
  const float* ct = (const float*)(p.ws + TABM_OFF); const float* st = ct + (size_t)S * 32;
  const int wave = tid_() >> 6, lane = tid_() & 63;
  const int row = item * 4 + wave, j = lane & 31;
  bf16_t* Lq = (bf16_t*)(sm + wave * 8448);
  bf16_t* Lk = Lq + 1536;
  bf16_t* Lo = Lk + 1088;
#define M3_SYNC() { asm volatile("" ::: "memory"); __builtin_amdgcn_wave_barrier(); asm volatile("s_waitcnt lgkmcnt(0)" ::: "memory"); }
#pragma unroll
  for (int i = 0; i < 3; ++i) *(u32x4*)(Lq + (lane + 64 * i) * 8) = *(const u32x4*)(Q + (size_t)row * 1536 + (lane + 64 * i) * 8);
#pragma unroll
  for (int i = 0; i < 2; ++i) *(u32x4*)(Lk + (lane + 64 * i) * 8) = *(const u32x4*)(KR + (size_t)row * 1024 + (lane + 64 * i) * 8);
  if (lane < 8) *(u32x4*)(Lk + 1024 + lane * 8) = *(const u32x4*)(P1 + (size_t)row * 640 + 512 + lane * 8);
  const float c = ct[(size_t)row * 32 + j], s = st[(size_t)row * 32 + j];
  const float sgn = (lane < 32) ? -1.f : 1.f;
  const float qscale = 0.07216878364870322f * 1.4426950408889634f;
  const float gq0 = p.mla_g_qnorm[lane], gq1 = p.mla_g_qnorm[64 + lane], gq2 = p.mla_g_qnorm[128 + lane];
  const float gk0 = p.mla_g_knorm[lane], gk1 = p.mla_g_knorm[64 + lane], gk2 = p.mla_g_knorm[128 + lane];
  M3_SYNC();
  const float kr = bf2f(Lk[1024 + lane]);
#pragma unroll
  for (int hd = 0; hd < 8; ++hd) {
    bf16_t* qp = Lq + hd * 192;
    float v0 = bf2f(qp[lane]), v1 = bf2f(qp[64 + lane]), v2 = bf2f(qp[128 + lane]);
    float ss = wave_sum(v0 * v0 + v1 * v1 + v2 * v2);
    float rs = rsqrtf(ss * (1.0f / 192.0f) + 1e-6f);
    v0 *= rs * gq0; v1 *= rs * gq1; v2 *= rs * gq2;
    float pr = __shfl_xor(v2, 32);
    float o2 = v2 * c + sgn * pr * s;
    qp[lane] = f2bf(v0 * qscale); qp[64 + lane] = f2bf(v1 * qscale); qp[128 + lane] = f2bf(o2 * qscale);
    const bf16_t* kp = Lk + hd * 128;
    float k0 = bf2f(kp[lane]), k1 = bf2f(kp[64 + lane]), k2 = kr;
    ss = wave_sum(k0 * k0 + k1 * k1 + k2 * k2);
    rs = rsqrtf(ss * (1.0f / 192.0f) + 1e-6f);
    k0 *= rs * gk0; k1 *= rs * gk1; k2 *= rs * gk2;
    pr = __shfl_xor(k2, 32);
    o2 = k2 * c + sgn * pr * s;
    bf16_t* ko = Lo + hd * 192;
    ko[lane] = f2bf(k0); ko[64 + lane] = f2bf(k1); ko[128 + lane] = f2bf(o2);
  }
  M3_SYNC();
  if (live || c == 1.2345e-30f) {
#pragma unroll
    for (int i = 0; i < 3; ++i) {
      *(u32x4*)(Q + (size_t)row * 1536 + (lane + 64 * i) * 8) = *(const u32x4*)(Lq + (lane + 64 * i) * 8);
      *(u32x4*)(KF + (size_t)row * 1536 + (lane + 64 * i) * 8) = *(const u32x4*)(Lo + (lane + 64 * i) * 8);
    }
  }
  M3_SYNC();
#undef M3_SYNC
}

DI void attn_unit(const Params& p, int unit, char* smem) {
  bf16_t* Ks = (bf16_t*)smem;
  bf16_t* VTs = (bf16_t*)(smem + 51200);
  const bf16_t* Q = (const bf16_t*)(p.ws + PB_OFF + 20 * MiB);
  const bf16_t* KF = (const bf16_t*)(p.ws + SB_OFF);
  const bf16_t* VT = (const bf16_t*)(p.ws + VTB_OFF);
  bf16_t* AO = (bf16_t*)(p.ws + AO_OFF);
  const int hd = unit & 7, qb = (unit < 256) ? 63 - (unit >> 3) : ((unit - 256) >> 3);
  const int gt = gtid_(), wave = gt >> 6, lane = gt & 63, r = lane & 31, h = lane >> 5;
  const int qrow = qb * 256 + 32 * wave + r;
  bf16x8 qf[12];
#pragma unroll
  for (int ks = 0; ks < 12; ++ks) qf[ks] = *(const bf16x8*)(Q + (size_t)qrow * 1536 + hd * 192 + 16 * ks + 8 * h);
  const int nkt = 4 * qb + 4;
  const int kmax_w = (qb * 256 + 32 * wave + 31) >> 6;
  const int kmask_w = (qb * 256 + 32 * wave) >> 6;
  float m = -1e30f, l = 0.f;
  f32x16 oacc[4];
#pragma unroll
  for (int i = 0; i < 4; ++i) oacc[i] = zero16();
  u32x4 rk[3], rv[2];
  const bf16_t* KFh = KF + hd * 192;
  const bf16_t* VTh = VT + (size_t)(hd * 128) * VTS;
#define A_LOAD(K0) { _Pragma("unroll") for (int i = 0; i < 3; ++i) { const int id = gt + 512 * i, kr = id / 24, ch = id % 24; rk[i] = *(const u32x4*)(KFh + (size_t)((K0) + kr) * 1536 + ch * 8); } \
                     _Pragma("unroll") for (int i = 0; i < 2; ++i) { const int id = gt + 512 * i, v = id >> 3, c8 = id & 7; rv[i] = *(const u32x4*)(VTh + (size_t)v * VTS + (K0) + c8 * 8); } }
#define A_STORE(BUF) { _Pragma("unroll") for (int i = 0; i < 3; ++i) { const int id = gt + 512 * i, kr = id / 24, ch = id % 24; *(u32x4*)(Ks + (BUF) * 12800 + kr * 200 + ch * 8) = rk[i]; } \
                       _Pragma("unroll") for (int i = 0; i < 2; ++i) { const int id = gt + 512 * i, v = id >> 3, c8 = id & 7; *(u32x4*)(VTs + (BUF) * 9216 + v * 72 + c8 * 8) = rv[i]; } }
  A_LOAD(0);
  __syncthreads();
  A_STORE(0);
  __syncthreads();
  for (int kt = 0; kt < nkt; ++kt) {
    const int buf = kt & 1;
    if (kt + 1 < nkt) A_LOAD((kt + 1) * 64);
    if (kt <= kmax_w) {
      const bf16_t* Kb = Ks + buf * 12800; const bf16_t* Vb = VTs + buf * 9216;
      f32x16 sa[2]; sa[0] = zero16(); sa[1] = zero16();
#pragma unroll
      for (int ks = 0; ks < 12; ++ks) {
        const bf16x8 a0 = *(const bf16x8*)(Kb + r * 200 + 16 * ks + 8 * h);
        const bf16x8 a1 = *(const bf16x8*)(Kb + (32 + r) * 200 + 16 * ks + 8 * h);
        sa[0] = MFMA(a0, qf[ks], sa[0]); sa[1] = MFMA(a1, qf[ks], sa[1]);
      }
      if (kt >= kmask_w) {
#pragma unroll
        for (int n = 0; n < 2; ++n)
#pragma unroll
          for (int i = 0; i < 16; ++i) { const int key = kt * 64 + 32 * n + crow(i, h); if (key > qrow) sa[n][i] = -1e30f; }
      }
      float mx = -1e30f;
#pragma unroll
      for (int n = 0; n < 2; ++n)
#pragma unroll
        for (int i = 0; i < 16; ++i) mx = fmaxf(mx, sa[n][i]);
      mx = fmaxf(mx, __shfl_xor(mx, 32));
      const float mnew = fmaxf(m, mx);
      const float alpha = __builtin_amdgcn_exp2f(m - mnew);
      m = mnew;
      float rsum = 0.f;
#pragma unroll
      for (int n = 0; n < 2; ++n)
#pragma unroll
        for (int i = 0; i < 16; ++i) { const float pv = __builtin_amdgcn_exp2f(sa[n][i] - mnew); sa[n][i] = pv; rsum += pv; }
      rsum += __shfl_xor(rsum, 32);
      l = l * alpha + rsum;
#pragma unroll
      for (int mt = 0; mt < 4; ++mt) {
        if (__builtin_amdgcn_ballot_w64(alpha != 1.0f) != 0ull) {
#pragma unroll
          for (int i = 0; i < 16; ++i) oacc[mt][i] *= alpha;
        }
      }
      bf16x8 pf[4];
#pragma unroll
      for (int n = 0; n < 2; ++n)
#pragma unroll
        for (int s2 = 0; s2 < 2; ++s2) {
          u32x4 pk;
          pk.x = pack2(sa[n][8 * s2 + 0], sa[n][8 * s2 + 1]); pk.y = pack2(sa[n][8 * s2 + 2], sa[n][8 * s2 + 3]);
          pk.z = pack2(sa[n][8 * s2 + 4], sa[n][8 * s2 + 5]); pk.w = pack2(sa[n][8 * s2 + 6], sa[n][8 * s2 + 7]);
          pf[n * 2 + s2] = __builtin_bit_cast(bf16x8, pk);
        }
#pragma unroll
      for (int mt = 0; mt < 4; ++mt)
#pragma unroll
        for (int f = 0; f < 4; ++f) {
          const bf16_t* vp = Vb + (32 * mt + r) * 72 + 16 * f + 4 * h;
          const u32x2 lo = *(const u32x2*)vp, hi = *(const u32x2*)(vp + 8);
          u32x4 av; av.x = lo.x; av.y = lo.y; av.z = hi.x; av.w = hi.y;
          oacc[mt] = MFMA(__builtin_bit_cast(bf16x8, av), pf[f], oacc[mt]);
        }
    }
    if (kt + 1 < nkt) A_STORE(buf ^ 1);
    __syncthreads();
  }
#undef A_LOAD
#undef A_STORE
  const float inv = 1.0f / l;
#pragma unroll
  for (int mt = 0; mt < 4; ++mt)
#pragma unroll
    for (int g = 0; g < 4; ++g) {
      u32x2 o; o.x = pack2(oacc[mt][4 * g] * inv, oacc[mt][4 * g + 1] * inv); o.y = pack2(oacc[mt][4 * g + 2] * inv, oacc[mt][4 * g + 3] * inv);
      *(u32x2*)(AO + (size_t)qrow * 1024 + hd * 128 + 32 * mt + 8 * g + 4 * h) = o;
    }
}

enum { ST_N1 = 0, ST_IN, ST_GATE, ST_S1, ST_S2, ST_S3, ST_S1B, ST_S2B, ST_S3B, ST_M1, ST_M2, ST_M3, ST_ATT, ST_OUT, ST_N2, ST_F1, ST_F2 };
__device__ __constant__ signed char c_steps[4][13] = {
  { ST_N1, ST_IN, ST_S1, ST_S2, ST_S3, ST_OUT, ST_F1, ST_F2, -1, -1, -1, -1, -1 },
  { ST_IN, ST_GATE, ST_S1, ST_S2, ST_S3, ST_OUT, ST_F1, ST_F2, -1, -1, -1, -1, -1 },
  { ST_IN, ST_S1, ST_S2, ST_S3, ST_S1B, ST_S2B, ST_S3B, ST_OUT, ST_F1, ST_F2, -1, -1, -1 },
  { ST_IN, ST_M1, ST_M2, ST_M3, ST_ATT, ST_OUT, ST_F1, ST_F2, -1, -1, -1, -1, -1 } };
constexpr int N_PHASES = 8 + 8 + 10 + 8;

struct ConvJob { const float* src; int K, N, Np, mode; bf16_t* dst; };
DI int conv_tiles(const ConvJob& j) { return (j.Np >> 6) * (j.K >> 6); }

DI bf16_t* wm_of(const Params& p, int layer) { return (bf16_t*)(p.ws + ((layer & 1) ? WMB_OFF : WM_OFF)); }
DI bool mixer_job(const Params& p, int layer, int j, ConvJob& o) {
  bf16_t* WM = wm_of(p, layer);
  if (layer == 0) {
    if (j == 0) { o = ConvJob{ p.hgrn_w_in, 1024, 4096, 4096, 0, WM }; return true; }
    if (j == 1) { o = ConvJob{ p.hgrn_w_out, 1024, 1024, 1024, 0, WM + 4194304 }; return true; }
  } else if (layer == 1) {
    if (j == 0) { o = ConvJob{ p.gla_w_in, 1024, 3088, 3328, 0, WM }; return true; }
    if (j == 1) { o = ConvJob{ p.gla_w_out, 1024, 1024, 1024, 0, WM + 3407872 }; return true; }
  } else if (layer == 2) {
    if (j == 0) { o = ConvJob{ p.ret_w_in, 1024, 6144, 6144, 0, WM }; return true; }
    if (j == 1) { o = ConvJob{ p.ret_w_out, 2048, 1024, 1024, 0, WM + 6291456 }; return true; }
  } else {
    if (j == 0) { o = ConvJob{ p.mla_w_in, 1024, 576, 768, 0, WM }; return true; }
    if (j == 1) { o = ConvJob{ p.mla_w_uq, 384, 1536, 1536, 0, WM + 786432 }; return true; }
    if (j == 2) { o = ConvJob{ p.mla_w_ukv, 128, 2048, 2048, 0, WM + 1376256 }; return true; }
    if (j == 3) { o = ConvJob{ p.mla_w_out, 1024, 1024, 1024, 0, WM + 1638400 }; return true; }
  }
  return false;
}
DI void run_conv(const ConvJob& job, int& off, char* sm) {
  const int G = VG_(), cnt = conv_tiles(job);
  const int start = (VB_() - (off % G) + G) % G;
  for (int t0 = 0; t0 < cnt; t0 += G) {
    int t = t0 + start; if (t >= cnt) t = cnt - 1;
    conv_tile(job.src, job.K, job.N, job.mode, job.dst, t, sm);
  }
  off += cnt;
}

DI ScanDesc make_scan(const Params& p, int layer, int grp) {
  ScanDesc d;
  bf16_t* P = (bf16_t*)(p.ws + PB_OFF);
  if (layer == 0) { d.q = P; d.k = P; d.g = P + 1024; d.ldp = 3072; d.ldg = 3072; d.gate = P + 2048; d.gnorm = p.hgrn_g_norm; d.mode = 0; d.H0 = 0; d.Hg = 8; d.dv = 128; }
  else if (layer == 1) { d.q = P; d.k = P + 512; d.g = (const bf16_t*)(p.ws + HB_OFF); d.ldp = 2176; d.ldg = 512; d.gate = P + 1024; d.gnorm = p.gla_g_norm; d.mode = 1; d.H0 = 0; d.Hg = 4; d.dv = 256; }
  else { d.q = P; d.k = P + 1024; d.g = P; d.ldp = 4160; d.ldg = 4160; d.gate = P + 2048; d.gnorm = nullptr; d.mode = 2; d.H0 = 4 * grp; d.Hg = 4; d.dv = 256; }
  return d;
}

DI void run_phase(const Params& p, int layer, int step, char* smem, bool live) {
  const int G = VG_(), B = VB_();
  char* sm = smem + (B & 1) * HALF_LDS;
  bf16_t* WM = wm_of(p, layer); bf16_t* WF = (bf16_t*)(p.ws + WF_OFF);
  bf16_t* H = (bf16_t*)(p.ws + HB_OFF); bf16_t* P = (bf16_t*)(p.ws + PB_OFF);
  switch (step) {
    case ST_N1: {
      for (int it = B; it < 4096; it += G) norm_item(p.x, p.norm_mix, H, it);
      for (int it = B; it < 4096; it += G) table_item(p, it);
      for (int it = B; it < 4; it += G) lb_item(p, it);
      { float* z = (float*)(p.ws + SSQA_OFF); for (int i = B * 256 + tid_(); i < 2 * 16384; i += G * 256) z[i] = 0.f; }
      int off = 0;
      for (int j = 0; j < 2; ++j) { ConvJob job; if (mixer_job(p, 0, j, job)) run_conv(job, off, sm); }
    } break;
    case ST_GATE: gla_gate_phase(p); break;
    case ST_S1: case ST_S1B: {
      const ScanDesc d = make_scan(p, layer, step == ST_S1B);
      const int n = 256 * d.Hg * (d.dv >> 7);
      scan1_run(p, d, n, sm);
    } break;
    case ST_S2: case ST_S2B: {
      const ScanDesc d = make_scan(p, layer, step == ST_S2B); scan2_phase(p, d, live);
      if (step == ST_S2) {
        int off = 0;
        { ConvJob job{ p.ffn_w_gate_up + (size_t)layer * 1024 * 5632, 1024, 5632, 5632, 1, WF }; run_conv(job, off, sm); }
        { ConvJob job{ p.ffn_w_down + (size_t)layer * 2816 * 1024, 2816, 1024, 1024, 0, WF + 5767168 }; run_conv(job, off, sm); }
        for (int j = 0; j < 4; ++j) { ConvJob job; if (mixer_job(p, layer + 1, j, job)) run_conv(job, off, sm); }
      }
    } break;
    case ST_S3: case ST_S3B: {
      const ScanDesc d = make_scan(p, layer, step == ST_S3B);
      const int n = 256 * d.Hg;
      for (int u0 = 0; u0 < n; u0 += G) { int u = u0 + B; const bool valid = (u < n) && live; if (u >= n) u = n - 1; scan3_unit(p, d, u, valid, sm); }
    } break;
    case ST_M1: {
      for (int it = B; it < 4096; it += G) mla_m1_item(p, it, live);
      int off = 0;
      { ConvJob job{ p.ffn_w_gate_up + (size_t)layer * 1024 * 5632, 1024, 5632, 5632, 1, WF }; run_conv(job, off, sm); }
      { ConvJob job{ p.ffn_w_down + (size_t)layer * 2816 * 1024, 2816, 1024, 1024, 0, WF + 5767168 }; run_conv(job, off, sm); }
    } break;
    case ST_M3: for (int it = B; it < 4096; it += G) mla_m3_item(p, it, live, sm); break;
    case ST_ATT: for (int u = blockIdx.x; u < 512; u += gridDim.x) attn_unit(p, u, smem); break;
    case ST_IN: case ST_M2: case ST_OUT: case ST_F1: case ST_F2: {
      const bf16_t* A = H; int lda = 1024; const bf16_t* W = WM; int K = 1024, ntn = 4, gid = G_OUT;
      const bf16_t* A2 = H; int lda2 = 0; const bf16_t* W2 = WM; int K2 = 0, ntn2 = 0, gid2 = 0;
      if (step == ST_IN) {
        if (layer == 0) { ntn = 16; gid = G_HGRN_IN; } else if (layer == 1) { ntn = 13; gid = G_GLA_IN; }
        else if (layer == 2) { ntn = 24; gid = G_RET_IN; } else { ntn = 3; gid = G_MLA_IN; }
      } else if (step == ST_M2) {
        A = P; lda = 640; W = WM + 786432; K = 384; ntn = 6; gid = G_MLA_Q;
        A2 = P + 384; lda2 = 640; W2 = WM + 1376256; K2 = 128; ntn2 = 8; gid2 = G_MLA_KV;
      } else if (step == ST_OUT) {
        if (layer == 0) { A = P + 2048; lda = 3072; W = WM + 4194304; }
        else if (layer == 1) { A = P + 1024; lda = 2176; W = WM + 3407872; }
        else if (layer == 2) { A = P + 2048; lda = 4160; W = WM + 6291456; K = 2048; }
        else { A = (const bf16_t*)(p.ws + AO_OFF); W = WM + 1638400; }
      } else if (step == ST_F1) { W = WF; ntn = 22; gid = G_FFN1; }
      else { A = P; lda = 2816; W = WF + 5767168; K = 2816; gid = G_FFN2; }
      if (step == ST_IN && layer > 0) { float* z = (float*)(p.ws + SSQA_OFF); for (int i = blockIdx.x * 512 + gtid_(); i < 16384; i += gridDim.x * 512) z[i] = 0.f; }
      if (step == ST_F1) { float* z = (float*)(p.ws + SSQB_OFF); for (int i = blockIdx.x * 512 + gtid_(); i < 16384; i += gridDim.x * 512) z[i] = 0.f; }
      const int nall = ntn + ntn2, nM = 64, total = nM * nall;
      for (int t = blockIdx.x; t < total; t += gridDim.x) {
        int wg = t; { const int q = total / 8, rr = total % 8, xcd = wg % 8, o = wg / 8; wg = (xcd < rr ? xcd * (q + 1) : rr * (q + 1) + (xcd - rr) * q) + o; }
        const int nig = 8 * nall, g0 = wg / nig, fm = g0 * 8, gsz = (nM - fm) < 8 ? (nM - fm) : 8;
        const int mt = fm + (wg % nig) % gsz; int n = (wg % nig) / gsz;
        const bf16_t* Ax = A; int ldx = lda; const bf16_t* Wx = W; int Kx = K, gx = gid;
        if (n >= ntn) { n -= ntn; Ax = A2; ldx = lda2; Wx = W2; Kx = K2; gx = gid2; }
        gemm_tile(p, Ax, ldx, Wx, Kx, gx, mt, n, layer, smem);
      }
    } break;
    default: break;
  }
}

#define XB_TMO      128
#define XB_XCNT(j)  (256  + 64 * (j))
#define XB_XSUB(j)  (1280 + 64 * (j))
#define XB_XGEN(j)  (2304 + 64 * (j))
#define XB_TOP      3328
#define XB_TOPGEN   3392
#define XCD_BAR_WORDS 3456
#define XB_SPIN_CAP (1u << 18)

__device__ __forceinline__ unsigned xb_ld(unsigned* p)              { return __hip_atomic_load(p, __ATOMIC_RELAXED, __HIP_MEMORY_SCOPE_AGENT); }
__device__ __forceinline__ unsigned xb_add(unsigned* p, unsigned v) { return __hip_atomic_fetch_add(p, v, __ATOMIC_RELAXED, __HIP_MEMORY_SCOPE_AGENT); }
__device__ __forceinline__ unsigned xb_xcc_id() { return (unsigned)__builtin_amdgcn_s_getreg((3 << 11) | 20) & 0xFu; }
#define XB_SPIN(cond, bar) do { unsigned _sp = 0; while (cond) { __builtin_amdgcn_s_sleep(1); \
    if ((++_sp & 255u) == 0u) { if (xb_ld(&(bar)[XB_TMO])) break; if (_sp > XB_SPIN_CAP) { atomicAdd(&(bar)[XB_TMO], 1u); break; } } } } while (0)

struct XcdBarrier {
    unsigned* bar; unsigned x;
    volatile unsigned* st;
};

__device__ __forceinline__ XcdBarrier xcd_barrier_post(unsigned* bar, volatile unsigned* st) {
    XcdBarrier b; b.bar = bar; b.x = xb_xcc_id(); b.st = st;
    if (threadIdx.x == 0) (void)xb_add(&bar[XB_XCNT(b.x)], 1u);
    return b;
}
__device__ __forceinline__ void xcd_barrier_complete(unsigned* bar, unsigned x, unsigned& nloc, unsigned& nx) {
    const unsigned G = gridDim.x * gridDim.y * gridDim.z;
    unsigned sum, cnt, mine, sp = 0u;
    for (;;) {
        sum = 0u; cnt = 0u; mine = 0u;
#pragma unroll
        for (unsigned j = 0; j < 16; ++j) { const unsigned c = xb_ld(&bar[XB_XCNT(j)]); sum += c; cnt += (c > 0u) ? 1u : 0u; mine = (j == x) ? c : mine; }
        if (sum == G) break;
        __builtin_amdgcn_s_sleep(1);
        if ((++sp & 255u) == 0u) { if (xb_ld(&bar[XB_TMO])) break; if (sp > XB_SPIN_CAP) { atomicAdd(&bar[XB_TMO], 1u); break; } }
    }
    nloc = mine > 0u ? mine : 1u; nx = cnt > 0u ? cnt : 1u;
}

__device__ __forceinline__ void xcd_barrier(const XcdBarrier& b) {
    asm volatile("s_waitcnt vmcnt(0)" ::: "memory");
    __syncthreads();
    if (threadIdx.x == 0) {
        unsigned* bar = b.bar;
        __builtin_amdgcn_s_waitcnt(0);
        unsigned nloc = b.st[0], nx = b.st[1];
        if (nloc == 0u) { xcd_barrier_complete(bar, b.x, nloc, nx); b.st[0] = nloc; b.st[1] = nx; }
        const unsigned old = xb_add(&bar[XB_XSUB(b.x)], 1u);
        const unsigned gen = old / nloc;
        if (old + 1u == (gen + 1u) * nloc) {
            __builtin_amdgcn_fence(__ATOMIC_RELEASE, "agent");
            asm volatile("s_waitcnt vmcnt(0)" ::: "memory");
            const unsigned og = xb_add(&bar[XB_TOP], 1u);
            const unsigned tg = og / nx;
            if (og + 1u == (tg + 1u) * nx) xb_add(&bar[XB_TOPGEN], 1u);
            else XB_SPIN(xb_ld(&bar[XB_TOPGEN]) == tg, bar);
            __builtin_amdgcn_fence(__ATOMIC_ACQUIRE, "agent");
            xb_add(&bar[XB_XGEN(b.x)], 1u);
            asm volatile("s_waitcnt vmcnt(0)" ::: "memory");
        } else {
            XB_SPIN(xb_ld(&bar[XB_XGEN(b.x)]) == gen, bar);
            __builtin_amdgcn_fence(__ATOMIC_ACQUIRE, "agent");
            asm volatile("s_waitcnt vmcnt(0)" ::: "memory");
        }
    }
    __syncthreads();
}


DI void grid_barrier(unsigned* ctr, unsigned& epoch) {
  asm volatile("s_waitcnt vmcnt(0)" ::: "memory");
  __syncthreads();
  epoch += gridDim.x;
  if (threadIdx.x < 64) {
    if (threadIdx.x == 0) {
      __builtin_amdgcn_fence(__ATOMIC_RELEASE, "agent");
      asm volatile("s_waitcnt vmcnt(0)" ::: "memory");
      __hip_atomic_fetch_add(ctr, 1u, __ATOMIC_RELAXED, __HIP_MEMORY_SCOPE_AGENT);
      while (__hip_atomic_load(ctr, __ATOMIC_RELAXED, __HIP_MEMORY_SCOPE_AGENT) < epoch) __builtin_amdgcn_s_sleep(1);
    }
    __builtin_amdgcn_fence(__ATOMIC_ACQUIRE, "agent");
    asm volatile("s_waitcnt vmcnt(0)" ::: "memory");
  }
  __syncthreads();
}

__global__ void __launch_bounds__(512) fwd_megakernel(Params p, int ph_lo, int ph_hi) {
  extern __shared__ __attribute__((aligned(16))) char smem[];
  cg::grid_group grid = cg::this_grid();
  volatile unsigned* xst = (volatile unsigned*)(smem + 147456);
  if (threadIdx.x == 0) { xst[0] = 0u; xst[1] = 0u; }
  __syncthreads();
  const XcdBarrier xb = xcd_barrier_post((unsigned*)(p.ws + LB_OFF + 262144), xst);
  int ph = 0;
  for (int layer = 0; layer < 4; ++layer) {
    for (int si = 0; si < 13; ++si) {
      const int step = c_steps[layer][si];
      if (step < 0) break;
      if (ph >= ph_lo && ph < ph_hi) {
        run_phase(p, layer, step, smem, true);
        if (ph + 1 < ph_hi) { if (ph_hi > 1000) grid.sync(); else xcd_barrier(xb); }
      }
      ++ph;
    }
  }
}

extern "C" void kernel_launch(void* const* d_in, const int* in_sizes, int n_in, void* d_out, int out_size, void* d_ws, size_t ws_size, hipStream_t stream) {
  static int grid_blocks = 0;
  Params p{};
  const float** fp = (const float**)&p;
  p.x = (const float*)d_in[0]; p.pos = (const int*)d_in[1];
  for (int i = 2; i < 25; ++i) fp[i] = (const float*)d_in[i];
  p.out = (float*)d_out; p.ws = (char*)d_ws;
  int lo = 0, hi = N_PHASES;
  void* args[] = { &p, &lo, &hi };
  if (!grid_blocks) {
    int dev = 0, cus = 0;
    (void)hipGetDevice(&dev);
    (void)hipDeviceGetAttribute(&cus, hipDeviceAttributeMultiprocessorCount, dev);
    (void)hipFuncSetAttribute((const void*)fwd_megakernel, hipFuncAttributeMaxDynamicSharedMemorySize, LDS_BYTES);
    grid_blocks = cus;
  }
  (void)hipMemsetAsync((char*)d_ws + LB_OFF + 262144, 0, XCD_BAR_WORDS * 4, stream);
  hipError_t e = hipLaunchCooperativeKernel((const void*)fwd_megakernel, dim3(grid_blocks), dim3(NT), args, LDS_BYTES, stream);
  if (e != hipSuccess) fprintf(stderr, "cooperative launch failed: %s (grid %d)\n", hipGetErrorString(e), grid_blocks);
}
```

```cpp
#include <hip/hip_runtime.h>
#include <hip/hip_cooperative_groups.h>
#include <stdint.h>
#include <cstdio>
namespace cg = cooperative_groups;

typedef unsigned short bf16_t;
typedef short bf16x8 __attribute__((ext_vector_type(8)));
typedef float f32x16 __attribute__((ext_vector_type(16)));
typedef float f32x4 __attribute__((ext_vector_type(4)));
typedef float f32x2 __attribute__((ext_vector_type(2)));
typedef unsigned u32x4 __attribute__((ext_vector_type(4)));
typedef unsigned u32x2 __attribute__((ext_vector_type(2)));

#define DI __device__ __forceinline__
#define MFMA(a, b, c) __builtin_amdgcn_mfma_f32_32x32x16_bf16((a), (b), (c), 0, 0, 0)

constexpr int S = 16384;
constexpr int VTS = 16384 + 192;
constexpr int NT = 512;
constexpr int LDS_BYTES = 147456 + 16;
constexpr int HALF_LDS = 73728;
constexpr int WGM = 4;
constexpr size_t MiB = 1048576;
constexpr size_t WM_OFF = 0, WF_OFF = 17 * MiB, HB_OFF = 34 * MiB, PB_OFF = 66 * MiB, VTB_OFF = 198 * MiB,
                 SB_OFF = 263 * MiB, DB_OFF = 327 * MiB, TABR_OFF = 328 * MiB, TABM_OFF = 336 * MiB, LB_OFF = 340 * MiB,
                 SSQA_OFF = LB_OFF + 8192, SSQB_OFF = LB_OFF + 8192 + 65536, WMB_OFF = 341 * MiB, AO_OFF = PB_OFF + 100 * MiB;

struct Params {
  const float* x; const int* pos; const float* norm_mix; const float* norm_ffn;
  const float* hgrn_w_in; const float* hgrn_g_norm; const float* hgrn_w_out; const float* hgrn_lb;
  const float* gla_w_in; const float* gla_w_gk_up; const float* gla_b_gk; const float* gla_g_norm; const float* gla_w_out;
  const float* ret_w_in; const float* ret_w_out;
  const float* mla_w_in; const float* mla_g_q_lora; const float* mla_g_kv_lora; const float* mla_w_uq; const float* mla_w_ukv;
  const float* mla_g_qnorm; const float* mla_g_knorm; const float* mla_w_out;
  const float* ffn_w_gate_up; const float* ffn_w_down;
  float* out; char* ws;
};

DI int tid_() { int t = threadIdx.x & 255; asm volatile("" : "+v"(t)); return t; }
DI int gtid_() { int t = threadIdx.x; asm volatile("" : "+v"(t)); return t; }
DI int VB_() { int hv = __builtin_amdgcn_readfirstlane((int)(threadIdx.x >> 8)); asm volatile("" : "+s"(hv)); return blockIdx.x * 2 + hv; }
DI int VG_() { return gridDim.x * 2; }
typedef __bf16 bf16n2 __attribute__((ext_vector_type(2)));
DI bf16_t f2bf(float x) { return __builtin_bit_cast(bf16_t, (__bf16)x); }
DI float bf2f(bf16_t b) { return __uint_as_float(((unsigned)b) << 16); }
DI unsigned pack2(float a, float b) { bf16n2 v; v[0] = (__bf16)a; v[1] = (__bf16)b; return __builtin_bit_cast(unsigned, v); }
DI float lo2f(unsigned u) { return __uint_as_float(u << 16); }
DI float hi2f(unsigned u) { return __uint_as_float(u & 0xffff0000u); }
DI int crow(int i, int h) { return (i & 3) + 8 * (i >> 2) + 4 * h; }
DI float sigmoidf_(float x) { return __builtin_amdgcn_rcpf(1.0f + __expf(-x)); }
DI float siluf_(float x) { return x * __builtin_amdgcn_rcpf(1.0f + __expf(-x)); }
DI float clampe(float e) { return fminf(fmaxf(e, -80.f), 80.f); }
#define DPP_ADD(v, ctrl) v += __int_as_float(__builtin_amdgcn_mov_dpp(__float_as_int(v), ctrl, 0xF, 0xF, true))
DI float wave_sum(float v) {
  DPP_ADD(v, 0xB1); DPP_ADD(v, 0x4E); DPP_ADD(v, 0x141); DPP_ADD(v, 0x140);
  return (__int_as_float(__builtin_amdgcn_readlane(__float_as_int(v), 0)) + __int_as_float(__builtin_amdgcn_readlane(__float_as_int(v), 16))) +
         (__int_as_float(__builtin_amdgcn_readlane(__float_as_int(v), 32)) + __int_as_float(__builtin_amdgcn_readlane(__float_as_int(v), 48)));
}
DI f32x16 zero16() { f32x16 z; for (int i = 0; i < 16; ++i) z[i] = 0.f; return z; }

DI void conv_tile(const float* __restrict__ src, int K, int N, int mode, bf16_t* __restrict__ dst, int tile, char* smem) {
  float* T = (float*)smem;
  const int nkt = K >> 6, rt = tile / nkt, kt = tile % nkt, tid = tid_();
  const int R0 = rt * 64;
  int n0 = R0;
  if (mode == 1) { const int q = R0 >> 7, t = (R0 & 127) >> 6; n0 = t * 2816 + q * 64; }
#pragma unroll
  for (int i = 0; i < 4; ++i) {
    const int id = tid + 256 * i, kr = id >> 4, c4 = id & 15;
    f32x4 v = {0.f, 0.f, 0.f, 0.f};
    if (n0 + 4 * c4 < N) v = *(const f32x4*)(src + (size_t)(kt * 64 + kr) * N + n0 + 4 * c4);
    *(f32x4*)(T + kr * 68 + 4 * c4) = v;
  }
  __syncthreads();
  const int r = tid >> 2, seg = tid & 3;
  u32x4 o0, o1;
  const float* tp = T + (seg * 16) * 68 + r;
  o0.x = pack2(tp[0 * 68], tp[1 * 68]); o0.y = pack2(tp[2 * 68], tp[3 * 68]); o0.z = pack2(tp[4 * 68], tp[5 * 68]); o0.w = pack2(tp[6 * 68], tp[7 * 68]);
  o1.x = pack2(tp[8 * 68], tp[9 * 68]); o1.y = pack2(tp[10 * 68], tp[11 * 68]); o1.z = pack2(tp[12 * 68], tp[13 * 68]); o1.w = pack2(tp[14 * 68], tp[15 * 68]);
  bf16_t* d = dst + (size_t)(R0 + r) * K + kt * 64 + seg * 16;
  *(u32x4*)d = o0; *(u32x4*)(d + 8) = o1;
  __syncthreads();
}

DI void norm_item(const float* __restrict__ x, const float* __restrict__ gain, bf16_t* __restrict__ H, int item) {
  const int wave = tid_() >> 6, lane = tid_() & 63;
  const int row = item * 4 + wave;
  const f32x4* xr = (const f32x4*)(x + (size_t)row * 1024);
  f32x4 v[4]; float ss = 0.f;
#pragma unroll
  for (int j = 0; j < 4; ++j) { v[j] = xr[lane + 64 * j]; ss += v[j].x * v[j].x + v[j].y * v[j].y + v[j].z * v[j].z + v[j].w * v[j].w; }
  ss = wave_sum(ss);
  const float rstd = rsqrtf(ss * (1.0f / 1024.0f) + 1e-6f);
  const f32x4* g4 = (const f32x4*)gain;
#pragma unroll
  for (int j = 0; j < 4; ++j) {
    const f32x4 g = g4[lane + 64 * j];
    u32x2 o; o.x = pack2(v[j].x * rstd * g.x, v[j].y * rstd * g.y); o.y = pack2(v[j].z * rstd * g.z, v[j].w * rstd * g.w);
    *(u32x2*)(H + (size_t)row * 1024 + 4 * (lane + 64 * j)) = o;
  }
}

DI void sincos_acc(float ang, float& c, float& s) {
  const double x = (double)ang;
  const double q = __builtin_rint(x * 0.63661977236758134308);
  const double y = x - q * 1.57079632679489661923;
  const double y2 = y * y;
  double sp = y * (1.0 + y2 * (-1.0 / 6 + y2 * (1.0 / 120 + y2 * (-1.0 / 5040 + y2 * (1.0 / 362880 + y2 * (-1.0 / 39916800))))));
  double cp = 1.0 + y2 * (-0.5 + y2 * (1.0 / 24 + y2 * (-1.0 / 720 + y2 * (1.0 / 40320 + y2 * (-1.0 / 3628800 + y2 * (1.0 / 479001600))))));
  const int k = ((int)q) & 3;
  double sr, cr;
  if (k == 0) { sr = sp; cr = cp; } else if (k == 1) { sr = cp; cr = -sp; } else if (k == 2) { sr = -sp; cr = -cp; } else { sr = -cp; cr = sp; }
  c = (float)cr; s = (float)sr;
}
DI void table_item(const Params& p, int item) {
  const int row = item * 4 + (tid_() >> 6), j = tid_() & 63;
  const float pf = (float)p.pos[row];
  float* tr = (float*)(p.ws + TABR_OFF); float* tm = (float*)(p.ws + TABM_OFF);
  {
    const float inv = 1.0f / exp2f((float)j * (13.287712379549449f / 64.0f));
    float c, s; sincos_acc(pf * inv, c, s);
    tr[(size_t)row * 64 + j] = c; tr[(size_t)S * 64 + (size_t)row * 64 + j] = s;
  }
  if (j < 32) {
    const float inv = 1.0f / exp2f((float)j * (13.287712379549449f / 32.0f));
    float c, s; sincos_acc(pf * inv, c, s);
    tm[(size_t)row * 32 + j] = c; tm[(size_t)S * 32 + (size_t)row * 32 + j] = s;
  }
}
DI void lb_item(const Params& p, int item) {
  const int c = item * 256 + tid_();
  float l[5], mx = -1e30f;
  for (int j = 0; j < 5; ++j) { l[j] = p.hgrn_lb[j * 1024 + c]; mx = fmaxf(mx, l[j]); }
  float sum = 0.f; for (int j = 0; j < 5; ++j) sum += __expf(l[j] - mx);
  ((float*)(p.ws + LB_OFF))[c] = __expf(l[0] - mx) / sum;
}

enum { EP_BF16 = 0, EP_SILU = 1, EP_LOGF = 2, EP_ROPE = 3, EP_VT = 4, EP_RESID = 5, EP_SWIGLU = 6, EP_NONE = 7 };
enum { G_HGRN_IN = 0, G_GLA_IN, G_RET_IN, G_MLA_IN, G_MLA_Q, G_MLA_KV, G_OUT, G_FFN1, G_FFN2 };
struct Epi { int mode; bf16_t* dst; int ld; int dcol0; float scale; const float* xin; float* xout; const float* rs_in; float* ssq_out; const float* gnext; };

DI Epi get_epi(const Params& p, int gid, int nt, int layer) {
  Epi e; e.mode = EP_BF16; e.dst = (bf16_t*)(p.ws + PB_OFF); e.ld = 0; e.dcol0 = 0; e.scale = 1.f; e.xin = nullptr; e.xout = nullptr; e.rs_in = nullptr; e.ssq_out = nullptr; e.gnext = nullptr;
  float* ssqA = (float*)(p.ws + SSQA_OFF); float* ssqB = (float*)(p.ws + SSQB_OFF);
  if (gid <= G_MLA_IN && layer > 0) e.rs_in = ssqB;
  if (gid == G_FFN1) e.rs_in = ssqA;
  bf16_t* VT = (bf16_t*)(p.ws + VTB_OFF);
  const float isq = 0.08838834764831845f;
  if (gid == G_HGRN_IN) {
    e.ld = 3072;
    if (nt < 8) { e.mode = EP_SILU; e.scale = isq; e.dcol0 = nt * 128; }
    else if (nt < 16) { e.mode = EP_LOGF; e.dcol0 = nt * 128; }
    else if (nt < 24) { e.mode = EP_VT; e.dst = VT; e.dcol0 = (nt - 16) * 128; }
    else { e.dcol0 = 2048 + (nt - 24) * 128; }
  } else if (gid == G_GLA_IN) {
    e.ld = 2176;
    if (nt < 4) { e.scale = isq; e.dcol0 = nt * 128; }
    else if (nt < 8) { e.dcol0 = nt * 128; }
    else if (nt < 16) { e.mode = EP_VT; e.dst = VT; e.dcol0 = (nt - 8) * 128; }
    else if (nt < 24) { e.dcol0 = 1024 + (nt - 16) * 128; }
    else if (nt == 24) { e.dcol0 = 2048; }
    else { e.mode = EP_NONE; }
  } else if (gid == G_RET_IN) {
    e.ld = 4160;
    if (nt < 8) { e.mode = EP_ROPE; e.dcol0 = nt * 128; }
    else if (nt < 16) { e.mode = EP_ROPE; e.scale = isq; e.dcol0 = nt * 128; }
    else if (nt < 32) { e.mode = EP_VT; e.dst = VT; e.dcol0 = (nt - 16) * 128; }
    else { e.dcol0 = 2048 + (nt - 32) * 128; }
  } else if (gid == G_MLA_IN) {
    e.ld = 640; e.dcol0 = nt * 128; if (nt >= 5) e.mode = EP_NONE;
  } else if (gid == G_MLA_Q) {
    e.dst = (bf16_t*)(p.ws + PB_OFF + 20 * MiB); e.ld = 1536; e.dcol0 = nt * 128;
  } else if (gid == G_MLA_KV) {
    if (nt & 1) { e.mode = EP_VT; e.dst = VT; e.dcol0 = (nt >> 1) * 128; }
    else { e.dst = (bf16_t*)(p.ws + PB_OFF + 68 * MiB); e.ld = 1024; e.dcol0 = (nt >> 1) * 128; }
  } else if (gid == G_OUT) {
    e.mode = EP_RESID; e.xin = (layer == 0) ? p.x : p.out; e.xout = p.out; e.dcol0 = nt * 128; e.ssq_out = ssqA; e.gnext = p.norm_ffn + layer * 1024;
  } else if (gid == G_FFN1) {
    e.mode = EP_SWIGLU; e.ld = 2816; e.dcol0 = nt * 64;
  } else {
    e.mode = EP_RESID; e.xin = p.out; e.xout = p.out; e.dcol0 = nt * 128; if (layer < 3) { e.ssq_out = ssqB; e.gnext = p.norm_mix + (layer + 1) * 1024; }
  }
  return e;
}

#define MFMA16(a, b, c) __builtin_amdgcn_mfma_f32_16x16x32_bf16((a), (b), (c), 0, 0, 0)
DI void gemm_tile(const Params& p, const bf16_t* __restrict__ A, int lda, const bf16_t* __restrict__ W, int K, int gid, int mt, int nt, int layer, char* smem) {
  const int gt = gtid_(), wave = gt >> 6, lane = gt & 63, l15 = lane & 15, q = lane >> 4, wr = wave >> 2, wc = wave & 3, grp = wc >> 1, wcl = wc & 1;
  const Epi e = get_epi(p, gid, nt * 2 + grp, layer);
  const int nk = K >> 5;
  f32x4 acc[4][2][4];
#pragma unroll
  for (int a = 0; a < 4; ++a)
#pragma unroll
    for (int b = 0; b < 2; ++b)
#pragma unroll
      for (int g = 0; g < 4; ++g) acc[a][b][g] = (f32x4){0.f, 0.f, 0.f, 0.f};
  const int lrow = lane >> 2, lch = (lane & 3) ^ ((0x78 >> (2 * (lrow >> 2))) & 3);
  const bf16_t* Ag = A + (size_t)(mt * 256 + 32 * wave + lrow) * lda + lch * 8;
  const bf16_t* Wg = W + (size_t)(nt * 256 + 32 * wave + lrow) * K + lch * 8;
  const unsigned a16 = (unsigned)(16 * lda), w16 = (unsigned)(16 * K);
  char* ldsw = smem + (32 * wave) * 64;
#define G_ISSUE(KT) { char* st_ = ldsw + ((KT) & 3) * 32768; const unsigned ko_ = (unsigned)((KT) * 32); \
    __builtin_amdgcn_global_load_lds((const unsigned*)(Ag + ko_), (unsigned*)(st_), 16, 0, 0); \
    __builtin_amdgcn_global_load_lds((const unsigned*)(Ag + a16 + ko_), (unsigned*)(st_ + 1024), 16, 0, 0); \
    __builtin_amdgcn_global_load_lds((const unsigned*)(Wg + ko_), (unsigned*)(st_ + 16384), 16, 0, 0); \
    __builtin_amdgcn_global_load_lds((const unsigned*)(Wg + w16 + ko_), (unsigned*)(st_ + 16384 + 1024), 16, 0, 0); }
#define RAW_BARRIER() { asm volatile("s_waitcnt lgkmcnt(0)" ::: "memory"); __builtin_amdgcn_s_barrier(); asm volatile("" ::: "memory"); }
  const int xo = (q ^ ((0x78 >> (2 * (l15 >> 2))) & 3)) * 16;
  const char* Afr = smem + (wr * 128 + l15) * 64 + xo;
  const char* Bfr = smem + 16384 + (grp * 128 + wcl * 32 + l15) * 64 + xo;
  RAW_BARRIER();
  G_ISSUE(0); G_ISSUE(1);
  for (int kt = 0; kt < nk; ++kt) {
    asm volatile("s_waitcnt vmcnt(4)" ::: "memory");
    RAW_BARRIER();
    const char* Ab = Afr + (kt & 3) * 32768; const char* Bb = Bfr + (kt & 3) * 32768;
    bf16x8 wf[2][2], af[4][2];
#pragma unroll
    for (int b = 0; b < 2; ++b)
#pragma unroll
      for (int t = 0; t < 2; ++t) wf[b][t] = *(const bf16x8*)(Bb + (b * 64 + t * 16) * 64);
#pragma unroll
    for (int a = 0; a < 4; ++a)
#pragma unroll
      for (int u2 = 0; u2 < 2; ++u2) af[a][u2] = *(const bf16x8*)(Ab + (a * 32 + u2 * 16) * 64);
    const int ktn = (kt + 2 < nk) ? kt + 2 : nk - 1;
    char* st_ = ldsw + ((kt + 2) & 3) * 32768; const unsigned ko_ = (unsigned)(ktn * 32);
#define MMA(a) { _Pragma("unroll") for (int u2 = 0; u2 < 2; ++u2) _Pragma("unroll") for (int b = 0; b < 2; ++b) _Pragma("unroll") for (int t = 0; t < 2; ++t) \
      acc[a][b][2 * u2 + t] = MFMA16(wf[b][t], af[a][u2], acc[a][b][2 * u2 + t]); }
#define SB() __builtin_amdgcn_sched_barrier(0)
    MMA(0); SB();
    __builtin_amdgcn_global_load_lds((const unsigned*)(Ag + ko_), (unsigned*)(st_), 16, 0, 0);
    SB(); MMA(1); SB();
    __builtin_amdgcn_global_load_lds((const unsigned*)(Ag + a16 + ko_), (unsigned*)(st_ + 1024), 16, 0, 0);
    SB(); MMA(2); SB();
    __builtin_amdgcn_global_load_lds((const unsigned*)(Wg + ko_), (unsigned*)(st_ + 16384), 16, 0, 0);
    SB(); MMA(3); SB();
    __builtin_amdgcn_global_load_lds((const unsigned*)(Wg + w16 + ko_), (unsigned*)(st_ + 16384 + 1024), 16, 0, 0);
    SB();
#undef MMA
#undef SB
  }
  asm volatile("s_waitcnt vmcnt(0)" ::: "memory");
  RAW_BARRIER();
#undef G_ISSUE
#undef RAW_BARRIER
  const int rowbase = mt * 256 + wr * 128;
  if (e.mode == EP_NONE) return;
  char* wl = smem + wave * 18432;
#define WAVE_SYNC() { asm volatile("" ::: "memory"); __builtin_amdgcn_wave_barrier(); asm volatile("s_waitcnt lgkmcnt(0)" ::: "memory"); }
#define RL(a, u2) (32 * (a) + 16 * (u2) + l15)
#define CL(t) (16 * (t) + 4 * q)
  if (e.rs_in) {
#pragma unroll
    for (int a = 0; a < 4; ++a)
#pragma unroll
      for (int u2 = 0; u2 < 2; ++u2) {
        const float rs = rsqrtf(e.rs_in[rowbase + RL(a, u2)] * (1.0f / 1024.0f) + 1e-6f);
#pragma unroll
        for (int b = 0; b < 2; ++b)
#pragma unroll
          for (int t = 0; t < 2; ++t) acc[a][b][2 * u2 + t] = acc[a][b][2 * u2 + t] * rs;
      }
  }
  if (e.mode == EP_VT) {
    bf16_t* St = (bf16_t*)wl;
#pragma unroll
    for (int a = 0; a < 4; ++a)
#pragma unroll
      for (int b = 0; b < 2; ++b)
#pragma unroll
        for (int u2 = 0; u2 < 2; ++u2)
#pragma unroll
          for (int t = 0; t < 2; ++t)
#pragma unroll
            for (int j = 0; j < 4; ++j) St[(32 * b + CL(t) + j) * 136 + RL(a, u2)] = f2bf(acc[a][b][2 * u2 + t][j]);
    WAVE_SYNC();
#pragma unroll
    for (int j = 0; j < 16; ++j) {
      const int id = lane + 64 * j, nl = id >> 4, ch = id & 15;
      const int n = 32 * wcl + 64 * (nl >> 5) + (nl & 31);
      *(u32x4*)(e.dst + (unsigned)((e.dcol0 + n) * VTS + rowbase + ch * 8)) = *(const u32x4*)(St + nl * 136 + ch * 8);
    }
    return;
  }
  if (e.mode == EP_RESID) {
    float* St = (float*)wl;
#pragma unroll
    for (int ps = 0; ps < 2; ++ps) {
#pragma unroll
      for (int a2 = 0; a2 < 2; ++a2)
#pragma unroll
        for (int b = 0; b < 2; ++b)
#pragma unroll
          for (int u2 = 0; u2 < 2; ++u2)
#pragma unroll
            for (int t = 0; t < 2; ++t) *(f32x4*)(St + RL(a2, u2) * 68 + 32 * b + CL(t)) = acc[2 * ps + a2][b][2 * u2 + t];
      WAVE_SYNC();
      const int pc = lane & 15, piece = pc >> 3, c4 = pc & 7, colx = e.dcol0 + 32 * wcl + 64 * piece + c4 * 4;
      f32x4 g4 = {1.f, 1.f, 1.f, 1.f};
      if (e.ssq_out) g4 = *(const f32x4*)(e.gnext + colx);
#pragma unroll
      for (int j = 0; j < 16; ++j) {
        const int id = lane + 64 * j, rw = id >> 4;
        const unsigned off = (unsigned)((rowbase + 64 * ps + rw) * 1024 + colx);
        const f32x4 xv = *(const f32x4*)(e.xin + off);
        const f32x4 av = *(const f32x4*)(St + rw * 68 + piece * 32 + c4 * 4);
        const f32x4 xn = xv + av;
        *(f32x4*)(e.xout + off) = xn;
        if (e.ssq_out) {
          u32x2 hb; hb.x = pack2(xn.x * g4.x, xn.y * g4.y); hb.y = pack2(xn.z * g4.z, xn.w * g4.w);
          *(u32x2*)((bf16_t*)(p.ws + HB_OFF) + off) = hb;
          float sq = xn.x * xn.x + xn.y * xn.y + xn.z * xn.z + xn.w * xn.w;
          DPP_ADD(sq, 0xB1); DPP_ADD(sq, 0x4E); DPP_ADD(sq, 0x141); DPP_ADD(sq, 0x140);
          if ((lane & 15) == 0) atomicAdd(e.ssq_out + (rowbase + 64 * ps + rw), sq);
        }
      }
      WAVE_SYNC();
    }
    return;
  }
  if (e.mode == EP_SWIGLU) {
    bf16_t* St = (bf16_t*)wl;
#pragma unroll
    for (int a = 0; a < 4; ++a)
#pragma unroll
      for (int u2 = 0; u2 < 2; ++u2)
#pragma unroll
        for (int t = 0; t < 2; ++t) {
          const f32x4 x = acc[a][0][2 * u2 + t], y = acc[a][1][2 * u2 + t];
          u32x2 o;
          o.x = pack2(siluf_(x.x) * y.x, siluf_(x.y) * y.y); o.y = pack2(siluf_(x.z) * y.z, siluf_(x.w) * y.w);
          *(u32x2*)(St + RL(a, u2) * 40 + CL(t)) = o;
        }
    WAVE_SYNC();
#pragma unroll
    for (int j = 0; j < 8; ++j) {
      const int id = lane + 64 * j, rw = id >> 2, c4 = id & 3;
      *(u32x4*)(e.dst + (unsigned)((rowbase + rw) * 2816 + e.dcol0 + 32 * wcl + c4 * 8)) = *(const u32x4*)(St + rw * 40 + c4 * 8);
    }
    return;
  }
  bf16_t* St = (bf16_t*)wl;
  if (e.mode == EP_ROPE) {
    const float* ct = (const float*)(p.ws + TABR_OFF); const float* st = ct + (size_t)S * 64;
#pragma unroll
    for (int a = 0; a < 4; ++a)
#pragma unroll
      for (int u2 = 0; u2 < 2; ++u2)
#pragma unroll
        for (int t = 0; t < 2; ++t) {
          const unsigned ti = (unsigned)((rowbase + RL(a, u2)) * 64 + 32 * wcl + CL(t));
          const f32x4 c = *(const f32x4*)(ct + ti), sn = *(const f32x4*)(st + ti);
          const f32x4 x1 = acc[a][0][2 * u2 + t], x2 = acc[a][1][2 * u2 + t];
          u32x2 o1, o2;
          o1.x = pack2((x1.x * c.x - x2.x * sn.x) * e.scale, (x1.y * c.y - x2.y * sn.y) * e.scale); o1.y = pack2((x1.z * c.z - x2.z * sn.z) * e.scale, (x1.w * c.w - x2.w * sn.w) * e.scale);
          o2.x = pack2((x2.x * c.x + x1.x * sn.x) * e.scale, (x2.y * c.y + x1.y * sn.y) * e.scale); o2.y = pack2((x2.z * c.z + x1.z * sn.z) * e.scale, (x2.w * c.w + x1.w * sn.w) * e.scale);
          *(u32x2*)(St + RL(a, u2) * 72 + CL(t)) = o1;
          *(u32x2*)(St + RL(a, u2) * 72 + 32 + CL(t)) = o2;
        }
  } else {
#pragma unroll
    for (int b = 0; b < 2; ++b)
#pragma unroll
      for (int t = 0; t < 2; ++t) {
        f32x4 lbv = {0.f, 0.f, 0.f, 0.f};
        if (e.mode == EP_LOGF) lbv = *(const f32x4*)((const float*)(p.ws + LB_OFF) + (e.dcol0 - 1024 + 32 * wcl + 64 * b + CL(t)));
#pragma unroll
        for (int a = 0; a < 4; ++a)
#pragma unroll
          for (int u2 = 0; u2 < 2; ++u2) {
            const f32x4 v = acc[a][b][2 * u2 + t];
            float v0 = v.x, v1 = v.y, v2 = v.z, v3 = v.w;
            if (e.mode == EP_SILU) { v0 = siluf_(v0) * e.scale; v1 = siluf_(v1) * e.scale; v2 = siluf_(v2) * e.scale; v3 = siluf_(v3) * e.scale; }
            else if (e.mode == EP_LOGF) {
              v0 = __logf(lbv.x + (1.f - lbv.x) * sigmoidf_(v0)); v1 = __logf(lbv.y + (1.f - lbv.y) * sigmoidf_(v1));
              v2 = __logf(lbv.z + (1.f - lbv.z) * sigmoidf_(v2)); v3 = __logf(lbv.w + (1.f - lbv.w) * sigmoidf_(v3));
            } else { v0 *= e.scale; v1 *= e.scale; v2 *= e.scale; v3 *= e.scale; }
            u32x2 o; o.x = pack2(v0, v1); o.y = pack2(v2, v3);
            *(u32x2*)(St + RL(a, u2) * 72 + 32 * b + CL(t)) = o;
          }
      }
  }
  WAVE_SYNC();
#pragma unroll
  for (int j = 0; j < 16; ++j) {
    const int id = lane + 64 * j, rw = id >> 3, pc = id & 7, piece = pc >> 2, c4 = pc & 3;
    *(u32x4*)(e.dst + (unsigned)((rowbase + rw) * e.ld + e.dcol0 + 32 * wcl + 64 * piece + c4 * 8)) = *(const u32x4*)(St + rw * 72 + piece * 32 + c4 * 8);
  }
#undef WAVE_SYNC
#undef RL
#undef CL
}

struct ScanDesc {
  const bf16_t* q; const bf16_t* k; const bf16_t* g; int ldp, ldg;
  bf16_t* gate;
  const float* gnorm;
  int mode;
  int H0, Hg, dv;
};
DI float ret_lg(int hh) { return __logf(1.0f - exp2f(-5.0f - (float)hh)); }

DI void scan1_run(const Params& p, const ScanDesc& d, int n, char* smem) {
  bf16_t* Gs = (bf16_t*)smem;
  bf16_t* Kr = (bf16_t*)(smem + 16384);
  bf16_t* KmT = (bf16_t*)(smem + 32768);
  bf16_t* VTs = (bf16_t*)(smem + 51200);
  float* tot = (float*)(smem + 69632);
  float* fac = (float*)(smem + 70656);
  const int ndvb = d.dv >> 7;
  const int G = VG_(), B = VB_();
  const int tid = tid_(), kk = tid & 127, half = tid >> 7;
  const int wave = tid >> 6, lane = tid & 63, r = lane & 31, h = lane >> 5;
  const bf16_t* VT = (const bf16_t*)(p.ws + VTB_OFF);
  u32x4 pg[4], pk[4], pv[4];
#define S1_ISSUE(U) { const int dvb_ = (U) % ndvb, hl_ = ((U) / ndvb) % d.Hg, c_ = (U) / (ndvb * d.Hg), hh_ = d.H0 + hl_, row0_ = c_ * 64; \
    _Pragma("unroll") for (int i = 0; i < 4; ++i) { const int id = tid + 256 * i, rw = id >> 4, ch = id & 15; \
      if (d.mode != 2) pg[i] = *(const u32x4*)(d.g + (size_t)(row0_ + rw) * d.ldg + hh_ * 128 + ch * 8); \
      if (d.mode != 0) pk[i] = *(const u32x4*)(d.k + (size_t)(row0_ + rw) * d.ldp + hh_ * 128 + ch * 8); \
      const int v = id >> 3, c8 = id & 7; \
      pv[i] = *(const u32x4*)(VT + (size_t)(hh_ * d.dv + dvb_ * 128 + v) * VTS + row0_ + c8 * 8); } }
  { int u = B; if (u >= n) u = n - 1; S1_ISSUE(u); }
  for (int u0 = 0; u0 < n; u0 += G) {
    int unit = u0 + B; if (unit >= n) unit = n - 1;
    const int dvb = unit % ndvb, hl = (unit / ndvb) % d.Hg, c = unit / (ndvb * d.Hg);
    const int hh = d.H0 + hl;
#pragma unroll
    for (int i = 0; i < 4; ++i) {
      const int id = tid + 256 * i, rw = id >> 4, ch = id & 15;
      if (d.mode != 2) *(u32x4*)(Gs + rw * 128 + ch * 8) = pg[i];
      if (d.mode != 0) *(u32x4*)(Kr + rw * 128 + ch * 8) = pk[i];
      const int v = id >> 3, c8 = id & 7;
      *(u32x4*)(VTs + v * 72 + c8 * 8) = pv[i];
    }
    __syncthreads();
    if (u0 + G < n) { int un = u0 + G + B; if (un >= n) un = n - 1; S1_ISSUE(un); }
    float gv[32];
    float tsum = 0.f;
    if (d.mode == 2) { const float lg = ret_lg(hh);
#pragma unroll
      for (int j = 0; j < 32; ++j) gv[j] = lg;
      tsum = 32.f * lg;
    } else {
#pragma unroll
      for (int j = 0; j < 32; ++j) { gv[j] = bf2f(Gs[(32 * half + j) * 128 + kk]); tsum += gv[j]; }
    }
    tot[half * 128 + kk] = tsum;
    __syncthreads();
    const float cum31 = tot[kk], last = cum31 + tot[128 + kk];
    if (half == 0) {
      fac[kk] = __expf(clampe(last - cum31));
      if (dvb == 0) ((float*)(p.ws + DB_OFF))[(size_t)(c * d.Hg + hl) * 128 + kk] = __expf(last);
    }
    float crun = half ? cum31 : 0.f;
#pragma unroll
    for (int g8 = 0; g8 < 4; ++g8) {
      float km[8];
#pragma unroll
      for (int j8 = 0; j8 < 8; ++j8) {
        const int j = g8 * 8 + j8;
        crun += gv[j];
        const float kval = (d.mode == 0) ? (1.0f - __expf(gv[j])) : bf2f(Kr[(32 * half + j) * 128 + kk]);
        km[j8] = kval * __expf(clampe(cum31 - crun));
      }
      u32x4 o; o.x = pack2(km[0], km[1]); o.y = pack2(km[2], km[3]); o.z = pack2(km[4], km[5]); o.w = pack2(km[6], km[7]);
      *(u32x4*)(KmT + kk * 72 + 32 * half + 8 * g8) = o;
    }
    __syncthreads();
    f32x16 acc[4];
#pragma unroll
    for (int nn = 0; nn < 4; ++nn) acc[nn] = zero16();
#pragma unroll
    for (int ks = 0; ks < 4; ++ks) {
      const bf16x8 a = *(const bf16x8*)(VTs + (32 * wave + r) * 72 + 16 * ks + 8 * h);
#pragma unroll
      for (int nn = 0; nn < 4; ++nn) {
        const bf16x8 bb = *(const bf16x8*)(KmT + (32 * nn + r) * 72 + 16 * ks + 8 * h);
        acc[nn] = MFMA(a, bb, acc[nn]);
      }
    }
#pragma unroll
    for (int nn = 0; nn < 4; ++nn) {
      const float f = fac[32 * nn + r];
#pragma unroll
      for (int i = 0; i < 16; ++i) Gs[(32 * wave + crow(i, h)) * 128 + 32 * nn + r] = f2bf(acc[nn][i] * f);
    }
    __syncthreads();
    bf16_t* Sb = (bf16_t*)(p.ws + SB_OFF) + ((size_t)(c * d.Hg + hl) * d.dv + dvb * 128) * 128;
#pragma unroll
    for (int i = 0; i < 8; ++i) { const int id = tid + 256 * i; *(u32x4*)(Sb + id * 8) = *(const u32x4*)(Gs + id * 8); }
    __syncthreads();
  }
#undef S1_ISSUE
}

DI void scan2_phase(const Params& p, const ScanDesc& d, bool live) {
  bf16_t* Sb = (bf16_t*)(p.ws + SB_OFF);
  const float* Db = (const float*)(p.ws + DB_OFF);
  const int per_c = d.Hg * d.dv * 128;
  const int n8 = per_c >> 3;
  const int tid = tid_();
  if (tid >= 32) return;
  for (int e8 = VB_() * 32 + tid; e8 < n8; e8 += VG_() * 32) {
    const int hl = e8 / (d.dv * 16), kk = (e8 & 15) * 8;
    bf16_t* sp = Sb + (size_t)e8 * 8; const float* dp = Db + hl * 128 + kk;
    float r[8];
#pragma unroll
    for (int q = 0; q < 8; ++q) r[q] = 0.f;
    for (int c0 = 0; c0 < 256; c0 += 8) {
      u32x4 L[8]; f32x4 d0[8], d1[8];
#pragma unroll
      for (int j = 0; j < 8; ++j) {
        L[j] = *(const u32x4*)(sp + (size_t)(c0 + j) * per_c);
        d0[j] = *(const f32x4*)(dp + (size_t)(c0 + j) * d.Hg * 128); d1[j] = *(const f32x4*)(dp + (size_t)(c0 + j) * d.Hg * 128 + 4);
      }
#pragma unroll
      for (int j = 0; j < 8; ++j) {
        u32x4 o; o.x = pack2(r[0], r[1]); o.y = pack2(r[2], r[3]); o.z = pack2(r[4], r[5]); o.w = pack2(r[6], r[7]);
        if (live) *(u32x4*)(sp + (size_t)(c0 + j) * per_c) = o;
        r[0] = d0[j].x * r[0] + lo2f(L[j].x); r[1] = d0[j].y * r[1] + hi2f(L[j].x); r[2] = d0[j].z * r[2] + lo2f(L[j].y); r[3] = d0[j].w * r[3] + hi2f(L[j].y);
        r[4] = d1[j].x * r[4] + lo2f(L[j].z); r[5] = d1[j].y * r[5] + hi2f(L[j].z); r[6] = d1[j].z * r[6] + lo2f(L[j].w); r[7] = d1[j].w * r[7] + hi2f(L[j].w);
      }
    }
    if (!live && r[0] == 1.2345e-30f) sp[0] = 0;
  }
}

DI void scan3_unit(const Params& p, const ScanDesc& d, int unit, bool valid, char* smem) {
  bf16_t* Qm = (bf16_t*)smem;
  bf16_t* Km = (bf16_t*)(smem + 17408);
  bf16_t* VTs = Km;
  bf16_t* Pm = (bf16_t*)(smem + 35840);
  bf16_t* Gs = Pm;
  bf16_t* Ss = (bf16_t*)(smem + 45056);
  float* tot = (float*)(smem + 63488);
  float* e31 = (float*)(smem + 64512);
  float* red = (float*)(smem + 65024);
  const int hl = unit % d.Hg, c = unit / d.Hg;
  const int hh = d.H0 + hl, row0 = c * 64;
  const int tid = tid_(), kk = tid & 127, half = tid >> 7;
  const int wave = tid >> 6, lane = tid & 63, r = lane & 31, h = lane >> 5;
#pragma unroll
  for (int i = 0; i < 4; ++i) {
    const int id = tid + 256 * i, rw = id >> 4, ch = id & 15;
    if (d.mode != 2) *(u32x4*)(Gs + rw * 128 + ch * 8) = *(const u32x4*)(d.g + (size_t)(row0 + rw) * d.ldg + hh * 128 + ch * 8);
    if (d.mode != 0) *(u32x4*)(Km + rw * 136 + ch * 8) = *(const u32x4*)(d.k + (size_t)(row0 + rw) * d.ldp + hh * 128 + ch * 8);
    *(u32x4*)(Qm + rw * 136 + ch * 8) = *(const u32x4*)(d.q + (size_t)(row0 + rw) * d.ldp + hh * 128 + ch * 8);
  }
  __syncthreads();
  {
    float gv[32];
    float tsum = 0.f;
    if (d.mode == 2) { const float lg = ret_lg(hh);
#pragma unroll
      for (int j = 0; j < 32; ++j) gv[j] = lg;
      tsum = 32.f * lg;
    } else {
#pragma unroll
      for (int j = 0; j < 32; ++j) { gv[j] = bf2f(Gs[(32 * half + j) * 128 + kk]); tsum += gv[j]; }
    }
    tot[half * 128 + kk] = tsum;
    __syncthreads();
    const float cum31 = tot[kk];
    if (half == 0) e31[kk] = __expf(cum31);
    float crun = half ? cum31 : 0.f;
#pragma unroll
    for (int j = 0; j < 32; ++j) {
      crun += gv[j];
      const float e = clampe(crun - cum31);
      const int idx = (32 * half + j) * 136 + kk;
      const float kval = (d.mode == 0) ? (1.0f - __expf(gv[j])) : bf2f(Km[idx]);
      const float qval = bf2f(Qm[idx]);
      Qm[idx] = f2bf(qval * __expf(e));
      Km[idx] = f2bf(kval * __expf(-e));
    }
  }
  __syncthreads();
  if (wave < 3) {
    const int I = (wave >= 1), J = (wave == 2);
    f32x16 sc = zero16();
#pragma unroll
    for (int ks = 0; ks < 8; ++ks) {
      const bf16x8 a = *(const bf16x8*)(Qm + (32 * I + r) * 136 + 16 * ks + 8 * h);
      const bf16x8 b = *(const bf16x8*)(Km + (32 * J + r) * 136 + 16 * ks + 8 * h);
      sc = MFMA(a, b, sc);
    }
#pragma unroll
    for (int i = 0; i < 16; ++i) {
      const int t = crow(i, h);
      float v = sc[i];
      if (I == J) v = (r <= t) ? v : 0.f;
      Pm[(32 * I + t) * 72 + 32 * J + r] = f2bf(v);
    }
  }
  __syncthreads();
  const int ndvb = d.dv >> 7;
  f32x16 acc[2][2];
#pragma unroll
  for (int a = 0; a < 2; ++a)
#pragma unroll
    for (int b = 0; b < 2; ++b) acc[a][b] = zero16();
  const bf16_t* VT = (const bf16_t*)(p.ws + VTB_OFF);
#pragma unroll
  for (int dvb = 0; dvb < 2; ++dvb) {
    if (dvb < ndvb) {
      const bf16_t* Sg = (const bf16_t*)(p.ws + SB_OFF) + ((size_t)(c * d.Hg + hl) * d.dv + dvb * 128) * 128;
#pragma unroll
      for (int i = 0; i < 4; ++i) {
        const int id = tid + 256 * i, v = id >> 3, ch = id & 7;
        *(u32x4*)(VTs + v * 72 + ch * 8) = *(const u32x4*)(VT + (size_t)(hh * d.dv + dvb * 128 + v) * VTS + row0 + ch * 8);
      }
#pragma unroll
      for (int hk = 0; hk < 2; ++hk) {
#pragma unroll
        for (int i = 0; i < 4; ++i) {
          const int id = tid + 256 * i, v = id >> 3, ch = id & 7;
          const u32x4 sv = *(const u32x4*)(Sg + (size_t)v * 128 + hk * 64 + ch * 8);
          const float* ef = e31 + hk * 64 + ch * 8;
          u32x4 o;
          o.x = pack2(lo2f(sv.x) * ef[0], hi2f(sv.x) * ef[1]); o.y = pack2(lo2f(sv.y) * ef[2], hi2f(sv.y) * ef[3]);
          o.z = pack2(lo2f(sv.z) * ef[4], hi2f(sv.z) * ef[5]); o.w = pack2(lo2f(sv.w) * ef[6], hi2f(sv.w) * ef[7]);
          *(u32x4*)(Ss + v * 72 + ch * 8) = o;
        }
        __syncthreads();
#pragma unroll
        for (int mt2 = 0; mt2 < 2; ++mt2) {
          if (hk == 0) {
#pragma unroll
            for (int ks = 0; ks < 4; ++ks) {
              if (mt2 == 1 || ks < 2) {
                const bf16x8 a = *(const bf16x8*)(Pm + (32 * mt2 + r) * 72 + 16 * ks + 8 * h);
                const bf16x8 b = *(const bf16x8*)(VTs + (32 * wave + r) * 72 + 16 * ks + 8 * h);
                acc[dvb][mt2] = MFMA(a, b, acc[dvb][mt2]);
              }
            }
          }
#pragma unroll
          for (int ks = 0; ks < 4; ++ks) {
            const bf16x8 a = *(const bf16x8*)(Qm + (32 * mt2 + r) * 136 + hk * 64 + 16 * ks + 8 * h);
            const bf16x8 b = *(const bf16x8*)(Ss + (32 * wave + r) * 72 + 16 * ks + 8 * h);
            acc[dvb][mt2] = MFMA(a, b, acc[dvb][mt2]);
          }
        }
        __syncthreads();
      }
    }
  }
#pragma unroll
  for (int mt2 = 0; mt2 < 2; ++mt2)
#pragma unroll
    for (int i = 0; i < 16; ++i) {
      float ssq = acc[0][mt2][i] * acc[0][mt2][i];
      if (ndvb == 2) ssq += acc[1][mt2][i] * acc[1][mt2][i];
      DPP_ADD(ssq, 0xB1); DPP_ADD(ssq, 0x4E); DPP_ADD(ssq, 0x141); DPP_ADD(ssq, 0x140);
      const float s0 = __int_as_float(__builtin_amdgcn_readlane(__float_as_int(ssq), 0)) + __int_as_float(__builtin_amdgcn_readlane(__float_as_int(ssq), 16));
      const float s1 = __int_as_float(__builtin_amdgcn_readlane(__float_as_int(ssq), 32)) + __int_as_float(__builtin_amdgcn_readlane(__float_as_int(ssq), 48));
      if (r == 0) red[wave * 64 + 32 * mt2 + crow(i, h)] = h ? s1 : s0;
    }
  __syncthreads();
  const float invdv = 1.0f / (float)d.dv;
  bf16_t* Ot = Qm;
#pragma unroll
  for (int dvb = 0; dvb < 2; ++dvb) {
    if (dvb < ndvb) {
      const int v = dvb * 128 + 32 * wave + r;
      const float gn = d.gnorm ? d.gnorm[v] : 1.0f;
#pragma unroll
      for (int mt2 = 0; mt2 < 2; ++mt2)
#pragma unroll
        for (int i = 0; i < 16; ++i) {
          const int t = 32 * mt2 + crow(i, h);
          const float tsq = red[t] + red[64 + t] + red[128 + t] + red[192 + t];
          const float rstd = rsqrtf(tsq * invdv + 1e-6f);
          Ot[t * 136 + 32 * wave + r] = f2bf(acc[dvb][mt2][i] * rstd * gn);
        }
      __syncthreads();
#pragma unroll
      for (int i = 0; i < 4; ++i) {
        const int id = tid + 256 * i, t = id >> 4, ch = id & 15;
        bf16_t* gp = d.gate + (size_t)(row0 + t) * d.ldp + hh * d.dv + dvb * 128 + ch * 8;
        const u32x4 gt = *(const u32x4*)gp;
        const u32x4 ov = *(const u32x4*)(Ot + t * 136 + ch * 8);
        u32x4 o;
        o.x = pack2(lo2f(ov.x) * siluf_(lo2f(gt.x)), hi2f(ov.x) * siluf_(hi2f(gt.x)));
        o.y = pack2(lo2f(ov.y) * siluf_(lo2f(gt.y)), hi2f(ov.y) * siluf_(hi2f(gt.y)));
        o.z = pack2(lo2f(ov.z) * siluf_(lo2f(gt.z)), hi2f(ov.z) * siluf_(hi2f(gt.z)));
        o.w = pack2(lo2f(ov.w) * siluf_(lo2f(gt.w)), hi2f(ov.w) * siluf_(hi2f(gt.w)));
        if (valid) *(u32x4*)gp = o;
      }
      __syncthreads();
    }
  }
}

DI void gla_gate_phase(const Params& p) {
  const bf16_t* P = (const bf16_t*)(p.ws + PB_OFF);
  bf16_t* G = (bf16_t*)(p.ws + HB_OFF);
  const int tid = tid_();
  float w0[16], w1[16];
#pragma unroll
  for (int j = 0; j < 16; ++j) { w0[j] = p.gla_w_gk_up[j * 512 + 2 * tid]; w1[j] = p.gla_w_gk_up[j * 512 + 2 * tid + 1]; }
  const float b0 = p.gla_b_gk[2 * tid], b1 = p.gla_b_gk[2 * tid + 1];
  for (int row = VB_(); row < S; row += VG_()) {
    const u32x4 g0 = *(const u32x4*)(P + (size_t)row * 2176 + 2048), g1 = *(const u32x4*)(P + (size_t)row * 2176 + 2056);
    float gl[16];
    gl[0] = lo2f(g0.x); gl[1] = hi2f(g0.x); gl[2] = lo2f(g0.y); gl[3] = hi2f(g0.y); gl[4] = lo2f(g0.z); gl[5] = hi2f(g0.z); gl[6] = lo2f(g0.w); gl[7] = hi2f(g0.w);
    gl[8] = lo2f(g1.x); gl[9] = hi2f(g1.x); gl[10] = lo2f(g1.y); gl[11] = hi2f(g1.y); gl[12] = lo2f(g1.z); gl[13] = hi2f(g1.z); gl[14] = lo2f(g1.w); gl[15] = hi2f(g1.w);
    float z0 = b0, z1 = b1;
#pragma unroll
    for (int j = 0; j < 16; ++j) { z0 += gl[j] * w0[j]; z1 += gl[j] * w1[j]; }
    const float l0 = (fminf(z0, 0.f) - __logf(1.0f + __expf(-fabsf(z0)))) * 0.0625f;
    const float l1 = (fminf(z1, 0.f) - __logf(1.0f + __expf(-fabsf(z1)))) * 0.0625f;
    *(unsigned*)(G + (size_t)row * 512 + 2 * tid) = pack2(l0, l1);
  }
}

DI void mla_m1_item(const Params& p, int item, bool live) {
  bf16_t* P1 = (bf16_t*)(p.ws + PB_OFF);
  const int wave = tid_() >> 6, lane = tid_() & 63;
  const int row = item * 4 + wave;
  unsigned* rp = (unsigned*)(P1 + (size_t)row * 640);
  unsigned a[3]; float ss = 0.f;
#pragma unroll
  for (int j = 0; j < 3; ++j) { a[j] = rp[lane + 64 * j]; const float x0 = lo2f(a[j]), x1 = hi2f(a[j]); ss += x0 * x0 + x1 * x1; }
  const unsigned b = rp[192 + lane]; const float y0 = lo2f(b), y1 = hi2f(b);
  float s2 = y0 * y0 + y1 * y1;
  ss = wave_sum(ss); s2 = wave_sum(s2);
  const float r1 = rsqrtf(ss * (1.0f / 384.0f) + 1e-6f), r2 = rsqrtf(s2 * (1.0f / 128.0f) + 1e-6f);
  if (live || r2 == 1.2345e-30f)
#pragma unroll
  for (int j = 0; j < 3; ++j) { const int c = 2 * (lane + 64 * j); rp[lane + 64 * j] = pack2(lo2f(a[j]) * r1 * p.mla_g_q_lora[c], hi2f(a[j]) * r1 * p.mla_g_q_lora[c + 1]); }
  if (live || r1 == 1.2345e-30f) rp[192 + lane] = pack2(y0 * r2 * p.mla_g_kv_lora[2 * lane], y1 * r2 * p.mla_g_kv_lora[2 * lane + 1]);
}
DI void mla_m3_item(const Params& p, int item, bool live, char* sm) {
  const bf16_t* P1 = (const bf16_t*)(p.ws + PB_OFF);
  bf16_t* Q = (bf16_t*)(p.ws + PB_OFF + 20 * MiB);
  const bf16_t* KR = (const bf16_t*)(p.ws + PB_OFF + 68 * MiB);
  bf16_t* KF = (bf16_t*)(p.ws + SB_OFF);
  const float* ct = (const float*)(p.ws + TABM_OFF); const float* st = ct + (size_t)S * 32;
  const int wave = tid_() >> 6, lane = tid_() & 63;
  const int row = item * 4 + wave, j = lane & 31;
  bf16_t* Lq = (bf16_t*)(sm + wave * 8448);
  bf16_t* Lk = Lq + 1536;
  bf16_t* Lo = Lk + 1088;
#define M3_SYNC() { asm volatile("" ::: "memory"); __builtin_amdgcn_wave_barrier(); asm volatile("s_waitcnt lgkmcnt(0)" ::: "memory"); }
#pragma unroll
  for (int i = 0; i < 3; ++i) *(u32x4*)(Lq + (lane + 64 * i) * 8) = *(const u32x4*)(Q + (size_t)row * 1536 + (lane + 64 * i) * 8);
#pragma unroll
  for (int i = 0; i < 2; ++i) *(u32x4*)(Lk + (lane + 64 * i) * 8) = *(const u32x4*)(KR + (size_t)row * 1024 + (lane + 64 * i) * 8);
  if (lane < 8) *(u32x4*)(Lk + 1024 + lane * 8) = *(const u32x4*)(P1 + (size_t)row * 640 + 512 + lane * 8);
  const float c = ct[(size_t)row * 32 + j], s = st[(size_t)row * 32 + j];
  const float sgn = (lane < 32) ? -1.f : 1.f;
  const float qscale = 0.07216878364870322f * 1.4426950408889634f;
  const float gq0 = p.mla_g_qnorm[lane], gq1 = p.mla_g_qnorm[64 + lane], gq2 = p.mla_g_qnorm[128 + lane];
  const float gk0 = p.mla_g_knorm[lane], gk1 = p.mla_g_knorm[64 + lane], gk2 = p.mla_g_knorm[128 + lane];
  M3_SYNC();
  const float kr = bf2f(Lk[1024 + lane]);
#pragma unroll
  for (int hd = 0; hd < 8; ++hd) {
    bf16_t* qp = Lq + hd * 192;
    float v0 = bf2f(qp[lane]), v1 = bf2f(qp[64 + lane]), v2 = bf2f(qp[128 + lane]);
    float ss = wave_sum(v0 * v0 + v1 * v1 + v2 * v2);
    float rs = rsqrtf(ss * (1.0f / 192.0f) + 1e-6f);
    v0 *= rs * gq0; v1 *= rs * gq1; v2 *= rs * gq2;
    float pr = __shfl_xor(v2, 32);
    float o2 = v2 * c + sgn * pr * s;
    qp[lane] = f2bf(v0 * qscale); qp[64 + lane] = f2bf(v1 * qscale); qp[128 + lane] = f2bf(o2 * qscale);
    const bf16_t* kp = Lk + hd * 128;
    float k0 = bf2f(kp[lane]), k1 = bf2f(kp[64 + lane]), k2 = kr;
    ss = wave_sum(k0 * k0 + k1 * k1 + k2 * k2);
    rs = rsqrtf(ss * (1.0f / 192.0f) + 1e-6f);
    k0 *= rs * gk0; k1 *= rs * gk1; k2 *= rs * gk2;
    pr = __shfl_xor(k2, 32);
    o2 = k2 * c + sgn * pr * s;
    bf16_t* ko = Lo + hd * 192;
    ko[lane] = f2bf(k0); ko[64 + lane] = f2bf(k1); ko[128 + lane] = f2bf(o2);
  }
  M3_SYNC();
  if (live || c == 1.2345e-30f) {
#pragma unroll
    for (int i = 0; i < 3; ++i) {
      *(u32x4*)(Q + (size_t)row * 1536 + (lane + 64 * i) * 8) = *(const u32x4*)(Lq + (lane + 64 * i) * 8);
      *(u32x4*)(KF + (size_t)row * 1536 + (lane + 64 * i) * 8) = *(const u32x4*)(Lo + (lane + 64 * i) * 8);
    }
  }
  M3_SYNC();
#undef M3_SYNC
}

DI void attn_unit(const Params& p, int unit, char* smem) {
  bf16_t* Ks = (bf16_t*)smem;
  bf16_t* VTs = (bf16_t*)(smem + 51200);
  const bf16_t* Q = (const bf16_t*)(p.ws + PB_OFF + 20 * MiB);
  const bf16_t* KF = (const bf16_t*)(p.ws + SB_OFF);
  const bf16_t* VT = (const bf16_t*)(p.ws + VTB_OFF);
  bf16_t* AO = (bf16_t*)(p.ws + AO_OFF);
  const int hd = unit & 7, qb = (unit < 256) ? 63 - (unit >> 3) : ((unit - 256) >> 3);
  const int gt = gtid_(), wave = gt >> 6, lane = gt & 63, r = lane & 31, h = lane >> 5;
  const int qrow = qb * 256 + 32 * wave + r;
  bf16x8 qf[12];
#pragma unroll
  for (int ks = 0; ks < 12; ++ks) qf[ks] = *(const bf16x8*)(Q + (size_t)qrow * 1536 + hd * 192 + 16 * ks + 8 * h);
  const int nkt = 4 * qb + 4;
  const int kmax_w = (qb * 256 + 32 * wave + 31) >> 6;
  const int kmask_w = (qb * 256 + 32 * wave) >> 6;
  float m = -1e30f, l = 0.f;
  f32x16 oacc[4];
#pragma unroll
  for (int i = 0; i < 4; ++i) oacc[i] = zero16();
  u32x4 rk[3], rv[2];
  const bf16_t* KFh = KF + hd * 192;
  const bf16_t* VTh = VT + (size_t)(hd * 128) * VTS;
#define A_LOAD(K0) { _Pragma("unroll") for (int i = 0; i < 3; ++i) { const int id = gt + 512 * i, kr = id / 24, ch = id % 24; rk[i] = *(const u32x4*)(KFh + (size_t)((K0) + kr) * 1536 + ch * 8); } \
                     _Pragma("unroll") for (int i = 0; i < 2; ++i) { const int id = gt + 512 * i, v = id >> 3, c8 = id & 7; rv[i] = *(const u32x4*)(VTh + (size_t)v * VTS + (K0) + c8 * 8); } }
#define A_STORE(BUF) { _Pragma("unroll") for (int i = 0; i < 3; ++i) { const int id = gt + 512 * i, kr = id / 24, ch = id % 24; *(u32x4*)(Ks + (BUF) * 12800 + kr * 200 + ch * 8) = rk[i]; } \
                       _Pragma("unroll") for (int i = 0; i < 2; ++i) { const int id = gt + 512 * i, v = id >> 3, c8 = id & 7; *(u32x4*)(VTs + (BUF) * 9216 + v * 72 + c8 * 8) = rv[i]; } }
  A_LOAD(0);
  __syncthreads();
  A_STORE(0);
  __syncthreads();
  for (int kt = 0; kt < nkt; ++kt) {
    const int buf = kt & 1;
    if (kt + 1 < nkt) A_LOAD((kt + 1) * 64);
    if (kt <= kmax_w) {
      const bf16_t* Kb = Ks + buf * 12800; const bf16_t* Vb = VTs + buf * 9216;
      f32x16 sa[2]; sa[0] = zero16(); sa[1] = zero16();
#pragma unroll
      for (int ks = 0; ks < 12; ++ks) {
        const bf16x8 a0 = *(const bf16x8*)(Kb + r * 200 + 16 * ks + 8 * h);
        const bf16x8 a1 = *(const bf16x8*)(Kb + (32 + r) * 200 + 16 * ks + 8 * h);
        sa[0] = MFMA(a0, qf[ks], sa[0]); sa[1] = MFMA(a1, qf[ks], sa[1]);
      }
      if (kt >= kmask_w) {
#pragma unroll
        for (int n = 0; n < 2; ++n)
#pragma unroll
          for (int i = 0; i < 16; ++i) { const int key = kt * 64 + 32 * n + crow(i, h); if (key > qrow) sa[n][i] = -1e30f; }
      }
      float mx = -1e30f;
#pragma unroll
      for (int n = 0; n < 2; ++n)
#pragma unroll
        for (int i = 0; i < 16; ++i) mx = fmaxf(mx, sa[n][i]);
      mx = fmaxf(mx, __shfl_xor(mx, 32));
      const float mnew = fmaxf(m, mx);
      const float alpha = __builtin_amdgcn_exp2f(m - mnew);
      m = mnew;
      float rsum = 0.f;
#pragma unroll
      for (int n = 0; n < 2; ++n)
#pragma unroll
        for (int i = 0; i < 16; ++i) { const float pv = __builtin_amdgcn_exp2f(sa[n][i] - mnew); sa[n][i] = pv; rsum += pv; }
      rsum += __shfl_xor(rsum, 32);
      l = l * alpha + rsum;
#pragma unroll
      for (int mt = 0; mt < 4; ++mt) {
        if (__builtin_amdgcn_ballot_w64(alpha != 1.0f) != 0ull) {
#pragma unroll
          for (int i = 0; i < 16; ++i) oacc[mt][i] *= alpha;
        }
      }
      bf16x8 pf[4];
#pragma unroll
      for (int n = 0; n < 2; ++n)
#pragma unroll
        for (int s2 = 0; s2 < 2; ++s2) {
          u32x4 pk;
          pk.x = pack2(sa[n][8 * s2 + 0], sa[n][8 * s2 + 1]); pk.y = pack2(sa[n][8 * s2 + 2], sa[n][8 * s2 + 3]);
          pk.z = pack2(sa[n][8 * s2 + 4], sa[n][8 * s2 + 5]); pk.w = pack2(sa[n][8 * s2 + 6], sa[n][8 * s2 + 7]);
          pf[n * 2 + s2] = __builtin_bit_cast(bf16x8, pk);
        }
#pragma unroll
      for (int mt = 0; mt < 4; ++mt)
#pragma unroll
        for (int f = 0; f < 4; ++f) {
          const bf16_t* vp = Vb + (32 * mt + r) * 72 + 16 * f + 4 * h;
          const u32x2 lo = *(const u32x2*)vp, hi = *(const u32x2*)(vp + 8);
          u32x4 av; av.x = lo.x; av.y = lo.y; av.z = hi.x; av.w = hi.y;
          oacc[mt] = MFMA(__builtin_bit_cast(bf16x8, av), pf[f], oacc[mt]);
        }
    }
    if (kt + 1 < nkt) A_STORE(buf ^ 1);
    __syncthreads();
  }
#undef A_LOAD
#undef A_STORE
  const float inv = 1.0f / l;
#pragma unroll
  for (int mt = 0; mt < 4; ++mt)
#pragma unroll
    for (int g = 0; g < 4; ++g) {
      u32x2 o; o.x = pack2(oacc[mt][4 * g] * inv, oacc[mt][4 * g + 1] * inv); o.y = pack2(oacc[mt][4 * g + 2] * inv, oacc[mt][4 * g + 3] * inv);
      *(u32x2*)(AO + (size_t)qrow * 1024 + hd * 128 + 32 * mt + 8 * g + 4 * h) = o;
    }
}

enum { ST_N1 = 0, ST_IN, ST_GATE, ST_S1, ST_S2, ST_S3, ST_S1B, ST_S2B, ST_S3B, ST_M1, ST_M2, ST_M3, ST_ATT, ST_OUT, ST_N2, ST_F1, ST_F2 };
__device__ __constant__ signed char c_steps[4][13] = {
  { ST_N1, ST_IN, ST_S1, ST_S2, ST_S3, ST_OUT, ST_F1, ST_F2, -1, -1, -1, -1, -1 },
  { ST_IN, ST_GATE, ST_S1, ST_S2, ST_S3, ST_OUT, ST_F1, ST_F2, -1, -1, -1, -1, -1 },
  { ST_IN, ST_S1, ST_S2, ST_S3, ST_S1B, ST_S2B, ST_S3B, ST_OUT, ST_F1, ST_F2, -1, -1, -1 },
  { ST_IN, ST_M1, ST_M2, ST_M3, ST_ATT, ST_OUT, ST_F1, ST_F2, -1, -1, -1, -1, -1 } };
constexpr int N_PHASES = 8 + 8 + 10 + 8;

struct ConvJob { const float* src; int K, N, Np, mode; bf16_t* dst; };
DI int conv_tiles(const ConvJob& j) { return (j.Np >> 6) * (j.K >> 6); }

DI bf16_t* wm_of(const Params& p, int layer) { return (bf16_t*)(p.ws + ((layer & 1) ? WMB_OFF : WM_OFF)); }
DI bool mixer_job(const Params& p, int layer, int j, ConvJob& o) {
  bf16_t* WM = wm_of(p, layer);
  if (layer == 0) {
    if (j == 0) { o = ConvJob{ p.hgrn_w_in, 1024, 4096, 4096, 0, WM }; return true; }
    if (j == 1) { o = ConvJob{ p.hgrn_w_out, 1024, 1024, 1024, 0, WM + 4194304 }; return true; }
  } else if (layer == 1) {
    if (j == 0) { o = ConvJob{ p.gla_w_in, 1024, 3088, 3328, 0, WM }; return true; }
    if (j == 1) { o = ConvJob{ p.gla_w_out, 1024, 1024, 1024, 0, WM + 3407872 }; return true; }
  } else if (layer == 2) {
    if (j == 0) { o = ConvJob{ p.ret_w_in, 1024, 6144, 6144, 0, WM }; return true; }
    if (j == 1) { o = ConvJob{ p.ret_w_out, 2048, 1024, 1024, 0, WM + 6291456 }; return true; }
  } else {
    if (j == 0) { o = ConvJob{ p.mla_w_in, 1024, 576, 768, 0, WM }; return true; }
    if (j == 1) { o = ConvJob{ p.mla_w_uq, 384, 1536, 1536, 0, WM + 786432 }; return true; }
    if (j == 2) { o = ConvJob{ p.mla_w_ukv, 128, 2048, 2048, 0, WM + 1376256 }; return true; }
    if (j == 3) { o = ConvJob{ p.mla_w_out, 1024, 1024, 1024, 0, WM + 1638400 }; return true; }
  }
  return false;
}
DI void run_conv(const ConvJob& job, int& off, char* sm) {
  const int G = VG_(), cnt = conv_tiles(job);
  const int start = (VB_() - (off % G) + G) % G;
  for (int t0 = 0; t0 < cnt; t0 += G) {
    int t = t0 + start; if (t >= cnt) t = cnt - 1;
    conv_tile(job.src, job.K, job.N, job.mode, job.dst, t, sm);
  }
  off += cnt;
}

DI ScanDesc make_scan(const Params& p, int layer, int grp) {
  ScanDesc d;
  bf16_t* P = (bf16_t*)(p.ws + PB_OFF);
  if (layer == 0) { d.q = P; d.k = P; d.g = P + 1024; d.ldp = 3072; d.ldg = 3072; d.gate = P + 2048; d.gnorm = p.hgrn_g_norm; d.mode = 0; d.H0 = 0; d.Hg = 8; d.dv = 128; }
  else if (layer == 1) { d.q = P; d.k = P + 512; d.g = (const bf16_t*)(p.ws + HB_OFF); d.ldp = 2176; d.ldg = 512; d.gate = P + 1024; d.gnorm = p.gla_g_norm; d.mode = 1; d.H0 = 0; d.Hg = 4; d.dv = 256; }
  else { d.q = P; d.k = P + 1024; d.g = P; d.ldp = 4160; d.ldg = 4160; d.gate = P + 2048; d.gnorm = nullptr; d.mode = 2; d.H0 = 4 * grp; d.Hg = 4; d.dv = 256; }
  return d;
}

DI void run_phase(const Params& p, int layer, int step, char* smem, bool live) {
  const int G = VG_(), B = VB_();
  char* sm = smem + (B & 1) * HALF_LDS;
  bf16_t* WM = wm_of(p, layer); bf16_t* WF = (bf16_t*)(p.ws + WF_OFF);
  bf16_t* H = (bf16_t*)(p.ws + HB_OFF); bf16_t* P = (bf16_t*)(p.ws + PB_OFF);
  switch (step) {
    case ST_N1: {
      for (int it = B; it < 4096; it += G) norm_item(p.x, p.norm_mix, H, it);
      for (int it = B; it < 4096; it += G) table_item(p, it);
      for (int it = B; it < 4; it += G) lb_item(p, it);
      { float* z = (float*)(p.ws + SSQA_OFF); for (int i = B * 256 + tid_(); i < 2 * 16384; i += G * 256) z[i] = 0.f; }
      int off = 0;
      for (int j = 0; j < 2; ++j) { ConvJob job; if (mixer_job(p, 0, j, job)) run_conv(job, off, sm); }
    } break;
    case ST_GATE: gla_gate_phase(p); break;
    case ST_S1: case ST_S1B: {
      const ScanDesc d = make_scan(p, layer, step == ST_S1B);
      const int n = 256 * d.Hg * (d.dv >> 7);
      scan1_run(p, d, n, sm);
    } break;
    case ST_S2: case ST_S2B: {
      const ScanDesc d = make_scan(p, layer, step == ST_S2B); scan2_phase(p, d, live);
      if (step == ST_S2) {
        int off = 0;
        { ConvJob job{ p.ffn_w_gate_up + (size_t)layer * 1024 * 5632, 1024, 5632, 5632, 1, WF }; run_conv(job, off, sm); }
        { ConvJob job{ p.ffn_w_down + (size_t)layer * 2816 * 1024, 2816, 1024, 1024, 0, WF + 5767168 }; run_conv(job, off, sm); }
        for (int j = 0; j < 4; ++j) { ConvJob job; if (mixer_job(p, layer + 1, j, job)) run_conv(job, off, sm); }
      }
    } break;
    case ST_S3: case ST_S3B: {
      const ScanDesc d = make_scan(p, layer, step == ST_S3B);
      const int n = 256 * d.Hg;
      for (int u0 = 0; u0 < n; u0 += G) { int u = u0 + B; const bool valid = (u < n) && live; if (u >= n) u = n - 1; scan3_unit(p, d, u, valid, sm); }
    } break;
    case ST_M1: {
      for (int it = B; it < 4096; it += G) mla_m1_item(p, it, live);
      int off = 0;
      { ConvJob job{ p.ffn_w_gate_up + (size_t)layer * 1024 * 5632, 1024, 5632, 5632, 1, WF }; run_conv(job, off, sm); }
      { ConvJob job{ p.ffn_w_down + (size_t)layer * 2816 * 1024, 2816, 1024, 1024, 0, WF + 5767168 }; run_conv(job, off, sm); }
    } break;
    case ST_M3: for (int it = B; it < 4096; it += G) mla_m3_item(p, it, live, sm); break;
    case ST_ATT: for (int u = blockIdx.x; u < 512; u += gridDim.x) attn_unit(p, u, smem); break;
    case ST_IN: case ST_M2: case ST_OUT: case ST_F1: case ST_F2: {
      const bf16_t* A = H; int lda = 1024; const bf16_t* W = WM; int K = 1024, ntn = 4, gid = G_OUT;
      const bf16_t* A2 = H; int lda2 = 0; const bf16_t* W2 = WM; int K2 = 0, ntn2 = 0, gid2 = 0;
      if (step == ST_IN) {
        if (layer == 0) { ntn = 16; gid = G_HGRN_IN; } else if (layer == 1) { ntn = 13; gid = G_GLA_IN; }
        else if (layer == 2) { ntn = 24; gid = G_RET_IN; } else { ntn = 3; gid = G_MLA_IN; }
      } else if (step == ST_M2) {
        A = P; lda = 640; W = WM + 786432; K = 384; ntn = 6; gid = G_MLA_Q;
        A2 = P + 384; lda2 = 640; W2 = WM + 1376256; K2 = 128; ntn2 = 8; gid2 = G_MLA_KV;
      } else if (step == ST_OUT) {
        if (layer == 0) { A = P + 2048; lda = 3072; W = WM + 4194304; }
        else if (layer == 1) { A = P + 1024; lda = 2176; W = WM + 3407872; }
        else if (layer == 2) { A = P + 2048; lda = 4160; W = WM + 6291456; K = 2048; }
        else { A = (const bf16_t*)(p.ws + AO_OFF); W = WM + 1638400; }
      } else if (step == ST_F1) { W = WF; ntn = 22; gid = G_FFN1; }
      else { A = P; lda = 2816; W = WF + 5767168; K = 2816; gid = G_FFN2; }
      if (step == ST_IN && layer > 0) { float* z = (float*)(p.ws + SSQA_OFF); for (int i = blockIdx.x * 512 + gtid_(); i < 16384; i += gridDim.x * 512) z[i] = 0.f; }
      if (step == ST_F1) { float* z = (float*)(p.ws + SSQB_OFF); for (int i = blockIdx.x * 512 + gtid_(); i < 16384; i += gridDim.x * 512) z[i] = 0.f; }
      const int nall = ntn + ntn2, nM = 64, total = nM * nall;
      for (int t = blockIdx.x; t < total; t += gridDim.x) {
        int wg = t; { const int q = total / 8, rr = total % 8, xcd = wg % 8, o = wg / 8; wg = (xcd < rr ? xcd * (q + 1) : rr * (q + 1) + (xcd - rr) * q) + o; }
        const int nig = WGM * nall, g0 = wg / nig, fm = g0 * WGM, gsz = (nM - fm) < WGM ? (nM - fm) : WGM;
        const int mt = fm + (wg % nig) % gsz; int n = (wg % nig) / gsz;
        const bf16_t* Ax = A; int ldx = lda; const bf16_t* Wx = W; int Kx = K, gx = gid;
        if (n >= ntn) { n -= ntn; Ax = A2; ldx = lda2; Wx = W2; Kx = K2; gx = gid2; }
        gemm_tile(p, Ax, ldx, Wx, Kx, gx, mt, n, layer, smem);
      }
    } break;
    default: break;
  }
}

#define XB_TMO      128
#define XB_XCNT(j)  (256  + 64 * (j))
#define XB_XSUB(j)  (1280 + 64 * (j))
#define XB_XGEN(j)  (2304 + 64 * (j))
#define XB_TOP      3328
#define XB_TOPGEN   3392
#define XCD_BAR_WORDS 3456
#define XB_SPIN_CAP (1u << 18)

__device__ __forceinline__ unsigned xb_ld(unsigned* p)              { return __hip_atomic_load(p, __ATOMIC_RELAXED, __HIP_MEMORY_SCOPE_AGENT); }
__device__ __forceinline__ unsigned xb_add(unsigned* p, unsigned v) { return __hip_atomic_fetch_add(p, v, __ATOMIC_RELAXED, __HIP_MEMORY_SCOPE_AGENT); }
__device__ __forceinline__ unsigned xb_xcc_id() { return (unsigned)__builtin_amdgcn_s_getreg((3 << 11) | 20) & 0xFu; }
#define XB_SPIN(cond, bar) do { unsigned _sp = 0; while (cond) { __builtin_amdgcn_s_sleep(1); \
    if ((++_sp & 255u) == 0u) { if (xb_ld(&(bar)[XB_TMO])) break; if (_sp > XB_SPIN_CAP) { atomicAdd(&(bar)[XB_TMO], 1u); break; } } } } while (0)

struct XcdBarrier {
    unsigned* bar; unsigned x;
    volatile unsigned* st;
};

__device__ __forceinline__ XcdBarrier xcd_barrier_post(unsigned* bar, volatile unsigned* st) {
    XcdBarrier b; b.bar = bar; b.x = xb_xcc_id(); b.st = st;
    if (threadIdx.x == 0) (void)xb_add(&bar[XB_XCNT(b.x)], 1u);
    return b;
}
__device__ __forceinline__ void xcd_barrier_complete(unsigned* bar, unsigned x, unsigned& nloc, unsigned& nx) {
    const unsigned G = gridDim.x * gridDim.y * gridDim.z;
    unsigned sum, cnt, mine, sp = 0u;
    for (;;) {
        sum = 0u; cnt = 0u; mine = 0u;
#pragma unroll
        for (unsigned j = 0; j < 16; ++j) { const unsigned c = xb_ld(&bar[XB_XCNT(j)]); sum += c; cnt += (c > 0u) ? 1u : 0u; mine = (j == x) ? c : mine; }
        if (sum == G) break;
        __builtin_amdgcn_s_sleep(1);
        if ((++sp & 255u) == 0u) { if (xb_ld(&bar[XB_TMO])) break; if (sp > XB_SPIN_CAP) { atomicAdd(&bar[XB_TMO], 1u); break; } }
    }
    nloc = mine > 0u ? mine : 1u; nx = cnt > 0u ? cnt : 1u;
}

__device__ __forceinline__ void xcd_barrier(const XcdBarrier& b) {
    asm volatile("s_waitcnt vmcnt(0)" ::: "memory");
    __syncthreads();
    if (threadIdx.x == 0) {
        unsigned* bar = b.bar;
        __builtin_amdgcn_s_waitcnt(0);
        unsigned nloc = b.st[0], nx = b.st[1];
        if (nloc == 0u) { xcd_barrier_complete(bar, b.x, nloc, nx); b.st[0] = nloc; b.st[1] = nx; }
        const unsigned old = xb_add(&bar[XB_XSUB(b.x)], 1u);
        const unsigned gen = old / nloc;
        if (old + 1u == (gen + 1u) * nloc) {
            __builtin_amdgcn_fence(__ATOMIC_RELEASE, "agent");
            asm volatile("s_waitcnt vmcnt(0)" ::: "memory");
            const unsigned og = xb_add(&bar[XB_TOP], 1u);
            const unsigned tg = og / nx;
            if (og + 1u == (tg + 1u) * nx) xb_add(&bar[XB_TOPGEN], 1u);
            else XB_SPIN(xb_ld(&bar[XB_TOPGEN]) == tg, bar);
            __builtin_amdgcn_fence(__ATOMIC_ACQUIRE, "agent");
            xb_add(&bar[XB_XGEN(b.x)], 1u);
            asm volatile("s_waitcnt vmcnt(0)" ::: "memory");
        } else {
            XB_SPIN(xb_ld(&bar[XB_XGEN(b.x)]) == gen, bar);
            __builtin_amdgcn_fence(__ATOMIC_ACQUIRE, "agent");
            asm volatile("s_waitcnt vmcnt(0)" ::: "memory");
        }
    }
    __syncthreads();
}


DI void grid_barrier(unsigned* ctr, unsigned& epoch) {
  asm volatile("s_waitcnt vmcnt(0)" ::: "memory");
  __syncthreads();
  epoch += gridDim.x;
  if (threadIdx.x < 64) {
    if (threadIdx.x == 0) {
      __builtin_amdgcn_fence(__ATOMIC_RELEASE, "agent");
      asm volatile("s_waitcnt vmcnt(0)" ::: "memory");
      __hip_atomic_fetch_add(ctr, 1u, __ATOMIC_RELAXED, __HIP_MEMORY_SCOPE_AGENT);
      while (__hip_atomic_load(ctr, __ATOMIC_RELAXED, __HIP_MEMORY_SCOPE_AGENT) < epoch) __builtin_amdgcn_s_sleep(1);
    }
    __builtin_amdgcn_fence(__ATOMIC_ACQUIRE, "agent");
    asm volatile("s_waitcnt vmcnt(0)" ::: "memory");
  }
  __syncthreads();
}

__global__ void __launch_bounds__(512) fwd_megakernel(Params p, int ph_lo, int ph_hi) {
  extern __shared__ __attribute__((aligned(16))) char smem[];
  cg::grid_group grid = cg::this_grid();
  volatile unsigned* xst = (volatile unsigned*)(smem + 147456);
  if (threadIdx.x == 0) { xst[0] = 0u; xst[1] = 0u; }
  __syncthreads();
  const XcdBarrier xb = xcd_barrier_post((unsigned*)(p.ws + LB_OFF + 262144), xst);
  int ph = 0;
  for (int layer = 0; layer < 4; ++layer) {
    for (int si = 0; si < 13; ++si) {
      const int step = c_steps[layer][si];
      if (step < 0) break;
      if (ph >= ph_lo && ph < ph_hi) {
        run_phase(p, layer, step, smem, true);
        if (ph + 1 < ph_hi) { if (ph_hi > 1000) grid.sync(); else xcd_barrier(xb); }
      }
      ++ph;
    }
  }
}

extern "C" void kernel_launch(void* const* d_in, const int* in_sizes, int n_in, void* d_out, int out_size, void* d_ws, size_t ws_size, hipStream_t stream) {
  static int grid_blocks = 0;
  Params p{};
  const float** fp = (const float**)&p;
  p.x = (const float*)d_in[0]; p.pos = (const int*)d_in[1];
  for (int i = 2; i < 25; ++i) fp[i] = (const float*)d_in[i];
  p.out = (float*)d_out; p.ws = (char*)d_ws;
  int lo = 0, hi = N_PHASES;
  void* args[] = { &p, &lo, &hi };
  if (!grid_blocks) {
    int dev = 0, cus = 0;
    (void)hipGetDevice(&dev);
    (void)hipDeviceGetAttribute(&cus, hipDeviceAttributeMultiprocessorCount, dev);
    (void)hipFuncSetAttribute((const void*)fwd_megakernel, hipFuncAttributeMaxDynamicSharedMemorySize, LDS_BYTES);
    grid_blocks = cus;
  }
  (void)hipMemsetAsync((char*)d_ws + LB_OFF + 262144, 0, XCD_BAR_WORDS * 4, stream);
  hipError_t e = hipLaunchCooperativeKernel((const void*)fwd_megakernel, dim3(grid_blocks), dim3(NT), args, LDS_BYTES, stream);
  if (e != hipSuccess) fprintf(stderr, "cooperative launch failed: %s (grid %d)\n", hipGetErrorString(e), grid_blocks);
}
```

```cpp
#include <hip/hip_runtime.h>
#include <hip/hip_cooperative_groups.h>
#include <stdint.h>
#include <cstdio>
namespace cg = cooperative_groups;

typedef unsigned short bf16_t;
typedef short bf16x8 __attribute__((ext_vector_type(8)));
typedef float f32x16 __attribute__((ext_vector_type(16)));
typedef float f32x4 __attribute__((ext_vector_type(4)));
typedef float f32x2 __attribute__((ext_vector_type(2)));
typedef unsigned u32x4 __attribute__((ext_vector_type(4)));
typedef unsigned u32x2 __attribute__((ext_vector_type(2)));

#define DI __device__ __forceinline__
#define MFMA(a, b, c) __builtin_amdgcn_mfma_f32_32x32x16_bf16((a), (b), (c), 0, 0, 0)

constexpr int S = 16384;
constexpr int VTS = 16384 + 192;
constexpr int NT = 512;
constexpr int LDS_BYTES = 147456 + 16;
constexpr int HALF_LDS = 73728;
constexpr int WGM = 4;
constexpr size_t MiB = 1048576;
constexpr size_t WM_OFF = 0, WF_OFF = 17 * MiB, HB_OFF = 34 * MiB, PB_OFF = 66 * MiB, VTB_OFF = 198 * MiB,
                 SB_OFF = 263 * MiB, DB_OFF = 327 * MiB, TABR_OFF = 328 * MiB, TABM_OFF = 336 * MiB, LB_OFF = 340 * MiB,
                 SSQA_OFF = LB_OFF + 8192, SSQB_OFF = LB_OFF + 8192 + 65536, WMB_OFF = 341 * MiB, AO_OFF = PB_OFF + 100 * MiB;

struct Params {
  const float* x; const int* pos; const float* norm_mix; const float* norm_ffn;
  const float* hgrn_w_in; const float* hgrn_g_norm; const float* hgrn_w_out; const float* hgrn_lb;
  const float* gla_w_in; const float* gla_w_gk_up; const float* gla_b_gk; const float* gla_g_norm; const float* gla_w_out;
  const float* ret_w_in; const float* ret_w_out;
  const float* mla_w_in; const float* mla_g_q_lora; const float* mla_g_kv_lora; const float* mla_w_uq; const float* mla_w_ukv;
  const float* mla_g_qnorm; const float* mla_g_knorm; const float* mla_w_out;
  const float* ffn_w_gate_up; const float* ffn_w_down;
  float* out; char* ws;
};

DI int tid_() { int t = threadIdx.x & 255; asm volatile("" : "+v"(t)); return t; }
DI int gtid_() { int t = threadIdx.x; asm volatile("" : "+v"(t)); return t; }
DI int VB_() { int hv = __builtin_amdgcn_readfirstlane((int)(threadIdx.x >> 8)); asm volatile("" : "+s"(hv)); return blockIdx.x * 2 + hv; }
DI int VG_() { return gridDim.x * 2; }
typedef __bf16 bf16n2 __attribute__((ext_vector_type(2)));
DI bf16_t f2bf(float x) { return __builtin_bit_cast(bf16_t, (__bf16)x); }
DI float bf2f(bf16_t b) { return __uint_as_float(((unsigned)b) << 16); }
DI unsigned pack2(float a, float b) { bf16n2 v; v[0] = (__bf16)a; v[1] = (__bf16)b; return __builtin_bit_cast(unsigned, v); }
DI float lo2f(unsigned u) { return __uint_as_float(u << 16); }
DI float hi2f(unsigned u) { return __uint_as_float(u & 0xffff0000u); }
DI int crow(int i, int h) { return (i & 3) + 8 * (i >> 2) + 4 * h; }
DI float sigmoidf_(float x) { return __builtin_amdgcn_rcpf(1.0f + __expf(-x)); }
DI float siluf_(float x) { return x * __builtin_amdgcn_rcpf(1.0f + __expf(-x)); }
DI float clampe(float e) { return fminf(fmaxf(e, -80.f), 80.f); }
#define DPP_ADD(v, ctrl) v += __int_as_float(__builtin_amdgcn_mov_dpp(__float_as_int(v), ctrl, 0xF, 0xF, true))
DI float wave_sum(float v) {
  DPP_ADD(v, 0xB1); DPP_ADD(v, 0x4E); DPP_ADD(v, 0x141); DPP_ADD(v, 0x140);
  return (__int_as_float(__builtin_amdgcn_readlane(__float_as_int(v), 0)) + __int_as_float(__builtin_amdgcn_readlane(__float_as_int(v), 16))) +
         (__int_as_float(__builtin_amdgcn_readlane(__float_as_int(v), 32)) + __int_as_float(__builtin_amdgcn_readlane(__float_as_int(v), 48)));
}
DI f32x16 zero16() { f32x16 z; for (int i = 0; i < 16; ++i) z[i] = 0.f; return z; }

DI void conv_tile(const float* __restrict__ src, int K, int N, int mode, bf16_t* __restrict__ dst, int tile, char* smem) {
  float* T = (float*)smem;
  const int nkt = K >> 6, rt = tile / nkt, kt = tile % nkt, tid = tid_();
  const int R0 = rt * 64;
  int n0 = R0;
  if (mode == 1) { const int q = R0 >> 7, t = (R0 & 127) >> 6; n0 = t * 2816 + q * 64; }
#pragma unroll
  for (int i = 0; i < 4; ++i) {
    const int id = tid + 256 * i, kr = id >> 4, c4 = id & 15;
    f32x4 v = {0.f, 0.f, 0.f, 0.f};
    if (n0 + 4 * c4 < N) v = __builtin_nontemporal_load((const f32x4*)(src + (size_t)(kt * 64 + kr) * N + n0 + 4 * c4));
    *(f32x4*)(T + kr * 68 + 4 * c4) = v;
  }
  __syncthreads();
  const int r = tid >> 2, seg = tid & 3;
  u32x4 o0, o1;
  const float* tp = T + (seg * 16) * 68 + r;
  o0.x = pack2(tp[0 * 68], tp[1 * 68]); o0.y = pack2(tp[2 * 68], tp[3 * 68]); o0.z = pack2(tp[4 * 68], tp[5 * 68]); o0.w = pack2(tp[6 * 68], tp[7 * 68]);
  o1.x = pack2(tp[8 * 68], tp[9 * 68]); o1.y = pack2(tp[10 * 68], tp[11 * 68]); o1.z = pack2(tp[12 * 68], tp[13 * 68]); o1.w = pack2(tp[14 * 68], tp[15 * 68]);
  bf16_t* d = dst + (size_t)(R0 + r) * K + kt * 64 + seg * 16;
  *(u32x4*)d = o0; *(u32x4*)(d + 8) = o1;
  __syncthreads();
}

DI void norm_item(const float* __restrict__ x, const float* __restrict__ gain, bf16_t* __restrict__ H, int item) {
  const int wave = tid_() >> 6, lane = tid_() & 63;
  const int row = item * 4 + wave;
  const f32x4* xr = (const f32x4*)(x + (size_t)row * 1024);
  f32x4 v[4]; float ss = 0.f;
#pragma unroll
  for (int j = 0; j < 4; ++j) { v[j] = xr[lane + 64 * j]; ss += v[j].x * v[j].x + v[j].y * v[j].y + v[j].z * v[j].z + v[j].w * v[j].w; }
  ss = wave_sum(ss);
  const float rstd = rsqrtf(ss * (1.0f / 1024.0f) + 1e-6f);
  const f32x4* g4 = (const f32x4*)gain;
#pragma unroll
  for (int j = 0; j < 4; ++j) {
    const f32x4 g = g4[lane + 64 * j];
    u32x2 o; o.x = pack2(v[j].x * rstd * g.x, v[j].y * rstd * g.y); o.y = pack2(v[j].z * rstd * g.z, v[j].w * rstd * g.w);
    *(u32x2*)(H + (size_t)row * 1024 + 4 * (lane + 64 * j)) = o;
  }
}

DI void sincos_acc(float ang, float& c, float& s) {
  const double x = (double)ang;
  const double q = __builtin_rint(x * 0.63661977236758134308);
  const double y = x - q * 1.57079632679489661923;
  const double y2 = y * y;
  double sp = y * (1.0 + y2 * (-1.0 / 6 + y2 * (1.0 / 120 + y2 * (-1.0 / 5040 + y2 * (1.0 / 362880 + y2 * (-1.0 / 39916800))))));
  double cp = 1.0 + y2 * (-0.5 + y2 * (1.0 / 24 + y2 * (-1.0 / 720 + y2 * (1.0 / 40320 + y2 * (-1.0 / 3628800 + y2 * (1.0 / 479001600))))));
  const int k = ((int)q) & 3;
  double sr, cr;
  if (k == 0) { sr = sp; cr = cp; } else if (k == 1) { sr = cp; cr = -sp; } else if (k == 2) { sr = -sp; cr = -cp; } else { sr = -cp; cr = sp; }
  c = (float)cr; s = (float)sr;
}
DI void table_item(const Params& p, int item) {
  const int row = item * 4 + (tid_() >> 6), j = tid_() & 63;
  const float pf = (float)p.pos[row];
  float* tr = (float*)(p.ws + TABR_OFF); float* tm = (float*)(p.ws + TABM_OFF);
  {
    const float inv = 1.0f / exp2f((float)j * (13.287712379549449f / 64.0f));
    float c, s; sincos_acc(pf * inv, c, s);
    tr[(size_t)row * 64 + j] = c; tr[(size_t)S * 64 + (size_t)row * 64 + j] = s;
  }
  if (j < 32) {
    const float inv = 1.0f / exp2f((float)j * (13.287712379549449f / 32.0f));
    float c, s; sincos_acc(pf * inv, c, s);
    tm[(size_t)row * 32 + j] = c; tm[(size_t)S * 32 + (size_t)row * 32 + j] = s;
  }
}
DI void lb_item(const Params& p, int item) {
  const int c = item * 256 + tid_();
  float l[5], mx = -1e30f;
  for (int j = 0; j < 5; ++j) { l[j] = p.hgrn_lb[j * 1024 + c]; mx = fmaxf(mx, l[j]); }
  float sum = 0.f; for (int j = 0; j < 5; ++j) sum += __expf(l[j] - mx);
  ((float*)(p.ws + LB_OFF))[c] = __expf(l[0] - mx) / sum;
}

enum { EP_BF16 = 0, EP_SILU = 1, EP_LOGF = 2, EP_ROPE = 3, EP_VT = 4, EP_RESID = 5, EP_SWIGLU = 6, EP_NONE = 7 };
enum { G_HGRN_IN = 0, G_GLA_IN, G_RET_IN, G_MLA_IN, G_MLA_Q, G_MLA_KV, G_OUT, G_FFN1, G_FFN2 };
struct Epi { int mode; bf16_t* dst; int ld; int dcol0; float scale; const float* xin; float* xout; const float* rs_in; float* ssq_out; const float* gnext; };

DI Epi get_epi(const Params& p, int gid, int nt, int layer) {
  Epi e; e.mode = EP_BF16; e.dst = (bf16_t*)(p.ws + PB_OFF); e.ld = 0; e.dcol0 = 0; e.scale = 1.f; e.xin = nullptr; e.xout = nullptr; e.rs_in = nullptr; e.ssq_out = nullptr; e.gnext = nullptr;
  float* ssqA = (float*)(p.ws + SSQA_OFF); float* ssqB = (float*)(p.ws + SSQB_OFF);
  if (gid <= G_MLA_IN && layer > 0) e.rs_in = ssqB;
  if (gid == G_FFN1) e.rs_in = ssqA;
  bf16_t* VT = (bf16_t*)(p.ws + VTB_OFF);
  const float isq = 0.08838834764831845f;
  if (gid == G_HGRN_IN) {
    e.ld = 3072;
    if (nt < 8) { e.mode = EP_SILU; e.scale = isq; e.dcol0 = nt * 128; }
    else if (nt < 16) { e.mode = EP_LOGF; e.dcol0 = nt * 128; }
    else if (nt < 24) { e.mode = EP_VT; e.dst = VT; e.dcol0 = (nt - 16) * 128; }
    else { e.dcol0 = 2048 + (nt - 24) * 128; }
  } else if (gid == G_GLA_IN) {
    e.ld = 2176;
    if (nt < 4) { e.scale = isq; e.dcol0 = nt * 128; }
    else if (nt < 8) { e.dcol0 = nt * 128; }
    else if (nt < 16) { e.mode = EP_VT; e.dst = VT; e.dcol0 = (nt - 8) * 128; }
    else if (nt < 24) { e.dcol0 = 1024 + (nt - 16) * 128; }
    else if (nt == 24) { e.dcol0 = 2048; }
    else { e.mode = EP_NONE; }
  } else if (gid == G_RET_IN) {
    e.ld = 4160;
    if (nt < 8) { e.mode = EP_ROPE; e.dcol0 = nt * 128; }
    else if (nt < 16) { e.mode = EP_ROPE; e.scale = isq; e.dcol0 = nt * 128; }
    else if (nt < 32) { e.mode = EP_VT; e.dst = VT; e.dcol0 = (nt - 16) * 128; }
    else { e.dcol0 = 2048 + (nt - 32) * 128; }
  } else if (gid == G_MLA_IN) {
    e.ld = 640; e.dcol0 = nt * 128; if (nt >= 5) e.mode = EP_NONE;
  } else if (gid == G_MLA_Q) {
    e.dst = (bf16_t*)(p.ws + PB_OFF + 20 * MiB); e.ld = 1536; e.dcol0 = nt * 128;
  } else if (gid == G_MLA_KV) {
    if (nt & 1) { e.mode = EP_VT; e.dst = VT; e.dcol0 = (nt >> 1) * 128; }
    else { e.dst = (bf16_t*)(p.ws + PB_OFF + 68 * MiB); e.ld = 1024; e.dcol0 = (nt >> 1) * 128; }
  } else if (gid == G_OUT) {
    e.mode = EP_RESID; e.xin = (layer == 0) ? p.x : p.out; e.xout = p.out; e.dcol0 = nt * 128; e.ssq_out = ssqA; e.gnext = p.norm_ffn + layer * 1024;
  } else if (gid == G_FFN1) {
    e.mode = EP_SWIGLU; e.ld = 2816; e.dcol0 = nt * 64;
  } else {
    e.mode = EP_RESID; e.xin = p.out; e.xout = p.out; e.dcol0 = nt * 128; if (layer < 3) { e.ssq_out = ssqB; e.gnext = p.norm_mix + (layer + 1) * 1024; }
  }
  return e;
}

#define MFMA16(a, b, c) __builtin_amdgcn_mfma_f32_16x16x32_bf16((a), (b), (c), 0, 0, 0)
DI void gemm_tile(const Params& p, const bf16_t* __restrict__ A, int lda, const bf16_t* __restrict__ W, int K, int gid, int mt, int nt, int layer, char* smem) {
  const int gt = gtid_(), wave = gt >> 6, lane = gt & 63, l15 = lane & 15, q = lane >> 4, wr = wave >> 2, wc = wave & 3, grp = wc >> 1, wcl = wc & 1;
  const Epi e = get_epi(p, gid, nt * 2 + grp, layer);
  const int nk = K >> 5;
  f32x4 acc[4][2][4];
#pragma unroll
  for (int a = 0; a < 4; ++a)
#pragma unroll
    for (int b = 0; b < 2; ++b)
#pragma unroll
      for (int g = 0; g < 4; ++g) acc[a][b][g] = (f32x4){0.f, 0.f, 0.f, 0.f};
  const int lrow = lane >> 2, lch = (lane & 3) ^ ((0x78 >> (2 * (lrow >> 2))) & 3);
  const bf16_t* Ag = A + (size_t)(mt * 256 + 32 * wave + lrow) * lda + lch * 8;
  const bf16_t* Wg = W + (size_t)(nt * 256 + 32 * wave + lrow) * K + lch * 8;
  const unsigned a16 = (unsigned)(16 * lda), w16 = (unsigned)(16 * K);
  char* ldsw = smem + (32 * wave) * 64;
#define G_ISSUE(KT) { char* st_ = ldsw + ((KT) & 3) * 32768; const unsigned ko_ = (unsigned)((KT) * 32); \
    __builtin_amdgcn_global_load_lds((const unsigned*)(Ag + ko_), (unsigned*)(st_), 16, 0, 0); \
    __builtin_amdgcn_global_load_lds((const unsigned*)(Ag + a16 + ko_), (unsigned*)(st_ + 1024), 16, 0, 0); \
    __builtin_amdgcn_global_load_lds((const unsigned*)(Wg + ko_), (unsigned*)(st_ + 16384), 16, 0, 0); \
    __builtin_amdgcn_global_load_lds((const unsigned*)(Wg + w16 + ko_), (unsigned*)(st_ + 16384 + 1024), 16, 0, 0); }
#define RAW_BARRIER() { asm volatile("s_waitcnt lgkmcnt(0)" ::: "memory"); __builtin_amdgcn_s_barrier(); asm volatile("" ::: "memory"); }
  const int xo = (q ^ ((0x78 >> (2 * (l15 >> 2))) & 3)) * 16;
  const char* Afr = smem + (wr * 128 + l15) * 64 + xo;
  const char* Bfr = smem + 16384 + (grp * 128 + wcl * 32 + l15) * 64 + xo;
  RAW_BARRIER();
  G_ISSUE(0); G_ISSUE(1);
  for (int kt = 0; kt < nk; ++kt) {
    asm volatile("s_waitcnt vmcnt(4)" ::: "memory");
    RAW_BARRIER();
    const char* Ab = Afr + (kt & 3) * 32768; const char* Bb = Bfr + (kt & 3) * 32768;
    bf16x8 wf[2][2], af[4][2];
#pragma unroll
    for (int b = 0; b < 2; ++b)
#pragma unroll
      for (int t = 0; t < 2; ++t) wf[b][t] = *(const bf16x8*)(Bb + (b * 64 + t * 16) * 64);
#pragma unroll
    for (int a = 0; a < 4; ++a)
#pragma unroll
      for (int u2 = 0; u2 < 2; ++u2) af[a][u2] = *(const bf16x8*)(Ab + (a * 32 + u2 * 16) * 64);
    const int ktn = (kt + 2 < nk) ? kt + 2 : nk - 1;
    char* st_ = ldsw + ((kt + 2) & 3) * 32768; const unsigned ko_ = (unsigned)(ktn * 32);
#define MMA(a) { _Pragma("unroll") for (int u2 = 0; u2 < 2; ++u2) _Pragma("unroll") for (int b = 0; b < 2; ++b) _Pragma("unroll") for (int t = 0; t < 2; ++t) \
      acc[a][b][2 * u2 + t] = MFMA16(wf[b][t], af[a][u2], acc[a][b][2 * u2 + t]); }
#define SB() __builtin_amdgcn_sched_barrier(0)
    MMA(0); SB();
    __builtin_amdgcn_global_load_lds((const unsigned*)(Ag + ko_), (unsigned*)(st_), 16, 0, 0);
    SB(); MMA(1); SB();
    __builtin_amdgcn_global_load_lds((const unsigned*)(Ag + a16 + ko_), (unsigned*)(st_ + 1024), 16, 0, 0);
    SB(); MMA(2); SB();
    __builtin_amdgcn_global_load_lds((const unsigned*)(Wg + ko_), (unsigned*)(st_ + 16384), 16, 0, 0);
    SB(); MMA(3); SB();
    __builtin_amdgcn_global_load_lds((const unsigned*)(Wg + w16 + ko_), (unsigned*)(st_ + 16384 + 1024), 16, 0, 0);
    SB();
#undef MMA
#undef SB
  }
  asm volatile("s_waitcnt vmcnt(0)" ::: "memory");
  RAW_BARRIER();
#undef G_ISSUE
#undef RAW_BARRIER
  const int rowbase = mt * 256 + wr * 128;
  if (e.mode == EP_NONE) return;
  char* wl = smem + wave * 18432;
#define WAVE_SYNC() { asm volatile("" ::: "memory"); __builtin_amdgcn_wave_barrier(); asm volatile("s_waitcnt lgkmcnt(0)" ::: "memory"); }
#define RL(a, u2) (32 * (a) + 16 * (u2) + l15)
#define CL(t) (16 * (t) + 4 * q)
  if (e.rs_in) {
#pragma unroll
    for (int a = 0; a < 4; ++a)
#pragma unroll
      for (int u2 = 0; u2 < 2; ++u2) {
        const float rs = rsqrtf(e.rs_in[rowbase + RL(a, u2)] * (1.0f / 1024.0f) + 1e-6f);
#pragma unroll
        for (int b = 0; b < 2; ++b)
#pragma unroll
          for (int t = 0; t < 2; ++t) acc[a][b][2 * u2 + t] = acc[a][b][2 * u2 + t] * rs;
      }
  }
  if (e.mode == EP_VT) {
    bf16_t* St = (bf16_t*)wl;
#pragma unroll
    for (int a = 0; a < 4; ++a)
#pragma unroll
      for (int b = 0; b < 2; ++b)
#pragma unroll
        for (int u2 = 0; u2 < 2; ++u2)
#pragma unroll
          for (int t = 0; t < 2; ++t)
#pragma unroll
            for (int j = 0; j < 4; ++j) St[(32 * b + CL(t) + j) * 136 + RL(a, u2)] = f2bf(acc[a][b][2 * u2 + t][j]);
    WAVE_SYNC();
#pragma unroll
    for (int j = 0; j < 16; ++j) {
      const int id = lane + 64 * j, nl = id >> 4, ch = id & 15;
      const int n = 32 * wcl + 64 * (nl >> 5) + (nl & 31);
      *(u32x4*)(e.dst + (unsigned)((e.dcol0 + n) * VTS + rowbase + ch * 8)) = *(const u32x4*)(St + nl * 136 + ch * 8);
    }
    return;
  }
  if (e.mode == EP_RESID) {
    float* St = (float*)wl;
#pragma unroll
    for (int ps = 0; ps < 2; ++ps) {
#pragma unroll
      for (int a2 = 0; a2 < 2; ++a2)
#pragma unroll
        for (int b = 0; b < 2; ++b)
#pragma unroll
          for (int u2 = 0; u2 < 2; ++u2)
#pragma unroll
            for (int t = 0; t < 2; ++t) *(f32x4*)(St + RL(a2, u2) * 68 + 32 * b + CL(t)) = acc[2 * ps + a2][b][2 * u2 + t];
      WAVE_SYNC();
      const int pc = lane & 15, piece = pc >> 3, c4 = pc & 7, colx = e.dcol0 + 32 * wcl + 64 * piece + c4 * 4;
      f32x4 g4 = {1.f, 1.f, 1.f, 1.f};
      if (e.ssq_out) g4 = *(const f32x4*)(e.gnext + colx);
#pragma unroll
      for (int j = 0; j < 16; ++j) {
        const int id = lane + 64 * j, rw = id >> 4;
        const unsigned off = (unsigned)((rowbase + 64 * ps + rw) * 1024 + colx);
        const f32x4 xv = *(const f32x4*)(e.xin + off);
        const f32x4 av = *(const f32x4*)(St + rw * 68 + piece * 32 + c4 * 4);
        const f32x4 xn = xv + av;
        *(f32x4*)(e.xout + off) = xn;
        if (e.ssq_out) {
          u32x2 hb; hb.x = pack2(xn.x * g4.x, xn.y * g4.y); hb.y = pack2(xn.z * g4.z, xn.w * g4.w);
          *(u32x2*)((bf16_t*)(p.ws + HB_OFF) + off) = hb;
          float sq = xn.x * xn.x + xn.y * xn.y + xn.z * xn.z + xn.w * xn.w;
          DPP_ADD(sq, 0xB1); DPP_ADD(sq, 0x4E); DPP_ADD(sq, 0x141); DPP_ADD(sq, 0x140);
          if ((lane & 15) == 0) atomicAdd(e.ssq_out + (rowbase + 64 * ps + rw), sq);
        }
      }
      WAVE_SYNC();
    }
    return;
  }
  if (e.mode == EP_SWIGLU) {
    bf16_t* St = (bf16_t*)wl;
#pragma unroll
    for (int a = 0; a < 4; ++a)
#pragma unroll
      for (int u2 = 0; u2 < 2; ++u2)
#pragma unroll
        for (int t = 0; t < 2; ++t) {
          const f32x4 x = acc[a][0][2 * u2 + t], y = acc[a][1][2 * u2 + t];
          u32x2 o;
          o.x = pack2(siluf_(x.x) * y.x, siluf_(x.y) * y.y); o.y = pack2(siluf_(x.z) * y.z, siluf_(x.w) * y.w);
          *(u32x2*)(St + RL(a, u2) * 40 + CL(t)) = o;
        }
    WAVE_SYNC();
#pragma unroll
    for (int j = 0; j < 8; ++j) {
      const int id = lane + 64 * j, rw = id >> 2, c4 = id & 3;
      *(u32x4*)(e.dst + (unsigned)((rowbase + rw) * 2816 + e.dcol0 + 32 * wcl + c4 * 8)) = *(const u32x4*)(St + rw * 40 + c4 * 8);
    }
    return;
  }
  bf16_t* St = (bf16_t*)wl;
  if (e.mode == EP_ROPE) {
    const float* ct = (const float*)(p.ws + TABR_OFF); const float* st = ct + (size_t)S * 64;
#pragma unroll
    for (int a = 0; a < 4; ++a)
#pragma unroll
      for (int u2 = 0; u2 < 2; ++u2)
#pragma unroll
        for (int t = 0; t < 2; ++t) {
          const unsigned ti = (unsigned)((rowbase + RL(a, u2)) * 64 + 32 * wcl + CL(t));
          const f32x4 c = *(const f32x4*)(ct + ti), sn = *(const f32x4*)(st + ti);
          const f32x4 x1 = acc[a][0][2 * u2 + t], x2 = acc[a][1][2 * u2 + t];
          u32x2 o1, o2;
          o1.x = pack2((x1.x * c.x - x2.x * sn.x) * e.scale, (x1.y * c.y - x2.y * sn.y) * e.scale); o1.y = pack2((x1.z * c.z - x2.z * sn.z) * e.scale, (x1.w * c.w - x2.w * sn.w) * e.scale);
          o2.x = pack2((x2.x * c.x + x1.x * sn.x) * e.scale, (x2.y * c.y + x1.y * sn.y) * e.scale); o2.y = pack2((x2.z * c.z + x1.z * sn.z) * e.scale, (x2.w * c.w + x1.w * sn.w) * e.scale);
          *(u32x2*)(St + RL(a, u2) * 72 + CL(t)) = o1;
          *(u32x2*)(St + RL(a, u2) * 72 + 32 + CL(t)) = o2;
        }
  } else {
#pragma unroll
    for (int b = 0; b < 2; ++b)
#pragma unroll
      for (int t = 0; t < 2; ++t) {
        f32x4 lbv = {0.f, 0.f, 0.f, 0.f};
        if (e.mode == EP_LOGF) lbv = *(const f32x4*)((const float*)(p.ws + LB_OFF) + (e.dcol0 - 1024 + 32 * wcl + 64 * b + CL(t)));
#pragma unroll
        for (int a = 0; a < 4; ++a)
#pragma unroll
          for (int u2 = 0; u2 < 2; ++u2) {
            const f32x4 v = acc[a][b][2 * u2 + t];
            float v0 = v.x, v1 = v.y, v2 = v.z, v3 = v.w;
            if (e.mode == EP_SILU) { v0 = siluf_(v0) * e.scale; v1 = siluf_(v1) * e.scale; v2 = siluf_(v2) * e.scale; v3 = siluf_(v3) * e.scale; }
            else if (e.mode == EP_LOGF) {
              v0 = __logf(lbv.x + (1.f - lbv.x) * sigmoidf_(v0)); v1 = __logf(lbv.y + (1.f - lbv.y) * sigmoidf_(v1));
              v2 = __logf(lbv.z + (1.f - lbv.z) * sigmoidf_(v2)); v3 = __logf(lbv.w + (1.f - lbv.w) * sigmoidf_(v3));
            } else { v0 *= e.scale; v1 *= e.scale; v2 *= e.scale; v3 *= e.scale; }
            u32x2 o; o.x = pack2(v0, v1); o.y = pack2(v2, v3);
            *(u32x2*)(St + RL(a, u2) * 72 + 32 * b + CL(t)) = o;
          }
      }
  }
  WAVE_SYNC();
#pragma unroll
  for (int j = 0; j < 16; ++j) {
    const int id = lane + 64 * j, rw = id >> 3, pc = id & 7, piece = pc >> 2, c4 = pc & 3;
    *(u32x4*)(e.dst + (unsigned)((rowbase + rw) * e.ld + e.dcol0 + 32 * wcl + 64 * piece + c4 * 8)) = *(const u32x4*)(St + rw * 72 + piece * 32 + c4 * 8);
  }
#undef WAVE_SYNC
#undef RL
#undef CL
}

struct ScanDesc {
  const bf16_t* q; const bf16_t* k; const bf16_t* g; int ldp, ldg;
  bf16_t* gate;
  const float* gnorm;
  int mode;
  int H0, Hg, dv;
};
DI float ret_lg(int hh) { return __logf(1.0f - exp2f(-5.0f - (float)hh)); }

DI void scan1_run(const Params& p, const ScanDesc& d, int n, char* smem) {
  bf16_t* Gs = (bf16_t*)smem;
  bf16_t* Kr = (bf16_t*)(smem + 16384);
  bf16_t* KmT = (bf16_t*)(smem + 32768);
  bf16_t* VTs = (bf16_t*)(smem + 51200);
  float* tot = (float*)(smem + 69632);
  float* fac = (float*)(smem + 70656);
  const int ndvb = d.dv >> 7;
  const int G = VG_(), B = VB_();
  const int tid = tid_(), kk = tid & 127, half = tid >> 7;
  const int wave = tid >> 6, lane = tid & 63, r = lane & 31, h = lane >> 5;
  const bf16_t* VT = (const bf16_t*)(p.ws + VTB_OFF);
  u32x4 pg[4], pk[4], pv[4];
#define S1_ISSUE(U) { const int dvb_ = (U) % ndvb, hl_ = ((U) / ndvb) % d.Hg, c_ = (U) / (ndvb * d.Hg), hh_ = d.H0 + hl_, row0_ = c_ * 64; \
    _Pragma("unroll") for (int i = 0; i < 4; ++i) { const int id = tid + 256 * i, rw = id >> 4, ch = id & 15; \
      if (d.mode != 2) pg[i] = *(const u32x4*)(d.g + (size_t)(row0_ + rw) * d.ldg + hh_ * 128 + ch * 8); \
      if (d.mode != 0) pk[i] = *(const u32x4*)(d.k + (size_t)(row0_ + rw) * d.ldp + hh_ * 128 + ch * 8); \
      const int v = id >> 3, c8 = id & 7; \
      pv[i] = *(const u32x4*)(VT + (size_t)(hh_ * d.dv + dvb_ * 128 + v) * VTS + row0_ + c8 * 8); } }
  { int u = B; if (u >= n) u = n - 1; S1_ISSUE(u); }
  for (int u0 = 0; u0 < n; u0 += G) {
    int unit = u0 + B; if (unit >= n) unit = n - 1;
    const int dvb = unit % ndvb, hl = (unit / ndvb) % d.Hg, c = unit / (ndvb * d.Hg);
    const int hh = d.H0 + hl;
#pragma unroll
    for (int i = 0; i < 4; ++i) {
      const int id = tid + 256 * i, rw = id >> 4, ch = id & 15;
      if (d.mode != 2) *(u32x4*)(Gs + rw * 128 + ch * 8) = pg[i];
      if (d.mode != 0) *(u32x4*)(Kr + rw * 128 + ch * 8) = pk[i];
      const int v = id >> 3, c8 = id & 7;
      *(u32x4*)(VTs + v * 72 + c8 * 8) = pv[i];
    }
    __syncthreads();
    if (u0 + G < n) { int un = u0 + G + B; if (un >= n) un = n - 1; S1_ISSUE(un); }
    float gv[32];
    float tsum = 0.f;
    if (d.mode == 2) { const float lg = ret_lg(hh);
#pragma unroll
      for (int j = 0; j < 32; ++j) gv[j] = lg;
      tsum = 32.f * lg;
    } else {
#pragma unroll
      for (int j = 0; j < 32; ++j) { gv[j] = bf2f(Gs[(32 * half + j) * 128 + kk]); tsum += gv[j]; }
    }
    tot[half * 128 + kk] = tsum;
    __syncthreads();
    const float cum31 = tot[kk], last = cum31 + tot[128 + kk];
    if (half == 0) {
      fac[kk] = __expf(clampe(last - cum31));
      if (dvb == 0) ((float*)(p.ws + DB_OFF))[(size_t)(c * d.Hg + hl) * 128 + kk] = __expf(last);
    }
    float crun = half ? cum31 : 0.f;
#pragma unroll
    for (int g8 = 0; g8 < 4; ++g8) {
      float km[8];
#pragma unroll
      for (int j8 = 0; j8 < 8; ++j8) {
        const int j = g8 * 8 + j8;
        crun += gv[j];
        const float kval = (d.mode == 0) ? (1.0f - __expf(gv[j])) : bf2f(Kr[(32 * half + j) * 128 + kk]);
        km[j8] = kval * __expf(clampe(cum31 - crun));
      }
      u32x4 o; o.x = pack2(km[0], km[1]); o.y = pack2(km[2], km[3]); o.z = pack2(km[4], km[5]); o.w = pack2(km[6], km[7]);
      *(u32x4*)(KmT + kk * 72 + 32 * half + 8 * g8) = o;
    }
    __syncthreads();
    f32x16 acc[4];
#pragma unroll
    for (int nn = 0; nn < 4; ++nn) acc[nn] = zero16();
#pragma unroll
    for (int ks = 0; ks < 4; ++ks) {
      const bf16x8 a = *(const bf16x8*)(VTs + (32 * wave + r) * 72 + 16 * ks + 8 * h);
#pragma unroll
      for (int nn = 0; nn < 4; ++nn) {
        const bf16x8 bb = *(const bf16x8*)(KmT + (32 * nn + r) * 72 + 16 * ks + 8 * h);
        acc[nn] = MFMA(a, bb, acc[nn]);
      }
    }
#pragma unroll
    for (int nn = 0; nn < 4; ++nn) {
      const float f = fac[32 * nn + r];
#pragma unroll
      for (int i = 0; i < 16; ++i) Gs[(32 * wave + crow(i, h)) * 128 + 32 * nn + r] = f2bf(acc[nn][i] * f);
    }
    __syncthreads();
    bf16_t* Sb = (bf16_t*)(p.ws + SB_OFF) + ((size_t)(c * d.Hg + hl) * d.dv + dvb * 128) * 128;
#pragma unroll
    for (int i = 0; i < 8; ++i) { const int id = tid + 256 * i; *(u32x4*)(Sb + id * 8) = *(const u32x4*)(Gs + id * 8); }
    __syncthreads();
  }
#undef S1_ISSUE
}

DI void scan2_phase(const Params& p, const ScanDesc& d, bool live) {
  bf16_t* Sb = (bf16_t*)(p.ws + SB_OFF);
  const float* Db = (const float*)(p.ws + DB_OFF);
  const int per_c = d.Hg * d.dv * 128;
  const int n8 = per_c >> 3;
  const int tid = tid_();
  if (tid >= 32) return;
  for (int e8 = VB_() * 32 + tid; e8 < n8; e8 += VG_() * 32) {
    const int hl = e8 / (d.dv * 16), kk = (e8 & 15) * 8;
    bf16_t* sp = Sb + (size_t)e8 * 8; const float* dp = Db + hl * 128 + kk;
    float r[8];
#pragma unroll
    for (int q = 0; q < 8; ++q) r[q] = 0.f;
    for (int c0 = 0; c0 < 256; c0 += 8) {
      u32x4 L[8]; f32x4 d0[8], d1[8];
#pragma unroll
      for (int j = 0; j < 8; ++j) {
        L[j] = *(const u32x4*)(sp + (size_t)(c0 + j) * per_c);
        d0[j] = *(const f32x4*)(dp + (size_t)(c0 + j) * d.Hg * 128); d1[j] = *(const f32x4*)(dp + (size_t)(c0 + j) * d.Hg * 128 + 4);
      }
#pragma unroll
      for (int j = 0; j < 8; ++j) {
        u32x4 o; o.x = pack2(r[0], r[1]); o.y = pack2(r[2], r[3]); o.z = pack2(r[4], r[5]); o.w = pack2(r[6], r[7]);
        if (live) *(u32x4*)(sp + (size_t)(c0 + j) * per_c) = o;
        r[0] = d0[j].x * r[0] + lo2f(L[j].x); r[1] = d0[j].y * r[1] + hi2f(L[j].x); r[2] = d0[j].z * r[2] + lo2f(L[j].y); r[3] = d0[j].w * r[3] + hi2f(L[j].y);
        r[4] = d1[j].x * r[4] + lo2f(L[j].z); r[5] = d1[j].y * r[5] + hi2f(L[j].z); r[6] = d1[j].z * r[6] + lo2f(L[j].w); r[7] = d1[j].w * r[7] + hi2f(L[j].w);
      }
    }
    if (!live && r[0] == 1.2345e-30f) sp[0] = 0;
  }
}

DI void scan3_unit(const Params& p, const ScanDesc& d, int unit, bool valid, char* smem) {
  bf16_t* Qm = (bf16_t*)smem;
  bf16_t* Km = (bf16_t*)(smem + 17408);
  bf16_t* VTs = Km;
  bf16_t* Pm = (bf16_t*)(smem + 35840);
  bf16_t* Gs = Pm;
  bf16_t* Ss = (bf16_t*)(smem + 45056);
  float* tot = (float*)(smem + 63488);
  float* e31 = (float*)(smem + 64512);
  float* red = (float*)(smem + 65024);
  const int hl = unit % d.Hg, c = unit / d.Hg;
  const int hh = d.H0 + hl, row0 = c * 64;
  const int tid = tid_(), kk = tid & 127, half = tid >> 7;
  const int wave = tid >> 6, lane = tid & 63, r = lane & 31, h = lane >> 5;
#pragma unroll
  for (int i = 0; i < 4; ++i) {
    const int id = tid + 256 * i, rw = id >> 4, ch = id & 15;
    if (d.mode != 2) *(u32x4*)(Gs + rw * 128 + ch * 8) = *(const u32x4*)(d.g + (size_t)(row0 + rw) * d.ldg + hh * 128 + ch * 8);
    if (d.mode != 0) *(u32x4*)(Km + rw * 136 + ch * 8) = *(const u32x4*)(d.k + (size_t)(row0 + rw) * d.ldp + hh * 128 + ch * 8);
    *(u32x4*)(Qm + rw * 136 + ch * 8) = *(const u32x4*)(d.q + (size_t)(row0 + rw) * d.ldp + hh * 128 + ch * 8);
  }
  __syncthreads();
  {
    float gv[32];
    float tsum = 0.f;
    if (d.mode == 2) { const float lg = ret_lg(hh);
#pragma unroll
      for (int j = 0; j < 32; ++j) gv[j] = lg;
      tsum = 32.f * lg;
    } else {
#pragma unroll
      for (int j = 0; j < 32; ++j) { gv[j] = bf2f(Gs[(32 * half + j) * 128 + kk]); tsum += gv[j]; }
    }
    tot[half * 128 + kk] = tsum;
    __syncthreads();
    const float cum31 = tot[kk];
    if (half == 0) e31[kk] = __expf(cum31);
    float crun = half ? cum31 : 0.f;
#pragma unroll
    for (int j = 0; j < 32; ++j) {
      crun += gv[j];
      const float e = clampe(crun - cum31);
      const int idx = (32 * half + j) * 136 + kk;
      const float kval = (d.mode == 0) ? (1.0f - __expf(gv[j])) : bf2f(Km[idx]);
      const float qval = bf2f(Qm[idx]);
      Qm[idx] = f2bf(qval * __expf(e));
      Km[idx] = f2bf(kval * __expf(-e));
    }
  }
  __syncthreads();
  if (wave < 3) {
    const int I = (wave >= 1), J = (wave == 2);
    f32x16 sc = zero16();
#pragma unroll
    for (int ks = 0; ks < 8; ++ks) {
      const bf16x8 a = *(const bf16x8*)(Qm + (32 * I + r) * 136 + 16 * ks + 8 * h);
      const bf16x8 b = *(const bf16x8*)(Km + (32 * J + r) * 136 + 16 * ks + 8 * h);
      sc = MFMA(a, b, sc);
    }
#pragma unroll
    for (int i = 0; i < 16; ++i) {
      const int t = crow(i, h);
      float v = sc[i];
      if (I == J) v = (r <= t) ? v : 0.f;
      Pm[(32 * I + t) * 72 + 32 * J + r] = f2bf(v);
    }
  }
  __syncthreads();
  const int ndvb = d.dv >> 7;
  f32x16 acc[2][2];
#pragma unroll
  for (int a = 0; a < 2; ++a)
#pragma unroll
    for (int b = 0; b < 2; ++b) acc[a][b] = zero16();
  const bf16_t* VT = (const bf16_t*)(p.ws + VTB_OFF);
#pragma unroll
  for (int dvb = 0; dvb < 2; ++dvb) {
    if (dvb < ndvb) {
      const bf16_t* Sg = (const bf16_t*)(p.ws + SB_OFF) + ((size_t)(c * d.Hg + hl) * d.dv + dvb * 128) * 128;
#pragma unroll
      for (int i = 0; i < 4; ++i) {
        const int id = tid + 256 * i, v = id >> 3, ch = id & 7;
        *(u32x4*)(VTs + v * 72 + ch * 8) = *(const u32x4*)(VT + (size_t)(hh * d.dv + dvb * 128 + v) * VTS + row0 + ch * 8);
      }
#pragma unroll
      for (int hk = 0; hk < 2; ++hk) {
#pragma unroll
        for (int i = 0; i < 4; ++i) {
          const int id = tid + 256 * i, v = id >> 3, ch = id & 7;
          const u32x4 sv = *(const u32x4*)(Sg + (size_t)v * 128 + hk * 64 + ch * 8);
          const float* ef = e31 + hk * 64 + ch * 8;
          u32x4 o;
          o.x = pack2(lo2f(sv.x) * ef[0], hi2f(sv.x) * ef[1]); o.y = pack2(lo2f(sv.y) * ef[2], hi2f(sv.y) * ef[3]);
          o.z = pack2(lo2f(sv.z) * ef[4], hi2f(sv.z) * ef[5]); o.w = pack2(lo2f(sv.w) * ef[6], hi2f(sv.w) * ef[7]);
          *(u32x4*)(Ss + v * 72 + ch * 8) = o;
        }
        __syncthreads();
#pragma unroll
        for (int mt2 = 0; mt2 < 2; ++mt2) {
          if (hk == 0) {
#pragma unroll
            for (int ks = 0; ks < 4; ++ks) {
              if (mt2 == 1 || ks < 2) {
                const bf16x8 a = *(const bf16x8*)(Pm + (32 * mt2 + r) * 72 + 16 * ks + 8 * h);
                const bf16x8 b = *(const bf16x8*)(VTs + (32 * wave + r) * 72 + 16 * ks + 8 * h);
                acc[dvb][mt2] = MFMA(a, b, acc[dvb][mt2]);
              }
            }
          }
#pragma unroll
          for (int ks = 0; ks < 4; ++ks) {
            const bf16x8 a = *(const bf16x8*)(Qm + (32 * mt2 + r) * 136 + hk * 64 + 16 * ks + 8 * h);
            const bf16x8 b = *(const bf16x8*)(Ss + (32 * wave + r) * 72 + 16 * ks + 8 * h);
            acc[dvb][mt2] = MFMA(a, b, acc[dvb][mt2]);
          }
        }
        __syncthreads();
      }
    }
  }
#pragma unroll
  for (int mt2 = 0; mt2 < 2; ++mt2)
#pragma unroll
    for (int i = 0; i < 16; ++i) {
      float ssq = acc[0][mt2][i] * acc[0][mt2][i];
      if (ndvb == 2) ssq += acc[1][mt2][i] * acc[1][mt2][i];
      DPP_ADD(ssq, 0xB1); DPP_ADD(ssq, 0x4E); DPP_ADD(ssq, 0x141); DPP_ADD(ssq, 0x140);
      const float s0 = __int_as_float(__builtin_amdgcn_readlane(__float_as_int(ssq), 0)) + __int_as_float(__builtin_amdgcn_readlane(__float_as_int(ssq), 16));
      const float s1 = __int_as_float(__builtin_amdgcn_readlane(__float_as_int(ssq), 32)) + __int_as_float(__builtin_amdgcn_readlane(__float_as_int(ssq), 48));
      if (r == 0) red[wave * 64 + 32 * mt2 + crow(i, h)] = h ? s1 : s0;
    }
  __syncthreads();
  const float invdv = 1.0f / (float)d.dv;
  bf16_t* Ot = Qm;
#pragma unroll
  for (int dvb = 0; dvb < 2; ++dvb) {
    if (dvb < ndvb) {
      const int v = dvb * 128 + 32 * wave + r;
      const float gn = d.gnorm ? d.gnorm[v] : 1.0f;
#pragma unroll
      for (int mt2 = 0; mt2 < 2; ++mt2)
#pragma unroll
        for (int i = 0; i < 16; ++i) {
          const int t = 32 * mt2 + crow(i, h);
          const float tsq = red[t] + red[64 + t] + red[128 + t] + red[192 + t];
          const float rstd = rsqrtf(tsq * invdv + 1e-6f);
          Ot[t * 136 + 32 * wave + r] = f2bf(acc[dvb][mt2][i] * rstd * gn);
        }
      __syncthreads();
#pragma unroll
      for (int i = 0; i < 4; ++i) {
        const int id = tid + 256 * i, t = id >> 4, ch = id & 15;
        bf16_t* gp = d.gate + (size_t)(row0 + t) * d.ldp + hh * d.dv + dvb * 128 + ch * 8;
        const u32x4 gt = *(const u32x4*)gp;
        const u32x4 ov = *(const u32x4*)(Ot + t * 136 + ch * 8);
        u32x4 o;
        o.x = pack2(lo2f(ov.x) * siluf_(lo2f(gt.x)), hi2f(ov.x) * siluf_(hi2f(gt.x)));
        o.y = pack2(lo2f(ov.y) * siluf_(lo2f(gt.y)), hi2f(ov.y) * siluf_(hi2f(gt.y)));
        o.z = pack2(lo2f(ov.z) * siluf_(lo2f(gt.z)), hi2f(ov.z) * siluf_(hi2f(gt.z)));
        o.w = pack2(lo2f(ov.w) * siluf_(lo2f(gt.w)), hi2f(ov.w) * siluf_(hi2f(gt.w)));
        if (valid) *(u32x4*)gp = o;
      }
      __syncthreads();
    }
  }
}

DI void gla_gate_phase(const Params& p) {
  const bf16_t* P = (const bf16_t*)(p.ws + PB_OFF);
  bf16_t* G = (bf16_t*)(p.ws + HB_OFF);
  const int tid = tid_();
  float w0[16], w1[16];
#pragma unroll
  for (int j = 0; j < 16; ++j) { w0[j] = p.gla_w_gk_up[j * 512 + 2 * tid]; w1[j] = p.gla_w_gk_up[j * 512 + 2 * tid + 1]; }
  const float b0 = p.gla_b_gk[2 * tid], b1 = p.gla_b_gk[2 * tid + 1];
  for (int row = VB_(); row < S; row += VG_()) {
    const u32x4 g0 = *(const u32x4*)(P + (size_t)row * 2176 + 2048), g1 = *(const u32x4*)(P + (size_t)row * 2176 + 2056);
    float gl[16];
    gl[0] = lo2f(g0.x); gl[1] = hi2f(g0.x); gl[2] = lo2f(g0.y); gl[3] = hi2f(g0.y); gl[4] = lo2f(g0.z); gl[5] = hi2f(g0.z); gl[6] = lo2f(g0.w); gl[7] = hi2f(g0.w);
    gl[8] = lo2f(g1.x); gl[9] = hi2f(g1.x); gl[10] = lo2f(g1.y); gl[11] = hi2f(g1.y); gl[12] = lo2f(g1.z); gl[13] = hi2f(g1.z); gl[14] = lo2f(g1.w); gl[15] = hi2f(g1.w);
    float z0 = b0, z1 = b1;
#pragma unroll
    for (int j = 0; j < 16; ++j) { z0 += gl[j] * w0[j]; z1 += gl[j] * w1[j]; }
    const float l0 = (fminf(z0, 0.f) - __logf(1.0f + __expf(-fabsf(z0)))) * 0.0625f;
    const float l1 = (fminf(z1, 0.f) - __logf(1.0f + __expf(-fabsf(z1)))) * 0.0625f;
    *(unsigned*)(G + (size_t)row * 512 + 2 * tid) = pack2(l0, l1);
  }
}

DI void mla_m1_item(const Params& p, int item, bool live) {
  bf16_t* P1 = (bf16_t*)(p.ws + PB_OFF);
  const int wave = tid_() >> 6, lane = tid_() & 63;
  const int row = item * 4 + wave;
  unsigned* rp = (unsigned*)(P1 + (size_t)row * 640);
  unsigned a[3]; float ss = 0.f;
#pragma unroll
  for (int j = 0; j < 3; ++j) { a[j] = rp[lane + 64 * j]; const float x0 = lo2f(a[j]), x1 = hi2f(a[j]); ss += x0 * x0 + x1 * x1; }
  const unsigned b = rp[192 + lane]; const float y0 = lo2f(b), y1 = hi2f(b);
  float s2 = y0 * y0 + y1 * y1;
  ss = wave_sum(ss); s2 = wave_sum(s2);
  const float r1 = rsqrtf(ss * (1.0f / 384.0f) + 1e-6f), r2 = rsqrtf(s2 * (1.0f / 128.0f) + 1e-6f);
  if (live || r2 == 1.2345e-30f)
#pragma unroll
  for (int j = 0; j < 3; ++j) { const int c = 2 * (lane + 64 * j); rp[lane + 64 * j] = pack2(lo2f(a[j]) * r1 * p.mla_g_q_lora[c], hi2f(a[j]) * r1 * p.mla_g_q_lora[c + 1]); }
  if (live || r1 == 1.2345e-30f) rp[192 + lane] = pack2(y0 * r2 * p.mla_g_kv_lora[2 * lane], y1 * r2 * p.mla_g_kv_lora[2 * lane + 1]);
}
DI void mla_m3_item(const Params& p, int item, bool live, char* sm) {
  const bf16_t* P1 = (const bf16_t*)(p.ws + PB_OFF);
  bf16_t* Q = (bf16_t*)(p.ws + PB_OFF + 20 * MiB);
  const bf16_t* KR = (const bf16_t*)(p.ws + PB_OFF + 68 * MiB);
  bf16_t* KF = (bf16_t*)(p.ws + SB_OFF);
  const float* ct = (const float*)(p.ws + TABM_OFF); const float* st = ct + (size_t)S * 32;
  const int wave = tid_() >> 6, lane = tid_() & 63;
  const int row = item * 4 + wave, j = lane & 31;
  bf16_t* Lq = (bf16_t*)(sm + wave * 8448);
  bf16_t* Lk = Lq + 1536;
  bf16_t* Lo = Lk + 1088;
#define M3_SYNC() { asm volatile("" ::: "memory"); __builtin_amdgcn_wave_barrier(); asm volatile("s_waitcnt lgkmcnt(0)" ::: "memory"); }
#pragma unroll
  for (int i = 0; i < 3; ++i) *(u32x4*)(Lq + (lane + 64 * i) * 8) = *(const u32x4*)(Q + (size_t)row * 1536 + (lane + 64 * i) * 8);
#pragma unroll
  for (int i = 0; i < 2; ++i) *(u32x4*)(Lk + (lane + 64 * i) * 8) = *(const u32x4*)(KR + (size_t)row * 1024 + (lane + 64 * i) * 8);
  if (lane < 8) *(u32x4*)(Lk + 1024 + lane * 8) = *(const u32x4*)(P1 + (size_t)row * 640 + 512 + lane * 8);
  const float c = ct[(size_t)row * 32 + j], s = st[(size_t)row * 32 + j];
  const float sgn = (lane < 32) ? -1.f : 1.f;
  const float qscale = 0.07216878364870322f * 1.4426950408889634f;
  const float gq0 = p.mla_g_qnorm[lane], gq1 = p.mla_g_qnorm[64 + lane], gq2 = p.mla_g_qnorm[128 + lane];
  const float gk0 = p.mla_g_knorm[lane], gk1 = p.mla_g_knorm[64 + lane], gk2 = p.mla_g_knorm[128 + lane];
  M3_SYNC();
  const float kr = bf2f(Lk[1024 + lane]);
#pragma unroll
  for (int hd = 0; hd < 8; ++hd) {
    bf16_t* qp = Lq + hd * 192;
    float v0 = bf2f(qp[lane]), v1 = bf2f(qp[64 + lane]), v2 = bf2f(qp[128 + lane]);
    float ss = wave_sum(v0 * v0 + v1 * v1 + v2 * v2);
    float rs = rsqrtf(ss * (1.0f / 192.0f) + 1e-6f);
    v0 *= rs * gq0; v1 *= rs * gq1; v2 *= rs * gq2;
    float pr = __shfl_xor(v2, 32);
    float o2 = v2 * c + sgn * pr * s;
    qp[lane] = f2bf(v0 * qscale); qp[64 + lane] = f2bf(v1 * qscale); qp[128 + lane] = f2bf(o2 * qscale);
    const bf16_t* kp = Lk + hd * 128;
    float k0 = bf2f(kp[lane]), k1 = bf2f(kp[64 + lane]), k2 = kr;
    ss = wave_sum(k0 * k0 + k1 * k1 + k2 * k2);
    rs = rsqrtf(ss * (1.0f / 192.0f) + 1e-6f);
    k0 *= rs * gk0; k1 *= rs * gk1; k2 *= rs * gk2;
    pr = __shfl_xor(k2, 32);
    o2 = k2 * c + sgn * pr * s;
    bf16_t* ko = Lo + hd * 192;
    ko[lane] = f2bf(k0); ko[64 + lane] = f2bf(k1); ko[128 + lane] = f2bf(o2);
  }
  M3_SYNC();
  if (live || c == 1.2345e-30f) {
#pragma unroll
    for (int i = 0; i < 3; ++i) {
      *(u32x4*)(Q + (size_t)row * 1536 + (lane + 64 * i) * 8) = *(const u32x4*)(Lq + (lane + 64 * i) * 8);
      *(u32x4*)(KF + (size_t)row * 1536 + (lane + 64 * i) * 8) = *(const u32x4*)(Lo + (lane + 64 * i) * 8);
    }
  }
  M3_SYNC();
#undef M3_SYNC
}

DI void attn_unit(const Params& p, int unit, char* smem) {
  bf16_t* Ks = (bf16_t*)smem;
  bf16_t* VTs = (bf16_t*)(smem + 51200);
  const bf16_t* Q = (const bf16_t*)(p.ws + PB_OFF + 20 * MiB);
  const bf16_t* KF = (const bf16_t*)(p.ws + SB_OFF);
  const bf16_t* VT = (const bf16_t*)(p.ws + VTB_OFF);
  bf16_t* AO = (bf16_t*)(p.ws + AO_OFF);
  const int hd = unit & 7, qb = (unit < 256) ? 63 - (unit >> 3) : ((unit - 256) >> 3);
  const int gt = gtid_(), wave = gt >> 6, lane = gt & 63, r = lane & 31, h = lane >> 5;
  const int qrow = qb * 256 + 32 * wave + r;
  bf16x8 qf[12];
#pragma unroll
  for (int ks = 0; ks < 12; ++ks) qf[ks] = *(const bf16x8*)(Q + (size_t)qrow * 1536 + hd * 192 + 16 * ks + 8 * h);
  const int nkt = 4 * qb + 4;
  const int kmax_w = (qb * 256 + 32 * wave + 31) >> 6;
  const int kmask_w = (qb * 256 + 32 * wave) >> 6;
  float m = -1e30f, l = 0.f;
  f32x16 oacc[4];
#pragma unroll
  for (int i = 0; i < 4; ++i) oacc[i] = zero16();
  u32x4 rk[3], rv[2];
  const bf16_t* KFh = KF + hd * 192;
  const bf16_t* VTh = VT + (size_t)(hd * 128) * VTS;
#define A_LOAD(K0) { _Pragma("unroll") for (int i = 0; i < 3; ++i) { const int id = gt + 512 * i, kr = id / 24, ch = id % 24; rk[i] = *(const u32x4*)(KFh + (size_t)((K0) + kr) * 1536 + ch * 8); } \
                     _Pragma("unroll") for (int i = 0; i < 2; ++i) { const int id = gt + 512 * i, v = id >> 3, c8 = id & 7; rv[i] = *(const u32x4*)(VTh + (size_t)v * VTS + (K0) + c8 * 8); } }
#define A_STORE(BUF) { _Pragma("unroll") for (int i = 0; i < 3; ++i) { const int id = gt + 512 * i, kr = id / 24, ch = id % 24; *(u32x4*)(Ks + (BUF) * 12800 + kr * 200 + ch * 8) = rk[i]; } \
                       _Pragma("unroll") for (int i = 0; i < 2; ++i) { const int id = gt + 512 * i, v = id >> 3, c8 = id & 7; *(u32x4*)(VTs + (BUF) * 9216 + v * 72 + c8 * 8) = rv[i]; } }
  A_LOAD(0);
  __syncthreads();
  A_STORE(0);
  __syncthreads();
  for (int kt = 0; kt < nkt; ++kt) {
    const int buf = kt & 1;
    if (kt + 1 < nkt) A_LOAD((kt + 1) * 64);
    if (kt <= kmax_w) {
      const bf16_t* Kb = Ks + buf * 12800; const bf16_t* Vb = VTs + buf * 9216;
      f32x16 sa[2]; sa[0] = zero16(); sa[1] = zero16();
#pragma unroll
      for (int ks = 0; ks < 12; ++ks) {
        const bf16x8 a0 = *(const bf16x8*)(Kb + r * 200 + 16 * ks + 8 * h);
        const bf16x8 a1 = *(const bf16x8*)(Kb + (32 + r) * 200 + 16 * ks + 8 * h);
        sa[0] = MFMA(a0, qf[ks], sa[0]); sa[1] = MFMA(a1, qf[ks], sa[1]);
      }
      if (kt >= kmask_w) {
#pragma unroll
        for (int n = 0; n < 2; ++n)
#pragma unroll
          for (int i = 0; i < 16; ++i) { const int key = kt * 64 + 32 * n + crow(i, h); if (key > qrow) sa[n][i] = -1e30f; }
      }
      float mx = -1e30f;
#pragma unroll
      for (int n = 0; n < 2; ++n)
#pragma unroll
        for (int i = 0; i < 16; ++i) mx = fmaxf(mx, sa[n][i]);
      mx = fmaxf(mx, __shfl_xor(mx, 32));
      const float mnew = fmaxf(m, mx);
      const float alpha = __builtin_amdgcn_exp2f(m - mnew);
      m = mnew;
      float rsum = 0.f;
#pragma unroll
      for (int n = 0; n < 2; ++n)
#pragma unroll
        for (int i = 0; i < 16; ++i) { const float pv = __builtin_amdgcn_exp2f(sa[n][i] - mnew); sa[n][i] = pv; rsum += pv; }
      rsum += __shfl_xor(rsum, 32);
      l = l * alpha + rsum;
#pragma unroll
      for (int mt = 0; mt < 4; ++mt) {
        if (__builtin_amdgcn_ballot_w64(alpha != 1.0f) != 0ull) {
#pragma unroll
          for (int i = 0; i < 16; ++i) oacc[mt][i] *= alpha;
        }
      }
      bf16x8 pf[4];
#pragma unroll
      for (int n = 0; n < 2; ++n)
#pragma unroll
        for (int s2 = 0; s2 < 2; ++s2) {
          u32x4 pk;
          pk.x = pack2(sa[n][8 * s2 + 0], sa[n][8 * s2 + 1]); pk.y = pack2(sa[n][8 * s2 + 2], sa[n][8 * s2 + 3]);
          pk.z = pack2(sa[n][8 * s2 + 4], sa[n][8 * s2 + 5]); pk.w = pack2(sa[n][8 * s2 + 6], sa[n][8 * s2 + 7]);
          pf[n * 2 + s2] = __builtin_bit_cast(bf16x8, pk);
        }
#pragma unroll
      for (int mt = 0; mt < 4; ++mt)
#pragma unroll
        for (int f = 0; f < 4; ++f) {
          const bf16_t* vp = Vb + (32 * mt + r) * 72 + 16 * f + 4 * h;
          const u32x2 lo = *(const u32x2*)vp, hi = *(const u32x2*)(vp + 8);
          u32x4 av; av.x = lo.x; av.y = lo.y; av.z = hi.x; av.w = hi.y;
          oacc[mt] = MFMA(__builtin_bit_cast(bf16x8, av), pf[f], oacc[mt]);
        }
    }
    if (kt + 1 < nkt) A_STORE(buf ^ 1);
    __syncthreads();
  }
#undef A_LOAD
#undef A_STORE
  const float inv = 1.0f / l;
#pragma unroll
  for (int mt = 0; mt < 4; ++mt)
#pragma unroll
    for (int g = 0; g < 4; ++g) {
      u32x2 o; o.x = pack2(oacc[mt][4 * g] * inv, oacc[mt][4 * g + 1] * inv); o.y = pack2(oacc[mt][4 * g + 2] * inv, oacc[mt][4 * g + 3] * inv);
      *(u32x2*)(AO + (size_t)qrow * 1024 + hd * 128 + 32 * mt + 8 * g + 4 * h) = o;
    }
}

enum { ST_N1 = 0, ST_IN, ST_GATE, ST_S1, ST_S2, ST_S3, ST_S1B, ST_S2B, ST_S3B, ST_M1, ST_M2, ST_M3, ST_ATT, ST_OUT, ST_N2, ST_F1, ST_F2 };
__device__ __constant__ signed char c_steps[4][13] = {
  { ST_N1, ST_IN, ST_S1, ST_S2, ST_S3, ST_OUT, ST_F1, ST_F2, -1, -1, -1, -1, -1 },
  { ST_IN, ST_GATE, ST_S1, ST_S2, ST_S3, ST_OUT, ST_F1, ST_F2, -1, -1, -1, -1, -1 },
  { ST_IN, ST_S1, ST_S2, ST_S3, ST_S1B, ST_S2B, ST_S3B, ST_OUT, ST_F1, ST_F2, -1, -1, -1 },
  { ST_IN, ST_M1, ST_M2, ST_M3, ST_ATT, ST_OUT, ST_F1, ST_F2, -1, -1, -1, -1, -1 } };
constexpr int N_PHASES = 8 + 8 + 10 + 8;

struct ConvJob { const float* src; int K, N, Np, mode; bf16_t* dst; };
DI int conv_tiles(const ConvJob& j) { return (j.Np >> 6) * (j.K >> 6); }

DI bf16_t* wm_of(const Params& p, int layer) { return (bf16_t*)(p.ws + ((layer & 1) ? WMB_OFF : WM_OFF)); }
DI bool mixer_job(const Params& p, int layer, int j, ConvJob& o) {
  bf16_t* WM = wm_of(p, layer);
  if (layer == 0) {
    if (j == 0) { o = ConvJob{ p.hgrn_w_in, 1024, 4096, 4096, 0, WM }; return true; }
    if (j == 1) { o = ConvJob{ p.hgrn_w_out, 1024, 1024, 1024, 0, WM + 4194304 }; return true; }
  } else if (layer == 1) {
    if (j == 0) { o = ConvJob{ p.gla_w_in, 1024, 3088, 3328, 0, WM }; return true; }
    if (j == 1) { o = ConvJob{ p.gla_w_out, 1024, 1024, 1024, 0, WM + 3407872 }; return true; }
  } else if (layer == 2) {
    if (j == 0) { o = ConvJob{ p.ret_w_in, 1024, 6144, 6144, 0, WM }; return true; }
    if (j == 1) { o = ConvJob{ p.ret_w_out, 2048, 1024, 1024, 0, WM + 6291456 }; return true; }
  } else {
    if (j == 0) { o = ConvJob{ p.mla_w_in, 1024, 576, 768, 0, WM }; return true; }
    if (j == 1) { o = ConvJob{ p.mla_w_uq, 384, 1536, 1536, 0, WM + 786432 }; return true; }
    if (j == 2) { o = ConvJob{ p.mla_w_ukv, 128, 2048, 2048, 0, WM + 1376256 }; return true; }
    if (j == 3) { o = ConvJob{ p.mla_w_out, 1024, 1024, 1024, 0, WM + 1638400 }; return true; }
  }
  return false;
}
DI void run_conv(const ConvJob& job, int& off, char* sm) {
  const int G = VG_(), cnt = conv_tiles(job);
  const int start = (VB_() - (off % G) + G) % G;
  for (int t0 = 0; t0 < cnt; t0 += G) {
    int t = t0 + start; if (t >= cnt) t = cnt - 1;
    conv_tile(job.src, job.K, job.N, job.mode, job.dst, t, sm);
  }
  off += cnt;
}

DI ScanDesc make_scan(const Params& p, int layer, int grp) {
  ScanDesc d;
  bf16_t* P = (bf16_t*)(p.ws + PB_OFF);
  if (layer == 0) { d.q = P; d.k = P; d.g = P + 1024; d.ldp = 3072; d.ldg = 3072; d.gate = P + 2048; d.gnorm = p.hgrn_g_norm; d.mode = 0; d.H0 = 0; d.Hg = 8; d.dv = 128; }
  else if (layer == 1) { d.q = P; d.k = P + 512; d.g = (const bf16_t*)(p.ws + HB_OFF); d.ldp = 2176; d.ldg = 512; d.gate = P + 1024; d.gnorm = p.gla_g_norm; d.mode = 1; d.H0 = 0; d.Hg = 4; d.dv = 256; }
  else { d.q = P; d.k = P + 1024; d.g = P; d.ldp = 4160; d.ldg = 4160; d.gate = P + 2048; d.gnorm = nullptr; d.mode = 2; d.H0 = 4 * grp; d.Hg = 4; d.dv = 256; }
  return d;
}

DI void run_phase(const Params& p, int layer, int step, char* smem, bool live) {
  const int G = VG_(), B = VB_();
  char* sm = smem + (B & 1) * HALF_LDS;
  bf16_t* WM = wm_of(p, layer); bf16_t* WF = (bf16_t*)(p.ws + WF_OFF);
  bf16_t* H = (bf16_t*)(p.ws + HB_OFF); bf16_t* P = (bf16_t*)(p.ws + PB_OFF);
  switch (step) {
    case ST_N1: {
      for (int it = B; it < 4096; it += G) norm_item(p.x, p.norm_mix, H, it);
      for (int it = B; it < 4096; it += G) table_item(p, it);
      for (int it = B; it < 4; it += G) lb_item(p, it);
      { float* z = (float*)(p.ws + SSQA_OFF); for (int i = B * 256 + tid_(); i < 2 * 16384; i += G * 256) z[i] = 0.f; }
      int off = 0;
      for (int j = 0; j < 2; ++j) { ConvJob job; if (mixer_job(p, 0, j, job)) run_conv(job, off, sm); }
    } break;
    case ST_GATE: gla_gate_phase(p); break;
    case ST_S1: case ST_S1B: {
      const ScanDesc d = make_scan(p, layer, step == ST_S1B);
      const int n = 256 * d.Hg * (d.dv >> 7);
      scan1_run(p, d, n, sm);
    } break;
    case ST_S2: case ST_S2B: {
      const ScanDesc d = make_scan(p, layer, step == ST_S2B); scan2_phase(p, d, live);
      if (step == ST_S2) {
        int off = 0;
        { ConvJob job{ p.ffn_w_gate_up + (size_t)layer * 1024 * 5632, 1024, 5632, 5632, 1, WF }; run_conv(job, off, sm); }
        { ConvJob job{ p.ffn_w_down + (size_t)layer * 2816 * 1024, 2816, 1024, 1024, 0, WF + 5767168 }; run_conv(job, off, sm); }
        for (int j = 0; j < 4; ++j) { ConvJob job; if (mixer_job(p, layer + 1, j, job)) run_conv(job, off, sm); }
      }
    } break;
    case ST_S3: case ST_S3B: {
      const ScanDesc d = make_scan(p, layer, step == ST_S3B);
      const int n = 256 * d.Hg;
      for (int u0 = 0; u0 < n; u0 += G) { int u = u0 + B; const bool valid = (u < n) && live; if (u >= n) u = n - 1; scan3_unit(p, d, u, valid, sm); }
    } break;
    case ST_M1: {
      for (int it = B; it < 4096; it += G) mla_m1_item(p, it, live);
      int off = 0;
      { ConvJob job{ p.ffn_w_gate_up + (size_t)layer * 1024 * 5632, 1024, 5632, 5632, 1, WF }; run_conv(job, off, sm); }
      { ConvJob job{ p.ffn_w_down + (size_t)layer * 2816 * 1024, 2816, 1024, 1024, 0, WF + 5767168 }; run_conv(job, off, sm); }
    } break;
    case ST_M3: for (int it = B; it < 4096; it += G) mla_m3_item(p, it, live, sm); break;
    case ST_ATT: for (int u = blockIdx.x; u < 512; u += gridDim.x) attn_unit(p, u, smem); break;
    case ST_IN: case ST_M2: case ST_OUT: case ST_F1: case ST_F2: {
      const bf16_t* A = H; int lda = 1024; const bf16_t* W = WM; int K = 1024, ntn = 4, gid = G_OUT;
      const bf16_t* A2 = H; int lda2 = 0; const bf16_t* W2 = WM; int K2 = 0, ntn2 = 0, gid2 = 0;
      if (step == ST_IN) {
        if (layer == 0) { ntn = 16; gid = G_HGRN_IN; } else if (layer == 1) { ntn = 13; gid = G_GLA_IN; }
        else if (layer == 2) { ntn = 24; gid = G_RET_IN; } else { ntn = 3; gid = G_MLA_IN; }
      } else if (step == ST_M2) {
        A = P; lda = 640; W = WM + 786432; K = 384; ntn = 6; gid = G_MLA_Q;
        A2 = P + 384; lda2 = 640; W2 = WM + 1376256; K2 = 128; ntn2 = 8; gid2 = G_MLA_KV;
      } else if (step == ST_OUT) {
        if (layer == 0) { A = P + 2048; lda = 3072; W = WM + 4194304; }
        else if (layer == 1) { A = P + 1024; lda = 2176; W = WM + 3407872; }
        else if (layer == 2) { A = P + 2048; lda = 4160; W = WM + 6291456; K = 2048; }
        else { A = (const bf16_t*)(p.ws + AO_OFF); W = WM + 1638400; }
      } else if (step == ST_F1) { W = WF; ntn = 22; gid = G_FFN1; }
      else { A = P; lda = 2816; W = WF + 5767168; K = 2816; gid = G_FFN2; }
      if (step == ST_IN && layer > 0) { float* z = (float*)(p.ws + SSQA_OFF); for (int i = blockIdx.x * 512 + gtid_(); i < 16384; i += gridDim.x * 512) z[i] = 0.f; }
      if (step == ST_F1) { float* z = (float*)(p.ws + SSQB_OFF); for (int i = blockIdx.x * 512 + gtid_(); i < 16384; i += gridDim.x * 512) z[i] = 0.f; }
      const int nall = ntn + ntn2, nM = 64, total = nM * nall;
      for (int t = blockIdx.x; t < total; t += gridDim.x) {
        int wg = t; { const int q = total / 8, rr = total % 8, xcd = wg % 8, o = wg / 8; wg = (xcd < rr ? xcd * (q + 1) : rr * (q + 1) + (xcd - rr) * q) + o; }
        const int nig = WGM * nall, g0 = wg / nig, fm = g0 * WGM, gsz = (nM - fm) < WGM ? (nM - fm) : WGM;
        const int mt = fm + (wg % nig) % gsz; int n = (wg % nig) / gsz;
        const bf16_t* Ax = A; int ldx = lda; const bf16_t* Wx = W; int Kx = K, gx = gid;
        if (n >= ntn) { n -= ntn; Ax = A2; ldx = lda2; Wx = W2; Kx = K2; gx = gid2; }
        gemm_tile(p, Ax, ldx, Wx, Kx, gx, mt, n, layer, smem);
      }
    } break;
    default: break;
  }
}

#define XB_TMO      128
#define XB_XCNT(j)  (256  + 64 * (j))
#define XB_XSUB(j)  (1280 + 64 * (j))
#define XB_XGEN(j)  (2304 + 64 * (j))
#define XB_TOP      3328
#define XB_TOPGEN   3392
#define XCD_BAR_WORDS 3456
#define XB_SPIN_CAP (1u << 18)

__device__ __forceinline__ unsigned xb_ld(unsigned* p)              { return __hip_atomic_load(p, __ATOMIC_RELAXED, __HIP_MEMORY_SCOPE_AGENT); }
__device__ __forceinline__ unsigned xb_add(unsigned* p, unsigned v) { return __hip_atomic_fetch_add(p, v, __ATOMIC_RELAXED, __HIP_MEMORY_SCOPE_AGENT); }
__device__ __forceinline__ unsigned xb_xcc_id() { return (unsigned)__builtin_amdgcn_s_getreg((3 << 11) | 20) & 0xFu; }
#define XB_SPIN(cond, bar) do { unsigned _sp = 0; while (cond) { __builtin_amdgcn_s_sleep(1); \
    if ((++_sp & 255u) == 0u) { if (xb_ld(&(bar)[XB_TMO])) break; if (_sp > XB_SPIN_CAP) { atomicAdd(&(bar)[XB_TMO], 1u); break; } } } } while (0)

struct XcdBarrier {
    unsigned* bar; unsigned x;
    volatile unsigned* st;
};

__device__ __forceinline__ XcdBarrier xcd_barrier_post(unsigned* bar, volatile unsigned* st) {
    XcdBarrier b; b.bar = bar; b.x = xb_xcc_id(); b.st = st;
    if (threadIdx.x == 0) (void)xb_add(&bar[XB_XCNT(b.x)], 1u);
    return b;
}
__device__ __forceinline__ void xcd_barrier_complete(unsigned* bar, unsigned x, unsigned& nloc, unsigned& nx) {
    const unsigned G = gridDim.x * gridDim.y * gridDim.z;
    unsigned sum, cnt, mine, sp = 0u;
    for (;;) {
        sum = 0u; cnt = 0u; mine = 0u;
#pragma unroll
        for (unsigned j = 0; j < 16; ++j) { const unsigned c = xb_ld(&bar[XB_XCNT(j)]); sum += c; cnt += (c > 0u) ? 1u : 0u; mine = (j == x) ? c : mine; }
        if (sum == G) break;
        __builtin_amdgcn_s_sleep(1);
        if ((++sp & 255u) == 0u) { if (xb_ld(&bar[XB_TMO])) break; if (sp > XB_SPIN_CAP) { atomicAdd(&bar[XB_TMO], 1u); break; } }
    }
    nloc = mine > 0u ? mine : 1u; nx = cnt > 0u ? cnt : 1u;
}

__device__ __forceinline__ void xcd_barrier(const XcdBarrier& b) {
    asm volatile("s_waitcnt vmcnt(0)" ::: "memory");
    __syncthreads();
    if (threadIdx.x == 0) {
        unsigned* bar = b.bar;
        __builtin_amdgcn_s_waitcnt(0);
        unsigned nloc = b.st[0], nx = b.st[1];
        if (nloc == 0u) { xcd_barrier_complete(bar, b.x, nloc, nx); b.st[0] = nloc; b.st[1] = nx; }
        const unsigned old = xb_add(&bar[XB_XSUB(b.x)], 1u);
        const unsigned gen = old / nloc;
        if (old + 1u == (gen + 1u) * nloc) {
            __builtin_amdgcn_fence(__ATOMIC_RELEASE, "agent");
            asm volatile("s_waitcnt vmcnt(0)" ::: "memory");
            const unsigned og = xb_add(&bar[XB_TOP], 1u);
            const unsigned tg = og / nx;
            if (og + 1u == (tg + 1u) * nx) xb_add(&bar[XB_TOPGEN], 1u);
            else XB_SPIN(xb_ld(&bar[XB_TOPGEN]) == tg, bar);
            __builtin_amdgcn_fence(__ATOMIC_ACQUIRE, "agent");
            xb_add(&bar[XB_XGEN(b.x)], 1u);
            asm volatile("s_waitcnt vmcnt(0)" ::: "memory");
        } else {
            XB_SPIN(xb_ld(&bar[XB_XGEN(b.x)]) == gen, bar);
            __builtin_amdgcn_fence(__ATOMIC_ACQUIRE, "agent");
            asm volatile("s_waitcnt vmcnt(0)" ::: "memory");
        }
    }
    __syncthreads();
}


DI void grid_barrier(unsigned* ctr, unsigned& epoch) {
  asm volatile("s_waitcnt vmcnt(0)" ::: "memory");
  __syncthreads();
  epoch += gridDim.x;
  if (threadIdx.x < 64) {
    if (threadIdx.x == 0) {
      __builtin_amdgcn_fence(__ATOMIC_RELEASE, "agent");
      asm volatile("s_waitcnt vmcnt(0)" ::: "memory");
      __hip_atomic_fetch_add(ctr, 1u, __ATOMIC_RELAXED, __HIP_MEMORY_SCOPE_AGENT);
      while (__hip_atomic_load(ctr, __ATOMIC_RELAXED, __HIP_MEMORY_SCOPE_AGENT) < epoch) __builtin_amdgcn_s_sleep(1);
    }
    __builtin_amdgcn_fence(__ATOMIC_ACQUIRE, "agent");
    asm volatile("s_waitcnt vmcnt(0)" ::: "memory");
  }
  __syncthreads();
}

__global__ void __launch_bounds__(512) fwd_megakernel(Params p, int ph_lo, int ph_hi) {
  extern __shared__ __attribute__((aligned(16))) char smem[];
  cg::grid_group grid = cg::this_grid();
  volatile unsigned* xst = (volatile unsigned*)(smem + 147456);
  if (threadIdx.x == 0) { xst[0] = 0u; xst[1] = 0u; }
  __syncthreads();
  const XcdBarrier xb = xcd_barrier_post((unsigned*)(p.ws + LB_OFF + 262144), xst);
  int ph = 0;
  for (int layer = 0; layer < 4; ++layer) {
    for (int si = 0; si < 13; ++si) {
      const int step = c_steps[layer][si];
      if (step < 0) break;
      if (ph >= ph_lo && ph < ph_hi) {
        run_phase(p, layer, step, smem, true);
        if (ph + 1 < ph_hi) { if (ph_hi > 1000) grid.sync(); else xcd_barrier(xb); }
      }
      ++ph;
    }
  }
}

extern "C" void kernel_launch(void* const* d_in, const int* in_sizes, int n_in, void* d_out, int out_size, void* d_ws, size_t ws_size, hipStream_t stream) {
  static int grid_blocks = 0;
  Params p{};
  const float** fp = (const float**)&p;
  p.x = (const float*)d_in[0]; p.pos = (const int*)d_in[1];
  for (int i = 2; i < 25; ++i) fp[i] = (const float*)d_in[i];
  p.out = (float*)d_out; p.ws = (char*)d_ws;
  int lo = 0, hi = N_PHASES;
  void* args[] = { &p, &lo, &hi };
  if (!grid_blocks) {
    int dev = 0, cus = 0;
    (void)hipGetDevice(&dev);
    (void)hipDeviceGetAttribute(&cus, hipDeviceAttributeMultiprocessorCount, dev);
    (void)hipFuncSetAttribute((const void*)fwd_megakernel, hipFuncAttributeMaxDynamicSharedMemorySize, LDS_BYTES);
    grid_blocks = cus;
  }
  (void)hipMemsetAsync((char*)d_ws + LB_OFF + 262144, 0, XCD_BAR_WORDS * 4, stream);
  hipError_t e = hipLaunchCooperativeKernel((const void*)fwd_megakernel, dim3(grid_blocks), dim3(NT), args, LDS_BYTES, stream);
  if (e != hipSuccess) fprintf(stderr, "cooperative launch failed: %s (grid %d)\n", hipGetErrorString(e), grid_blocks);
}
```
